# Optimizing an MI355X kernel written in HIP

```python
import numpy as np
import jax
import jax.numpy as jnp
from jax import lax

D_MODEL = 2048
BATCH = 2
SEQ = 4096
DEPTH = 1

GLA_WIDTH = D_MODEL // 2
NSA_WIDTH = D_MODEL - GLA_WIDTH
GLA_HEADS = 4
GLA_DV = GLA_WIDTH // GLA_HEADS
GLA_DK = GLA_DV // 2
GLA_RANK = 16
GLA_TAU = 16.0
GLA_CHUNK = 64
NSA_HEAD_DIM = 128
NSA_HEADS = NSA_WIDTH // NSA_HEAD_DIM
NSA_GROUPS = 2
NSA_HPG = NSA_HEADS // NSA_GROUPS
CMP_STRIDE = 16
CMP_BLOCK = 2 * CMP_STRIDE
CMP_HIDDEN = 256
SEL_BLOCK = 64
SEL_TOPK = 16
SEL_QBLOCK = 64
WINDOW = 512
WIN_QBLOCK = 128
ROPE_DIM = NSA_HEAD_DIM // 4
ROPE_THETA = 500000.0
N_EXPERTS = 32
TOP_K = 4
D_FF = D_MODEL
SWIGLU_LIMIT = 7.0
SWIGLU_ALPHA = 1.702
DN_ALPHA = (2.0 * DEPTH) ** 0.25
DN_BETA = (8.0 * DEPTH) ** -0.25
LN_EPS = 1e-5
NSA_KV = NSA_GROUPS * NSA_HEAD_DIM
IN_SPLITS = (GLA_HEADS * GLA_DK, GLA_HEADS * GLA_DK, GLA_WIDTH, GLA_WIDTH, GLA_RANK,
             NSA_WIDTH, NSA_KV, NSA_KV, NSA_KV, NSA_KV, NSA_KV, NSA_KV, NSA_HEADS * 3)
D_IN = sum(IN_SPLITS)

kernel_name = 'hybrid_gla_nsa_moe_deepnorm_adaln'


def layer_norm(x, g=None, b=None):
    xf = x.astype(jnp.float32)
    xc = xf - jnp.mean(xf, -1, keepdims=True)
    y = xc * lax.rsqrt(jnp.mean(xc * xc, -1, keepdims=True) + LN_EPS)
    if g is not None:
        y = y * g.astype(jnp.float32) + b.astype(jnp.float32)
    return y.astype(x.dtype)


def rms_norm(x, g):
    xf = x.astype(jnp.float32)
    return xf * lax.rsqrt(jnp.mean(xf * xf, -1, keepdims=True) + LN_EPS) * g.astype(jnp.float32)


def partial_rope(x, pos):
    half = ROPE_DIM // 2
    inv_freq = ROPE_THETA ** (-jnp.arange(half, dtype=jnp.float32) * (2.0 / ROPE_DIM))
    ang = pos.astype(jnp.float32)[:, None] * inv_freq
    cos = jnp.cos(ang)[:, None, :]
    sin = jnp.sin(ang)[:, None, :]
    xr = x[..., :ROPE_DIM].astype(jnp.float32)
    x1, x2 = xr[..., :half], xr[..., half:]
    rot = jnp.concatenate([x1 * cos - x2 * sin, x2 * cos + x1 * sin], -1)
    return jnp.concatenate([rot.astype(x.dtype), x[..., ROPE_DIM:]], -1)


def gla_mixer(q, k, v, r, g_lr, w_gk, b_gk, norm_g):
    B, T, _ = q.shape
    H, C = GLA_HEADS, GLA_CHUNK
    NC = T // C
    f32 = jnp.float32
    q = q.astype(f32) * (GLA_DK ** -0.5)
    log_a = jax.nn.log_sigmoid((g_lr @ w_gk + b_gk).astype(f32)) / GLA_TAU

    def chunks(a):
        return a.astype(f32).reshape(B, NC, C, H, -1).transpose(1, 0, 3, 2, 4)

    qc, kc, vc = chunks(q), chunks(k), chunks(v)
    bc = jnp.cumsum(chunks(log_a), axis=3)
    causal = jnp.tril(jnp.ones((C, C), bool))[None, None, :, :, None]

    def step(S, inp):
        qt, kt, vt, bt = inp
        o_inter = jnp.einsum('bhtd,bhde->bhte', qt * jnp.exp(bt), S)
        diff = bt[:, :, :, None, :] - bt[:, :, None, :, :]
        decay = jnp.exp(jnp.where(causal, diff, -jnp.inf))
        att = jnp.einsum('bhtd,bhsd,bhtsd->bhts', qt, kt, decay)
        o = o_inter + jnp.einsum('bhts,bhse->bhte', att, vt)
        b_last = bt[:, :, -1:, :]
        S = jnp.exp(b_last[:, :, 0, :, None]) * S + jnp.einsum('bhsd,bhse->bhde', kt * jnp.exp(b_last - bt), vt)
        return S, o

    S0 = jnp.zeros((B, H, GLA_DK, GLA_DV), f32)
    _, o = lax.scan(step, S0, (qc, kc, vc, bc))
    o = o.transpose(1, 0, 3, 2, 4).reshape(B, T, H, GLA_DV)
    return rms_norm(o, norm_g).reshape(B, T, GLA_WIDTH) * jax.nn.silu(r.astype(f32))


def compress(a, pe, w1, b1, w2, b2):
    B, T, G, D = a.shape
    a16 = a.reshape(B, T // CMP_STRIDE, CMP_STRIDE, G, D)
    blocks = jnp.concatenate([a16[:, :-1], a16[:, 1:]], axis=2) + pe[None, None, :, None, :]
    flat = blocks.transpose(0, 1, 3, 2, 4).reshape(B, T // CMP_STRIDE - 1, G, CMP_BLOCK * D)
    return jax.nn.silu(flat @ w1 + b1) @ w2 + b2


def nsa_mixer(q, k_cmp, v_cmp, k_slc, v_slc, k_win, v_win, gate_logits, pe_k, pe_v,
              w_ck1, b_ck1, w_ck2, b_ck2, w_cv1, b_cv1, w_cv2, b_cv2):
    B, T, _ = q.shape
    G, HPG, DH = NSA_GROUPS, NSA_HPG, NSA_HEAD_DIM
    f32 = jnp.float32
    scale = DH ** -0.5
    pos = jnp.arange(T)
    qg = partial_rope(q.reshape(B, T, NSA_HEADS, DH), pos).reshape(B, T, G, HPG, DH)

    def kv(a):
        return a.reshape(B, T, G, DH)

    n_cmp = T // CMP_STRIDE - 1
    cmp_end = jnp.arange(n_cmp) * CMP_STRIDE + (CMP_BLOCK - 1)
    kc = partial_rope(compress(kv(k_cmp), pe_k, w_ck1, b_ck1, w_ck2, b_ck2), cmp_end)
    vc = compress(kv(v_cmp), pe_v, w_cv1, b_cv1, w_cv2, b_cv2)
    s = jnp.einsum('btghd,bngd->bghtn', qg, kc).astype(f32) * scale
    s = jnp.where(cmp_end[None, :] <= pos[:, None], s, -jnp.inf)
    m = jnp.max(s, -1, keepdims=True)
    e = jnp.exp(s - jnp.where(jnp.isfinite(m), m, 0.0))
    p_cmp = e / jnp.maximum(jnp.sum(e, -1, keepdims=True), 1e-30)
    o_cmp = jnp.einsum('bghtn,bngd->btghd', p_cmp, vc.astype(f32))

    n_blk = T // SEL_BLOCK
    topk = min(SEL_TOPK, n_blk)
    c_start = np.arange(n_cmp) * CMP_STRIDE
    b_start = np.arange(n_blk) * SEL_BLOCK
    overlap = ((c_start[:, None] < b_start[None, :] + SEL_BLOCK)
               & (c_start[:, None] + CMP_BLOCK > b_start[None, :])).astype(np.float32)
    p_blk = jnp.einsum('bghtn,nj->btgj', p_cmp, jnp.asarray(overlap))
    cur = pos // SEL_BLOCK
    j = jnp.arange(n_blk)
    forced = (j[None] == 0) | (j[None] == cur[:, None]) | (j[None] == cur[:, None] - 1)
    allowed = j[None] <= cur[:, None]
    score = jnp.where(forced[None, :, None, :], jnp.inf,
                      jnp.where(allowed[None, :, None, :], p_blk, -jnp.inf))
    _, sel_idx = lax.top_k(score, topk)
    kb = partial_rope(kv(k_slc), pos).reshape(B, n_blk, SEL_BLOCK, G, DH).transpose(0, 3, 1, 2, 4)
    vb = kv(v_slc).reshape(B, n_blk, SEL_BLOCK, G, DH).transpose(0, 3, 1, 2, 4)
    nq = T // SEL_QBLOCK
    q_blocks = qg.reshape(B, nq, SEL_QBLOCK, G, HPG, DH).transpose(1, 0, 3, 2, 4, 5)
    i_blocks = sel_idx.reshape(B, nq, SEL_QBLOCK, G, topk).transpose(1, 0, 3, 2, 4)
    p_blocks = pos.reshape(nq, SEL_QBLOCK)
    bi = jnp.arange(B)[:, None, None, None]
    gi = jnp.arange(G)[None, :, None, None]

    def sel_attend(args):
        qb, ib, pb = args
        kg = kb[bi, gi, ib]
        vg = vb[bi, gi, ib]
        s = jnp.einsum('bgqhd,bgqkpd->bgqhkp', qb, kg).astype(f32) * scale
        key_pos = ib[..., None] * SEL_BLOCK + jnp.arange(SEL_BLOCK)
        s = jnp.where((key_pos <= pb[None, None, :, None, None])[:, :, :, None], s, -jnp.inf)
        p = jax.nn.softmax(s.reshape(s.shape[:4] + (-1,)), axis=-1).reshape(s.shape)
        return jnp.einsum('bgqhkp,bgqkpd->bqghd', p, vg.astype(f32))

    o_slc = lax.map(sel_attend, (q_blocks, i_blocks, p_blocks))
    o_slc = o_slc.transpose(1, 0, 2, 3, 4, 5).reshape(B, T, G, HPG, DH)

    nw = T // WIN_QBLOCK
    n_pad = WINDOW // WIN_QBLOCK

    def band(a):
        ap = jnp.pad(a, ((0, 0), (WINDOW, 0), (0, 0), (0, 0))).reshape(B, nw + n_pad, WIN_QBLOCK, G, DH)
        return jnp.concatenate([ap[:, i:i + nw] for i in range(n_pad + 1)], axis=2)

    kw = band(partial_rope(kv(k_win), pos))
    vw = band(kv(v_win))
    qw = qg.reshape(B, nw, WIN_QBLOCK, G, HPG, DH)
    s = jnp.einsum('bnqghd,bnkgd->bnghqk', qw, kw).astype(f32) * scale
    q_pos = pos.reshape(nw, WIN_QBLOCK)
    k_pos = jnp.arange(nw)[:, None] * WIN_QBLOCK - WINDOW + jnp.arange((n_pad + 1) * WIN_QBLOCK)[None, :]
    dist = q_pos[:, :, None] - k_pos[:, None, :]
    win_mask = (dist >= 0) & (dist < WINDOW) & (k_pos[:, None, :] >= 0)
    p = jax.nn.softmax(jnp.where(win_mask[None, :, None, None], s, -jnp.inf), axis=-1)
    o_win = jnp.einsum('bnghqk,bnkgd->bnqghd', p, vw.astype(f32)).reshape(B, T, G, HPG, DH)

    gates = jax.nn.sigmoid(gate_logits.astype(f32)).reshape(B, T, G, HPG, 3)
    o = gates[..., 0:1] * o_cmp + gates[..., 1:2] * o_slc + gates[..., 2:3] * o_win
    return o.reshape(B, T, NSA_WIDTH)


def clamped_swiglu(gate, up):
    gate = jnp.minimum(gate, SWIGLU_LIMIT)
    up = jnp.clip(up, -SWIGLU_LIMIT, SWIGLU_LIMIT)
    return gate * jax.nn.sigmoid(SWIGLU_ALPHA * gate) * (up + 1.0)


def moe_ffn(h, w_router, b_router, w_gate, b_gate, w_up, b_up, w_down, b_down):
    B, T, D = h.shape
    xt = h.reshape(B * T, D)
    logits = (xt @ w_router + b_router).astype(jnp.float32)
    top_val, top_idx = lax.top_k(logits, TOP_K)
    top_w = jax.nn.softmax(top_val, axis=-1)
    combine = jnp.einsum('nk,nke->ne', top_w, jax.nn.one_hot(top_idx, N_EXPERTS, dtype=jnp.float32))
    out = jnp.zeros((B * T, D), jnp.float32)
    for e in range(N_EXPERTS):
        act = clamped_swiglu(xt @ w_gate[e] + b_gate[e], xt @ w_up[e] + b_up[e])
        out = out + combine[:, e:e + 1] * (act @ w_down[e] + b_down[e]).astype(jnp.float32)
    return out.reshape(B, T, D)


def setup_inputs(seed: int = 0) -> dict:
    key = jax.random.key(seed)
    ks = jax.random.split(key, 31)

    def nrm(i, shape, scale):
        return jax.random.normal(ks[i], shape, jnp.float32) * scale

    L, D, E, F = DEPTH, D_MODEL, N_EXPERTS, D_FF
    cin = CMP_BLOCK * NSA_HEAD_DIM
    return {
        'x': nrm(0, (BATCH, SEQ, D), 1.0),
        'c': nrm(1, (BATCH, D), 1.0),
        'w_ada': nrm(2, (L, D, 6 * D), 0.1 * D ** -0.5),
        'b_ada': nrm(3, (L, 6 * D), 0.02),
        'w_in': nrm(4, (L, D, D_IN), D ** -0.5),
        'w_gk': nrm(5, (L, GLA_RANK, GLA_HEADS * GLA_DK), GLA_RANK ** -0.5),
        'b_gk': nrm(6, (L, GLA_HEADS * GLA_DK), 0.1),
        'gla_norm_g': 1.0 + nrm(7, (L, GLA_DV), 0.02),
        'pe_k': nrm(8, (L, CMP_BLOCK, NSA_HEAD_DIM), 0.1),
        'pe_v': nrm(9, (L, CMP_BLOCK, NSA_HEAD_DIM), 0.1),
        'w_ck1': nrm(10, (L, cin, CMP_HIDDEN), cin ** -0.5),
        'b_ck1': nrm(11, (L, CMP_HIDDEN), 0.02),
        'w_ck2': nrm(12, (L, CMP_HIDDEN, NSA_HEAD_DIM), CMP_HIDDEN ** -0.5),
        'b_ck2': nrm(13, (L, NSA_HEAD_DIM), 0.02),
        'w_cv1': nrm(14, (L, cin, CMP_HIDDEN), cin ** -0.5),
        'b_cv1': nrm(15, (L, CMP_HIDDEN), 0.02),
        'w_cv2': nrm(16, (L, CMP_HIDDEN, NSA_HEAD_DIM), CMP_HIDDEN ** -0.5),
        'b_cv2': nrm(17, (L, NSA_HEAD_DIM), 0.02),
        'w_o': nrm(18, (L, D, D), DN_BETA * D ** -0.5),
        'ln1_g': 1.0 + nrm(19, (L, D), 0.02),
        'ln1_b': nrm(20, (L, D), 0.02),
        'w_router': nrm(21, (L, D, E), D ** -0.5),
        'b_router': nrm(22, (L, E), 0.01),
        'w_gate': nrm(23, (L, E, D, F), D ** -0.5),
        'b_gate': nrm(24, (L, E, F), 0.02),
        'w_up': nrm(25, (L, E, D, F), D ** -0.5),
        'b_up': nrm(26, (L, E, F), 0.02),
        'w_down': nrm(27, (L, E, F, D), DN_BETA * F ** -0.5),
        'b_down': nrm(28, (L, E, D), 0.02),
        'ln2_g': 1.0 + nrm(29, (L, D), 0.02),
        'ln2_b': nrm(30, (L, D), 0.02),
    }


def reference(x, c, w_ada, b_ada, w_in, w_gk, b_gk, gla_norm_g, pe_k, pe_v,
              w_ck1, b_ck1, w_ck2, b_ck2, w_cv1, b_cv1, w_cv2, b_cv2, w_o, ln1_g, ln1_b,
              w_router, b_router, w_gate, b_gate, w_up, b_up, w_down, b_down, ln2_g, ln2_b):
    split_at = tuple(int(v) for v in np.cumsum(IN_SPLITS)[:-1])
    for l in range(DEPTH):
        mod = (jax.nn.silu(c) @ w_ada[l] + b_ada[l])[:, None, :]
        sh1, sc1, g1, sh2, sc2, g2 = jnp.split(mod, 6, axis=-1)

        h = layer_norm(x) * (1.0 + sc1) + sh1
        (gq, gk, gv, gr, glr, nq, kcm, vcm, ksl, vsl, kwn, vwn, ngt) = jnp.split(h @ w_in[l], split_at, axis=-1)
        y_gla = gla_mixer(gq, gk, gv, gr, glr, w_gk[l], b_gk[l], gla_norm_g[l])
        y_nsa = nsa_mixer(nq, kcm, vcm, ksl, vsl, kwn, vwn, ngt, pe_k[l], pe_v[l],
                          w_ck1[l], b_ck1[l], w_ck2[l], b_ck2[l], w_cv1[l], b_cv1[l], w_cv2[l], b_cv2[l])
        mix = jnp.concatenate([y_gla, y_nsa], -1).astype(x.dtype) @ w_o[l]
        x = layer_norm(DN_ALPHA * x + (1.0 + g1) * mix, ln1_g[l], ln1_b[l])

        h2 = layer_norm(x) * (1.0 + sc2) + sh2
        y_ffn = moe_ffn(h2, w_router[l], b_router[l], w_gate[l], b_gate[l],
                        w_up[l], b_up[l], w_down[l], b_down[l]).astype(x.dtype)
        x = layer_norm(DN_ALPHA * x + (1.0 + g2) * y_ffn, ln2_g[l], ln2_b[l])
    return x
```

```cpp
#include <hip/hip_runtime.h>
#include <stdint.h>
#include <cstdio>

#ifndef N_LAUNCH_MODE
#define N_LAUNCH_MODE 1
#endif

typedef unsigned short bf16_t;
typedef float f32x4 __attribute__((ext_vector_type(4)));
#define LAS __attribute__((address_space(3)))

constexpr int NB = 2, T = 4096, D = 2048, NTOK = NB * T;
constexpr int DIN = 5672;
constexpr int C_GQ = 0, C_GK = 512, C_GV = 1024, C_GR = 2048, C_GLR = 3072, C_NQ = 3088, C_KCM = 4112, C_VCM = 4368,
              C_KSL = 4624, C_VSL = 4880, C_KWN = 5136, C_VWN = 5392, C_NGT = 5648;
constexpr int NE = 32, TOPK = 4, DFF = 2048;
constexpr int NCMP = 255;
constexpr float LN_EPS = 1e-5f;
constexpr float DN_ALPHA = 1.189207115002721f;
constexpr int NTHR = 512;

constexpr size_t MiB = 1u << 20;
constexpr size_t WS_CTL = 0, CTL_BYTES = 1 * MiB;
constexpr size_t WS_MODP = 1 * MiB;
constexpr size_t WS_MOD = 2 * MiB;
constexpr size_t WS_ROPE = 3 * MiB;
constexpr size_t WS_PEBP = 4 * MiB;
constexpr size_t WS_KC = 5 * MiB;
constexpr size_t WS_VC = 6 * MiB;
constexpr size_t WS_H = 16 * MiB;
constexpr size_t WS_PROJ = 48 * MiB;
constexpr size_t WS_MIXIN = 144 * MiB;
constexpr size_t WS_Z = 176 * MiB;
constexpr size_t WS_X1 = 240 * MiB;
constexpr size_t WS_TOPW = 304 * MiB;
constexpr size_t WS_LIST = 305 * MiB;
constexpr size_t WS_ACT = 340 * MiB;
constexpr size_t WS_YP = 470 * MiB;
constexpr size_t WS_HIDP = 600 * MiB;
constexpr size_t WS_BC = 616 * MiB;
constexpr size_t WS_U = 632 * MiB;
constexpr size_t WS_DTOT = 648 * MiB;
constexpr size_t WS_WRT = 650 * MiB;
constexpr size_t WS_WINB = 652 * MiB;
constexpr size_t WS_WOB = 676 * MiB;
constexpr size_t WS_END = 686 * MiB;
constexpr int CW_BAR = 4096;
constexpr int CW_CNT = 8192;
constexpr int CW_Q = 12288;

constexpr int LDS_BYTES = 160 * 1024;

__device__ __forceinline__ float bf2f(bf16_t b) { return __uint_as_float(((unsigned)b) << 16); }
__device__ __forceinline__ bf16_t f2bf(float f) { unsigned u = __float_as_uint(f); u += 0x7fffu + ((u >> 16) & 1u); return (bf16_t)(u >> 16); }
__device__ __forceinline__ unsigned pk2(float lo, float hi) { return (unsigned)f2bf(lo) | ((unsigned)f2bf(hi) << 16); }
__device__ __forceinline__ float silu_f(float x) { return x / (1.f + __expf(-x)); }
__device__ __forceinline__ float sigmoid_f(float x) { return 1.f / (1.f + __expf(-x)); }
__device__ __forceinline__ float logsigmoid_f(float x) { return fminf(x, 0.f) - log1pf(__expf(-fabsf(x))); }
__device__ __forceinline__ float wave_sum(float v) {
#pragma unroll
    for (int o = 1; o < 64; o <<= 1) v += __shfl_xor(v, o);
    return v;
}
__device__ __forceinline__ float wave_max(float v) {
#pragma unroll
    for (int o = 1; o < 64; o <<= 1) v = fmaxf(v, __shfl_xor(v, o));
    return v;
}

#define XB_TMO      128
#define XB_XCNT(j)  (256  + 64 * (j))
#define XB_XSUB(j)  (1280 + 64 * (j))
#define XB_XGEN(j)  (2304 + 64 * (j))
#define XB_TOP      3328
#define XB_TOPGEN   3392
#define XCD_BAR_WORDS 3456
#define XB_SPIN_CAP (1u << 18)
__device__ __forceinline__ unsigned xb_ld(unsigned* p)              { return __hip_atomic_load(p, __ATOMIC_RELAXED, __HIP_MEMORY_SCOPE_AGENT); }
__device__ __forceinline__ unsigned xb_add(unsigned* p, unsigned v) { return __hip_atomic_fetch_add(p, v, __ATOMIC_RELAXED, __HIP_MEMORY_SCOPE_AGENT); }
__device__ __forceinline__ unsigned xb_xcc_id() { return (unsigned)__builtin_amdgcn_s_getreg((3 << 11) | 20) & 0xFu; }
#define XB_SPIN(cond, bar) do { unsigned _sp = 0; while (cond) { __builtin_amdgcn_s_sleep(1); \
    if ((++_sp & 255u) == 0u) { if (xb_ld(&(bar)[XB_TMO])) break; if (_sp > XB_SPIN_CAP) { atomicAdd(&(bar)[XB_TMO], 1u); break; } } } } while (0)
struct XcdBarrier { unsigned* bar; unsigned x; volatile LAS unsigned* st; };
__device__ __forceinline__ XcdBarrier xcd_barrier_post(unsigned* bar, volatile LAS unsigned* st) {
    XcdBarrier b; b.bar = bar; b.x = xb_xcc_id(); b.st = st;
    if (threadIdx.x == 0) (void)xb_add(&bar[XB_XCNT(b.x)], 1u);
    return b;
}
__device__ __forceinline__ void xcd_barrier_complete(unsigned* bar, unsigned x, unsigned& nloc, unsigned& nx) {
    const unsigned G = gridDim.x * gridDim.y * gridDim.z;
    unsigned sum, cnt, mine, sp = 0u;
    for (;;) {
        sum = 0u; cnt = 0u; mine = 0u;
#pragma unroll
        for (unsigned j = 0; j < 16; ++j) { const unsigned c = xb_ld(&bar[XB_XCNT(j)]); sum += c; cnt += (c > 0u) ? 1u : 0u; mine = (j == x) ? c : mine; }
        if (sum == G) break;
        __builtin_amdgcn_s_sleep(1);
        if ((++sp & 255u) == 0u) { if (xb_ld(&bar[XB_TMO])) break; if (sp > XB_SPIN_CAP) { atomicAdd(&bar[XB_TMO], 1u); break; } }
    }
    nloc = mine > 0u ? mine : 1u; nx = cnt > 0u ? cnt : 1u;
}
__device__ __forceinline__ void xcd_barrier(const XcdBarrier& b) {
    asm volatile("s_waitcnt vmcnt(0)" ::: "memory");
    __syncthreads();
    if (threadIdx.x == 0) {
        unsigned* bar = b.bar;
        __builtin_amdgcn_s_waitcnt(0);
        unsigned nloc = b.st[0], nx = b.st[1];
        if (nloc == 0u) { xcd_barrier_complete(bar, b.x, nloc, nx); b.st[0] = nloc; b.st[1] = nx; }
        const unsigned old = xb_add(&bar[XB_XSUB(b.x)], 1u);
        const unsigned gen = old / nloc;
        if (old + 1u == (gen + 1u) * nloc) {
            __builtin_amdgcn_fence(__ATOMIC_RELEASE, "agent");
            asm volatile("s_waitcnt vmcnt(0)" ::: "memory");
            const unsigned og = xb_add(&bar[XB_TOP], 1u);
            const unsigned tg = og / nx;
            if (og + 1u == (tg + 1u) * nx) xb_add(&bar[XB_TOPGEN], 1u);
            else XB_SPIN(xb_ld(&bar[XB_TOPGEN]) == tg, bar);
            __builtin_amdgcn_fence(__ATOMIC_ACQUIRE, "agent");
            xb_add(&bar[XB_XGEN(b.x)], 1u);
            asm volatile("s_waitcnt vmcnt(0)" ::: "memory");
        } else {
            XB_SPIN(xb_ld(&bar[XB_XGEN(b.x)]) == gen, bar);
            __builtin_amdgcn_fence(__ATOMIC_ACQUIRE, "agent");
            asm volatile("s_waitcnt vmcnt(0)" ::: "memory");
        }
    }
    __syncthreads();
}

struct Params {
    const float *x, *c, *w_ada, *b_ada, *w_in, *w_gk, *b_gk, *gla_g, *pe_k, *pe_v;
    const float *w_ck1, *b_ck1, *w_ck2, *b_ck2, *w_cv1, *b_cv1, *w_cv2, *b_cv2, *w_o, *ln1_g, *ln1_b;
    const float *w_router, *b_router, *w_gate, *b_gate, *w_up, *b_up, *w_down, *b_down, *ln2_g, *ln2_b;
    float* out; unsigned char* ws;
    int ph_lo, ph_hi;
};


__device__ __forceinline__ void ph0(const Params& p, float* lds) {
    const int tid = threadIdx.x, lane = tid & 63, wave = tid >> 6;
    float* modp = (float*)(p.ws + WS_MODP);
    float* rope = (float*)(p.ws + WS_ROPE);
    float* pebp = (float*)(p.ws + WS_PEBP);
    for (int u = blockIdx.x; u < 384; u += gridDim.x) {
        const int cb = u % 48, kc = u / 48;
        const int col = cb * 256 + lane * 4, kb = kc * 256 + wave * 32;
        f32x4 a0 = {0.f, 0.f, 0.f, 0.f}, a1 = {0.f, 0.f, 0.f, 0.f};
#pragma unroll 8
        for (int k = kb; k < kb + 32; ++k) {
            const f32x4 w = *(const f32x4*)(p.w_ada + (size_t)k * 12288 + col);
            const float s0 = silu_f(p.c[k]), s1 = silu_f(p.c[D + k]);
            a0 += s0 * w; a1 += s1 * w;
        }
        __syncthreads();
        *(f32x4*)(lds + (wave * 2 + 0) * 256 + lane * 4) = a0;
        *(f32x4*)(lds + (wave * 2 + 1) * 256 + lane * 4) = a1;
        __syncthreads();
        { const int b = tid >> 8, cc = tid & 255; float s = 0.f;
#pragma unroll
          for (int w = 0; w < 8; ++w) s += lds[(w * 2 + b) * 256 + cc];
          modp[((size_t)kc * 2 + b) * 12288 + cb * 256 + cc] = s; }
    }
    for (int i = blockIdx.x * NTHR + tid; i < 4096 * 16; i += gridDim.x * NTHR) {
        const int pos = i >> 4, f = i & 15;
        const double inv = pow(500000.0, -(double)f / 16.0);
        const double ang = (double)pos * inv;
        rope[i] = (float)cos(ang); rope[65536 + i] = (float)sin(ang);
    }
    { bf16_t* winb = (bf16_t*)(p.ws + WS_WINB); bf16_t* wob = (bf16_t*)(p.ws + WS_WOB);
      const size_t n1 = (size_t)D * DIN / 8, n2 = (size_t)D * D / 8;
      for (size_t i = (size_t)blockIdx.x * NTHR + tid; i < n1 + n2; i += (size_t)gridDim.x * NTHR) {
          const float* src = i < n1 ? p.w_in + i * 8 : p.w_o + (i - n1) * 8; bf16_t* dst = i < n1 ? winb + i * 8 : wob + (i - n1) * 8;
          const f32x4 a = *(const f32x4*)src, b = *(const f32x4*)(src + 4);
          uint4 o; o.x = pk2(a[0], a[1]); o.y = pk2(a[2], a[3]); o.z = pk2(b[0], b[1]); o.w = pk2(b[2], b[3]);
          *(uint4*)dst = o; } }
    { bf16_t* wrt = (bf16_t*)(p.ws + WS_WRT);
      for (int i = blockIdx.x * NTHR + tid; i < 2048 * 32; i += gridDim.x * NTHR) {
          const int k = i >> 5, e = i & 31; const float w = p.w_router[i];
          const bf16_t hi = f2bf(w); const bf16_t lo = f2bf(w - bf2f(hi));
          wrt[e * 2048 + k] = hi; wrt[65536 + e * 2048 + k] = lo; } }
    for (int u = blockIdx.x; u < 32; u += gridDim.x) {
        const int kv = u >> 4, rs = u & 15;
        const float* w1 = kv ? p.w_cv1 : p.w_ck1; const float* pe = kv ? p.pe_v : p.pe_k;
        const int j = tid & 255, half = tid >> 8;
        float s = 0.f;
        for (int r = rs * 256 + half * 128; r < rs * 256 + half * 128 + 128; ++r) s = fmaf(pe[r], w1[(size_t)r * 256 + j], s);
        __syncthreads();
        lds[tid] = s;
        __syncthreads();
        if (tid < 256) pebp[(kv * 16 + rs) * 256 + tid] = lds[tid] + lds[tid + 256];
    }
}

__device__ __forceinline__ void ph1(const Params& p, float* lds) {
    const int tid = threadIdx.x, lane = tid & 63, wave = tid >> 6;
    const float* modp = (const float*)(p.ws + WS_MODP);
    float* mod = (float*)(p.ws + WS_MOD);
    bf16_t* H = (bf16_t*)(p.ws + WS_H);
    for (int i = blockIdx.x * NTHR + tid; i < 2 * 12288; i += gridDim.x * NTHR) {
        const int b = i / 12288, col = i % 12288;
        float v = p.b_ada[col];
#pragma unroll
        for (int kc = 0; kc < 8; ++kc) v += modp[((size_t)kc * 2 + b) * 12288 + col];
        mod[i] = v;
    }
    const int rpb = (((NTOK + (int)gridDim.x - 1) / (int)gridDim.x) + 7) & ~7;
    int cached_b = -1;
    for (int r0 = blockIdx.x * rpb; r0 < min(NTOK, (int)(blockIdx.x + 1) * rpb); r0 += 8) {
        const int row = r0 + wave;
        const int bb = r0 / T;
        if (bb != cached_b) {
            __syncthreads();
            for (int i = tid; i < 4096; i += NTHR) { const int seg = i >> 11, jx = i & 2047, col = seg * 2048 + jx;
                float v = p.b_ada[col];
#pragma unroll
                for (int kc = 0; kc < 8; ++kc) v += modp[((size_t)kc * 2 + bb) * 12288 + col];
                lds[i] = v; }
            __syncthreads();
            cached_b = bb;
        }
        if (row >= NTOK) continue;
        const f32x4* xr = (const f32x4*)(p.x + (size_t)row * D) + lane;
        f32x4 v[8]; float s = 0.f;
#pragma unroll
        for (int j2 = 0; j2 < 8; ++j2) { v[j2] = xr[64 * j2]; s += (v[j2][0] + v[j2][1]) + (v[j2][2] + v[j2][3]); }
        const float mean = wave_sum(s) * (1.f / D); float s2 = 0.f;
#pragma unroll
        for (int j2 = 0; j2 < 8; ++j2) { v[j2] = v[j2] - mean; s2 += (v[j2][0] * v[j2][0] + v[j2][1] * v[j2][1]) + (v[j2][2] * v[j2][2] + v[j2][3] * v[j2][3]); }
        const float rstd = 1.f / sqrtf(wave_sum(s2) * (1.f / D) + LN_EPS);
        unsigned long long* o8 = (unsigned long long*)(H + (size_t)row * D) + lane;
#pragma unroll
        for (int j2 = 0; j2 < 8; ++j2) {
            const int c0 = 256 * j2 + lane * 4;
            const f32x4 sh = *(const f32x4*)(lds + c0), sc = *(const f32x4*)(lds + 2048 + c0);
            const f32x4 y = v[j2] * rstd * (1.f + sc) + sh;
            o8[64 * j2] = (unsigned long long)pk2(y[0], y[1]) | ((unsigned long long)pk2(y[2], y[3]) << 32);
        }
    }
}


__device__ __forceinline__ void ph9(const Params& p, float* lds) {
    const float* X1 = (const float*)(p.ws + WS_X1);
    const float* mod = (const float*)(p.ws + WS_MOD);
    const bf16_t* YP = (const bf16_t*)(p.ws + WS_YP);
    const int tid = threadIdx.x, lane = tid & 63, wave = tid >> 6;
    for (int row = blockIdx.x * 8 + wave; row < NTOK; row += gridDim.x * 8) {
        const int b = row / T;
        f32x4 v[8]; float s = 0.f;
#pragma unroll
        for (int j = 0; j < 8; ++j) { const int c0 = 256 * j + lane * 4;
            f32x4 y = {0.f, 0.f, 0.f, 0.f};
#pragma unroll
            for (int k = 0; k < 4; ++k) { const unsigned long long w = *(const unsigned long long*)(YP + ((size_t)row * 4 + k) * D + c0);
                y[0] += bf2f((bf16_t)(w & 0xffff)); y[1] += bf2f((bf16_t)((w >> 16) & 0xffff)); y[2] += bf2f((bf16_t)((w >> 32) & 0xffff)); y[3] += bf2f((bf16_t)(w >> 48)); }
            const f32x4 g2 = *(const f32x4*)(mod + b * 12288 + 5 * 2048 + c0);
            v[j] = DN_ALPHA * *(const f32x4*)(X1 + (size_t)row * D + c0) + (1.f + g2) * y;
            s += (v[j][0] + v[j][1]) + (v[j][2] + v[j][3]); }
        const float mean = wave_sum(s) * (1.f / D); float s2 = 0.f;
#pragma unroll
        for (int j = 0; j < 8; ++j) { v[j] = v[j] - mean; s2 += (v[j][0] * v[j][0] + v[j][1] * v[j][1]) + (v[j][2] * v[j][2] + v[j][3] * v[j][3]); }
        const float rstd = 1.f / sqrtf(wave_sum(s2) * (1.f / D) + LN_EPS);
        const float pscale = 1.f;
#pragma unroll
        for (int j = 0; j < 8; ++j) { const int c0 = 256 * j + lane * 4;
            *(f32x4*)(p.out + (size_t)row * D + c0) = pscale * (v[j] * rstd * *(const f32x4*)(p.ln2_g + c0) + *(const f32x4*)(p.ln2_b + c0)); }
    }
}


typedef short bf16x8 __attribute__((ext_vector_type(8)));
typedef short s16x4 __attribute__((ext_vector_type(4)));
typedef unsigned u32x4 __attribute__((ext_vector_type(4)));
typedef unsigned u32x2 __attribute__((ext_vector_type(2)));
typedef LAS unsigned char* ldsp_t;
__device__ __forceinline__ unsigned cvt_pk_bf16(float lo, float hi) { unsigned r; asm volatile("v_cvt_pk_bf16_f32 %0, %1, %2" : "=v"(r) : "v"(lo), "v"(hi)); return r; }
constexpr int GT_A_BYTES = 256 * 128, GT_B_BYTES = 64 * 256;
constexpr int GT_A0 = 0, GT_A1 = GT_A_BYTES, GT_B0 = 2 * GT_A_BYTES, GT_B1 = 2 * GT_A_BYTES + GT_B_BYTES, GT_LDS = 2 * GT_A_BYTES + 2 * GT_B_BYTES;

struct TileSrc {
    const bf16_t* arow[4];
    const float* bcol;
    int SA;
    int ldb;
    int nkt;
    bool bvalid;
};

__device__ __forceinline__ void gemm_tile(ldsp_t lds, const TileSrc& s, f32x4 (&acc)[4][4]) {
    const int tid = threadIdx.x, lane = tid & 63, wave = __builtin_amdgcn_readfirstlane(tid >> 6);
    const int wm0 = (wave >> 1) * 64, wn = wave & 1;
    const int rA = tid >> 3, chA = tid & 7;
    const unsigned wA = (unsigned)(rA * 128 + ((chA ^ (rA & 7)) << 4));
    const int kB = tid >> 5, cB = (tid & 31) * 4;
    const int sB = (kB & 3) | (((kB >> 3) & 1) << 2);
    const unsigned wB = (unsigned)(kB * 256 + (((cB >> 4) ^ sB) << 5) + (cB & 15) * 2);
    const int r = lane & 15, g = lane >> 4;
    const unsigned aR0 = (unsigned)((wm0 + r) * 128 + (((g) ^ (r & 7)) << 4));
    const unsigned aR1 = (unsigned)((wm0 + r) * 128 + (((4 + g) ^ (r & 7)) << 4));
    const int q = r >> 2, pp = r & 3, sR = q | ((g & 1) << 2);
    unsigned bR[4];
#pragma unroll
    for (int ni = 0; ni < 4; ++ni) bR[ni] = (unsigned)((8 * g + q) * 256 + (((wn * 4 + ni) ^ sR) << 5) + 8 * pp);
#pragma unroll
    for (int mi = 0; mi < 4; ++mi)
#pragma unroll
        for (int ni = 0; ni < 4; ++ni) acc[mi][ni] = (f32x4){0.f, 0.f, 0.f, 0.f};
    u32x4 ra[4]; f32x4 rb[4];
    const f32x4 zero4 = {0.f, 0.f, 0.f, 0.f};
#define GT_ISSUE(t) do { const int _k0 = (t) * 64; const int _ao = (_k0 >> 7) * s.SA + (_k0 & 127); \
        _Pragma("unroll") for (int i = 0; i < 4; ++i) ra[i] = *(const u32x4*)(s.arow[i] + _ao); \
        _Pragma("unroll") for (int i = 0; i < 4; ++i) rb[i] = s.bvalid ? *(const f32x4*)(s.bcol + (size_t)(_k0 + kB + 16 * i) * s.ldb) : zero4; } while (0)
#define GT_WRITE(aoff, boff) do { \
        _Pragma("unroll") for (int i = 0; i < 4; ++i) *(LAS u32x4*)(lds + (aoff) + wA + i * 8192) = ra[i]; \
        _Pragma("unroll") for (int i = 0; i < 4; ++i) { u32x2 w; w.x = cvt_pk_bf16(rb[i][0], rb[i][1]); w.y = cvt_pk_bf16(rb[i][2], rb[i][3]); *(LAS u32x2*)(lds + (boff) + wB + i * 4096) = w; } } while (0)
#define GT_COMPUTE(aoff, boff) do { \
        _Pragma("unroll") for (int ks = 0; ks < 2; ++ks) { \
            bf16x8 af[4], bfr[4]; \
            _Pragma("unroll") for (int mi = 0; mi < 4; ++mi) af[mi] = *(const LAS bf16x8*)(lds + (aoff) + (ks ? aR1 : aR0) + mi * 2048); \
            _Pragma("unroll") for (int ni = 0; ni < 4; ++ni) { \
                const s16x4 lo = __builtin_bit_cast(s16x4, __builtin_amdgcn_ds_read_tr16_b64_v4i16((LAS s16x4*)(lds + (boff) + bR[ni] + ks * 8192))); \
                const s16x4 hi = __builtin_bit_cast(s16x4, __builtin_amdgcn_ds_read_tr16_b64_v4i16((LAS s16x4*)(lds + (boff) + bR[ni] + ks * 8192 + 1024))); \
                bfr[ni] = __builtin_shufflevector(lo, hi, 0, 1, 2, 3, 4, 5, 6, 7); } \
            _Pragma("unroll") for (int mi = 0; mi < 4; ++mi) \
                _Pragma("unroll") for (int ni = 0; ni < 4; ++ni) acc[mi][ni] = __builtin_amdgcn_mfma_f32_16x16x32_bf16(bfr[ni], af[mi], acc[mi][ni], 0, 0, 0); } } while (0)
    __syncthreads();
    GT_ISSUE(0); GT_WRITE(GT_A0, GT_B0);
    if (s.nkt > 1) GT_ISSUE(1);
    for (int t = 0; t < s.nkt; t += 2) {
        __syncthreads();
        if (t + 1 < s.nkt) GT_WRITE(GT_A1, GT_B1);
        if (t + 2 < s.nkt) GT_ISSUE(t + 2);
        GT_COMPUTE(GT_A0, GT_B0);
        if (t + 1 < s.nkt) {
            __syncthreads();
            if (t + 2 < s.nkt) GT_WRITE(GT_A0, GT_B0);
            if (t + 3 < s.nkt) GT_ISSUE(t + 3);
            GT_COMPUTE(GT_A1, GT_B1);
        }
    }
#undef GT_ISSUE
#undef GT_WRITE
#undef GT_COMPUTE
}

constexpr int G2_A = 0  , G2_B0 = 49152, G2_B1 = 65536, G2_LDS = 81920;
__device__ __forceinline__ int f4(int x) { return (0x1320 >> (4 * x)) & 3; }
struct TileSrc2 {
    const bf16_t* arow[2];
    const float* bcol;
    int SA, ldb, nkt; bool bvalid;
};
__device__ __forceinline__ void glds16_asm(const void* gsrc, unsigned lds_dst) {
    unsigned keep;
    asm volatile("s_mov_b32 %0, m0\n\ts_mov_b32 m0, %2\n\ts_nop 0\n\tglobal_load_lds_dwordx4 %1, off\n\ts_mov_b32 m0, %0" : "=&s"(keep) : "v"(gsrc), "s"(lds_dst) : "memory");
}
__device__ __forceinline__ void gemm_tile2(ldsp_t lds, const TileSrc2& s, f32x4 (&acc)[8][4], const int nmi) {
    int tid = threadIdx.x; asm volatile("" : "+v"(tid));
    const int lane = tid & 63, wave = __builtin_amdgcn_readfirstlane(tid >> 6);
    const int wm0 = (wave >> 2) * 128, wn = wave & 3;
    const int kB = 2 * (tid >> 6) + ((tid >> 5) & 1), cB = (tid & 31) * 8;
    const int r = lane & 15, g = lane >> 4;
    const unsigned aR = (unsigned)((wm0 + r) * 64 + ((g ^ f4((r >> 2) & 3)) << 4));
    const int q = r >> 2, pp = r & 3, sR = q | ((g & 1) << 2);
    const unsigned bR0 = (unsigned)((8 * g + q) * 512 + (((wn * 4) ^ sR) << 5) + 8 * pp);
    const unsigned wB0 = (unsigned)(kB * 512 + (((cB >> 4) ^ ((kB & 3) | (((kB >> 3) & 1) << 2))) << 5) + (cB & 15) * 2);
#pragma unroll
    for (int mi = 0; mi < 8; ++mi)
#pragma unroll
        for (int ni = 0; ni < 4; ++ni) acc[mi][ni] = (f32x4){0.f, 0.f, 0.f, 0.f};
    f32x4 rb[4]; u32x4 wv[2];
    const f32x4 zero4 = {0.f, 0.f, 0.f, 0.f};
    const unsigned ldsbase = (unsigned)(unsigned long long)lds;
    const unsigned dmaw = ldsbase + G2_A + (unsigned)wave * 1024u;
#define G2_DMA_A(t, stage) do { const int _k0 = (t) * 32; const int _ao = (_k0 >> 7) * s.SA + (_k0 & 127); \
        _Pragma("unroll") for (int i = 0; i < 2; ++i) glds16_asm(s.arow[i] + _ao, dmaw + (unsigned)(stage) * 16384u + i * 8192u); } while (0)
#define G2_ISSUE_B(t) do { const int _k0 = (t) * 32; \
        _Pragma("unroll") for (int i = 0; i < 2; ++i) { const float* _p = s.bcol + (size_t)(_k0 + kB + 16 * i) * s.ldb; rb[2 * i] = *(const f32x4*)_p; rb[2 * i + 1] = *(const f32x4*)(_p + 4); } } while (0)
#define G2_WRITE_B(boff, tt) do { \
        _Pragma("unroll") for (int i = 0; i < 2; ++i) { wv[i].x = cvt_pk_bf16(rb[2 * i][0], rb[2 * i][1]); wv[i].y = cvt_pk_bf16(rb[2 * i][2], rb[2 * i][3]); \
            wv[i].z = cvt_pk_bf16(rb[2 * i + 1][0], rb[2 * i + 1][1]); wv[i].w = cvt_pk_bf16(rb[2 * i + 1][2], rb[2 * i + 1][3]); \
            *(LAS u32x4*)(lds + (boff) + wB0 + i * 8192) = wv[i]; } } while (0)
    const int nkt = s.nkt;
    const int grp = wave >> 2;
    __syncthreads();
    G2_ISSUE_B(0); G2_DMA_A(0, 0); G2_DMA_A(1, 1); G2_WRITE_B(G2_B0, 0); G2_ISSUE_B(1);
    asm volatile("s_waitcnt vmcnt(4)" ::: "memory");
    __syncthreads();
    if (grp) { __builtin_amdgcn_s_barrier(); asm volatile("" ::: "memory"); }
    int st = 0, st2 = 2;
    for (int t = 0; t < nkt; ++t) {
        const int bcur = (t & 1) ? G2_B1 : G2_B0, bnxt = (t & 1) ? G2_B0 : G2_B1;
        bf16x8 bfr[4], af[8];
#pragma unroll
        for (int ni = 0; ni < 4; ++ni) {
            const s16x4 lo = __builtin_bit_cast(s16x4, __builtin_amdgcn_ds_read_tr16_b64_v4i16((LAS s16x4*)(lds + bcur + (bR0 ^ (ni << 5)))));
            const s16x4 hi = __builtin_bit_cast(s16x4, __builtin_amdgcn_ds_read_tr16_b64_v4i16((LAS s16x4*)(lds + bcur + (bR0 ^ (ni << 5)) + 2048)));
            bfr[ni] = __builtin_shufflevector(lo, hi, 0, 1, 2, 3, 4, 5, 6, 7); }
#pragma unroll
        for (int mi = 0; mi < 8; ++mi) af[mi] = *(const LAS bf16x8*)(lds + G2_A + st * 16384 + aR + mi * 1024);
        __builtin_amdgcn_sched_barrier(0);
        if (t + 1 < nkt) G2_WRITE_B(bnxt, t + 1);
        if (t + 2 < nkt) { G2_ISSUE_B(t + 2); G2_DMA_A(t + 2, st2); }
        if (t + 2 < nkt) asm volatile("s_waitcnt vmcnt(6) lgkmcnt(0)" ::: "memory"); else asm volatile("s_waitcnt vmcnt(0) lgkmcnt(0)" ::: "memory");
        __builtin_amdgcn_s_barrier(); asm volatile("" ::: "memory");
        __builtin_amdgcn_s_setprio(1);
#pragma unroll
        for (int mi = 0; mi < 8; ++mi) if (mi < nmi) {
#pragma unroll
            for (int ni = 0; ni < 4; ++ni) acc[mi][ni] = __builtin_amdgcn_mfma_f32_16x16x32_bf16(bfr[ni], af[mi], acc[mi][ni], 0, 0, 0); }
        __builtin_amdgcn_s_setprio(0);
        asm volatile("" ::: "memory"); __builtin_amdgcn_s_barrier(); asm volatile("" ::: "memory");
        st = (st == 2) ? 0 : st + 1; st2 = (st2 == 2) ? 0 : st2 + 1;
    }
    if (!grp) { __builtin_amdgcn_s_barrier(); asm volatile("" ::: "memory"); }
#undef G2_DMA_A
#undef G2_ISSUE_B
#undef G2_WRITE_B
#undef G2_COMPUTE
}

struct TileSrc2b { const bf16_t* arow[2]; const bf16_t* brow[2]; int SA, ldb, nkt; };
constexpr int G3_A = 0  , G3_B = 49152  ;
__device__ __forceinline__ void gemm_tile2b(ldsp_t lds, const TileSrc2b& s, f32x4 (&acc)[8][4], const int nmi = 8) {
    int tid = threadIdx.x; asm volatile("" : "+v"(tid));
    const int lane = tid & 63, wave = __builtin_amdgcn_readfirstlane(tid >> 6);
    const int wm0 = (wave >> 2) * 128, wn = wave & 3;
    const int r = lane & 15, g = lane >> 4;
    const unsigned aR = (unsigned)((wm0 + r) * 64 + ((g ^ f4((r >> 2) & 3)) << 4));
    const int q = r >> 2, pp = r & 3, sR = q | ((g & 1) << 2);
    const unsigned bR0 = (unsigned)((8 * g + q) * 512 + (((wn * 4) ^ sR) << 5) + 8 * pp);
#pragma unroll
    for (int mi = 0; mi < 8; ++mi)
#pragma unroll
        for (int ni = 0; ni < 4; ++ni) acc[mi][ni] = (f32x4){0.f, 0.f, 0.f, 0.f};
    const unsigned ldsbase = (unsigned)(unsigned long long)lds;
    const unsigned dmaw = ldsbase + (unsigned)wave * 1024u;
#define G3_DMA(t, stage) do { const int _k0 = (t) * 32; const int _ao = (_k0 >> 7) * s.SA + (_k0 & 127); \
        _Pragma("unroll") for (int i = 0; i < 2; ++i) glds16_asm(s.arow[i] + _ao, dmaw + G3_A + (unsigned)(stage) * 16384u + i * 8192u); \
        _Pragma("unroll") for (int i = 0; i < 2; ++i) glds16_asm(s.brow[i] + (size_t)_k0 * s.ldb, dmaw + G3_B + (unsigned)(stage) * 16384u + i * 8192u); } while (0)
    const int nkt = s.nkt;
    const int grp = wave >> 2;
    __syncthreads();
    G3_DMA(0, 0); G3_DMA(1, 1);
    asm volatile("s_waitcnt vmcnt(4)" ::: "memory");
    __syncthreads();
    if (grp) { __builtin_amdgcn_s_barrier(); asm volatile("" ::: "memory"); }
    int st = 0, st2 = 2;
    for (int t = 0; t < nkt; ++t) {
        if (t + 2 < nkt) G3_DMA(t + 2, st2);
        bf16x8 bfr[4], af[8];
#pragma unroll
        for (int ni = 0; ni < 4; ++ni) {
            const s16x4 lo = __builtin_bit_cast(s16x4, __builtin_amdgcn_ds_read_tr16_b64_v4i16((LAS s16x4*)(lds + G3_B + st * 16384 + (bR0 ^ (ni << 5)))));
            const s16x4 hi = __builtin_bit_cast(s16x4, __builtin_amdgcn_ds_read_tr16_b64_v4i16((LAS s16x4*)(lds + G3_B + st * 16384 + (bR0 ^ (ni << 5)) + 2048)));
            bfr[ni] = __builtin_shufflevector(lo, hi, 0, 1, 2, 3, 4, 5, 6, 7); }
#pragma unroll
        for (int mi = 0; mi < 8; ++mi) af[mi] = *(const LAS bf16x8*)(lds + G3_A + st * 16384 + aR + mi * 1024);
        if (t + 2 < nkt) asm volatile("s_waitcnt vmcnt(4) lgkmcnt(0)" ::: "memory"); else asm volatile("s_waitcnt vmcnt(0) lgkmcnt(0)" ::: "memory");
        __builtin_amdgcn_s_barrier(); asm volatile("" ::: "memory");
        __builtin_amdgcn_s_setprio(1);
#pragma unroll
        for (int mi = 0; mi < 8; ++mi) if (mi < nmi) {
#pragma unroll
            for (int ni = 0; ni < 4; ++ni) acc[mi][ni] = __builtin_amdgcn_mfma_f32_16x16x32_bf16(bfr[ni], af[mi], acc[mi][ni], 0, 0, 0); }
        __builtin_amdgcn_s_setprio(0);
        asm volatile("" ::: "memory"); __builtin_amdgcn_s_barrier(); asm volatile("" ::: "memory");
        st = (st == 2) ? 0 : st + 1; st2 = (st2 == 2) ? 0 : st2 + 1;
    }
    if (!grp) { __builtin_amdgcn_s_barrier(); asm volatile("" ::: "memory"); }
#undef G3_DMA
}
__device__ __forceinline__ void b_src_setup(TileSrc2b& s, const bf16_t* Bbase, int ldb, int n0, int ncols, int tid) {
    const int lane = tid & 63, wave = tid >> 6;
#pragma unroll
    for (int j = 0; j < 2; ++j) {
        const int k = 2 * (8 * j + wave) + (lane >> 5), slot = lane & 31;
        const int piece = (((slot >> 1) ^ ((k & 3) | (((k >> 3) & 1) << 2))) << 1) | (slot & 1);
        int col = n0 + piece * 8; if (col > ncols - 8) col = ncols - 8;
        s.brow[j] = Bbase + (size_t)k * ldb + col;
    }
}

__device__ __forceinline__ int vcu_of_block() { const int G = gridDim.x, bx = blockIdx.x; return (G % 8 == 0) ? (bx % 8) * (G / 8) + bx / 8 : bx; }


__device__ __forceinline__ void moe_offsets256(const Params& p, LAS int* li) {
    const unsigned* ctl = (const unsigned*)(p.ws + WS_CTL);
    __syncthreads();
    if (threadIdx.x < 32) li[threadIdx.x] = (int)__hip_atomic_load(ctl + CW_CNT + 64 * threadIdx.x, __ATOMIC_RELAXED, __HIP_MEMORY_SCOPE_AGENT);
    __syncthreads();
    if (threadIdx.x == 0) { int o = 0, tt = 0; for (int e = 0; e < 32; ++e) { li[32 + e] = o; li[72 + e] = tt; o += li[e]; tt += (li[e] + 255) / 256; } li[64] = o; li[104] = tt; }
    __syncthreads();
}


constexpr int NA_KV = 32768;
constexpr int NA_PBH = 65536;
constexpr int NA_SELM = NA_PBH + 32768;
constexpr float NA_C = 0.08838834764831845f * 1.4426950408889634f;

struct NaTile { const bf16_t* k; const bf16_t* v; };
#define NA_ISSUE(tile, rs) do { _Pragma("unroll") for (int i = 0; i < 2; ++i) { const size_t _o = (size_t)((tid >> 4) + 32 * i) * (rs) + (tid & 15) * 8; \
        rk[i] = *(const u32x4*)((tile).k + _o); rv[i] = *(const u32x4*)((tile).v + _o); } } while (0)
#define NA_WRITE(buf) do { _Pragma("unroll") for (int i = 0; i < 2; ++i) { const int _key = (tid >> 4) + 32 * i, _ch = tid & 15; \
        *(LAS u32x4*)(lds + (buf) * NA_KV + _key * 256 + ((_ch ^ (_key & 15)) << 4)) = rk[i]; \
        *(LAS u32x4*)(lds + (buf) * NA_KV + 16384 + _key * 256 + (((_ch >> 1) ^ (_key & 7)) << 5) + (_ch & 1) * 16) = rv[i]; } } while (0)

__device__ __forceinline__ void na_tile(ldsp_t img, const bf16x8 (&qf)[4], const unsigned (&kR)[4], unsigned vB, int sv, int g,
                                        float& m, float& l, f32x4 (&o)[8], bool need_mask, int key0, int lo, int hi, f32x4 (&p)[4], float& alpha_out) {
    f32x4 sc[4];
#pragma unroll
    for (int kt = 0; kt < 4; ++kt) { sc[kt] = (f32x4){0.f, 0.f, 0.f, 0.f};
#pragma unroll
        for (int ks = 0; ks < 4; ++ks) { const bf16x8 kf = *(const LAS bf16x8*)(img + kt * 4096 + kR[ks]); sc[kt] = __builtin_amdgcn_mfma_f32_16x16x32_bf16(kf, qf[ks], sc[kt], 0, 0, 0); } }
    float mx = -INFINITY;
#pragma unroll
    for (int kt = 0; kt < 4; ++kt)
#pragma unroll
        for (int i = 0; i < 4; ++i) { float v = sc[kt][i] * NA_C; if (need_mask) { const int key = key0 + 16 * kt + 4 * g + i; v = (key >= lo && key <= hi) ? v : -INFINITY; } sc[kt][i] = v; mx = fmaxf(mx, v); }
    mx = fmaxf(mx, __shfl_xor(mx, 16)); mx = fmaxf(mx, __shfl_xor(mx, 32));
    const float mn = fmaxf(m, mx), mu = (mn == -INFINITY) ? 0.f : mn;
    const float alpha = __builtin_amdgcn_exp2f(m - mu);
    float ls = 0.f;
#pragma unroll
    for (int kt = 0; kt < 4; ++kt)
#pragma unroll
        for (int i = 0; i < 4; ++i) { const float e = __builtin_amdgcn_exp2f(sc[kt][i] - mu); p[kt][i] = e; ls += e; }
    l = l * alpha + ls; m = mn; alpha_out = alpha;
    if (!__all(alpha == 1.f)) {
#pragma unroll
        for (int dt = 0; dt < 8; ++dt) o[dt] = o[dt] * alpha;
    }
    bf16x8 pf[2];
#pragma unroll
    for (int kk = 0; kk < 2; ++kk) { u32x4 w; w.x = cvt_pk_bf16(p[2 * kk][0], p[2 * kk][1]); w.y = cvt_pk_bf16(p[2 * kk][2], p[2 * kk][3]);
        w.z = cvt_pk_bf16(p[2 * kk + 1][0], p[2 * kk + 1][1]); w.w = cvt_pk_bf16(p[2 * kk + 1][2], p[2 * kk + 1][3]); pf[kk] = __builtin_bit_cast(bf16x8, w); }
#pragma unroll
    for (int dt = 0; dt < 8; ++dt) {
        const unsigned va = 16384u + vB + (unsigned)((dt ^ sv) << 5);
#pragma unroll
        for (int kk = 0; kk < 2; ++kk) {
            const s16x4 lo4 = __builtin_bit_cast(s16x4, __builtin_amdgcn_ds_read_tr16_b64_v4i16((LAS s16x4*)(img + va + kk * 8192)));
            const s16x4 hi4 = __builtin_bit_cast(s16x4, __builtin_amdgcn_ds_read_tr16_b64_v4i16((LAS s16x4*)(img + va + kk * 8192 + 4096)));
            const bf16x8 vf = __builtin_shufflevector(lo4, hi4, 0, 1, 2, 3, 4, 5, 6, 7);
            o[dt] = __builtin_amdgcn_mfma_f32_16x16x32_bf16(vf, pf[kk], o[dt], 0, 0, 0);
        }
    }
}

__device__ __forceinline__ void nsa_unit(const Params& p, ldsp_t lds, int u) {
    const bf16_t* PROJ = (const bf16_t*)(p.ws + WS_PROJ);
    const bf16_t* KC = (const bf16_t*)(p.ws + WS_KC);
    const bf16_t* VC = (const bf16_t*)(p.ws + WS_VC);
    bf16_t* MIXIN = (bf16_t*)(p.ws + WS_MIXIN);
    const int tid = threadIdx.x, lane = tid & 63, wave = __builtin_amdgcn_readfirstlane(tid >> 6);
    const int tb = 127 - (u >> 2), b = (u >> 1) & 1, grp = u & 1;
    const int t0 = 32 * tb, cur = t0 >> 6;
    const int hh = wave >> 1, th = wave & 1, qi = lane & 15, g = lane >> 4;
    const int tq = t0 + 16 * th + qi;
    const size_t rowq = (size_t)b * T + tq;
    const int head = grp * 4 + hh;
    bf16x8 qf[4];
#pragma unroll
    for (int ks = 0; ks < 4; ++ks) qf[ks] = *(const bf16x8*)(PROJ + rowq * DIN + C_NQ + head * 128 + 32 * ks + 8 * g);
    const float g0 = sigmoid_f(bf2f(PROJ[rowq * DIN + C_NGT + head * 3 + 0])), g1 = sigmoid_f(bf2f(PROJ[rowq * DIN + C_NGT + head * 3 + 1])), g2 = sigmoid_f(bf2f(PROJ[rowq * DIN + C_NGT + head * 3 + 2]));
    unsigned kR[4];
#pragma unroll
    for (int ks = 0; ks < 4; ++ks) kR[ks] = (unsigned)(qi * 256 + (((4 * ks + g) ^ qi) << 4));
    const int qq = qi >> 2, pp = qi & 3;
    const unsigned vB = (unsigned)((4 * g + qq) * 256 + 8 * pp);
    const int sv = ((4 * g + qq) & 7);
    u32x4 rk[2], rv[2];
    f32x4 o[8], outacc[8], pt[4];
    float m, l, alpha;
    const int nvis_q = tq >= 31 ? (tq - 31) / 16 + 1 : 0;
    const int nvis_max = t0 / 16 + 1;
    const int ntl = (min(nvis_max, NCMP) + 63) >> 6;
    float pb[17];
#pragma unroll
    for (int i = 0; i < 17; ++i) pb[i] = 0.f;
#pragma unroll
    for (int dt = 0; dt < 8; ++dt) o[dt] = (f32x4){0.f, 0.f, 0.f, 0.f};
    m = -INFINITY; l = 0.f;
    const bf16_t* kc0 = KC + ((size_t)b * 256 * 2 + grp) * 128; const bf16_t* vc0 = VC + ((size_t)b * 256 * 2 + grp) * 128;
    __syncthreads();
    { NaTile t0_{kc0, vc0}; NA_ISSUE(t0_, 256); NA_WRITE(0); if (ntl > 1) { NaTile t1_{kc0 + 64 * 256, vc0 + 64 * 256}; NA_ISSUE(t1_, 256); } }
#pragma unroll
    for (int tl = 0; tl < 4; ++tl) {
        if (tl < ntl) {
            __syncthreads();
            if (tl + 1 < ntl) NA_WRITE((tl + 1) & 1);
            if (tl + 2 < ntl) { NaTile t2_{kc0 + (size_t)(tl + 2) * 64 * 256, vc0 + (size_t)(tl + 2) * 64 * 256}; NA_ISSUE(t2_, 256); }
            na_tile(lds + (tl & 1) * NA_KV, qf, kR, vB, sv, g, m, l, o, true, 64 * tl, 0, nvis_q - 1, pt, alpha);
#pragma unroll
            for (int i = 0; i < 17; ++i) pb[i] *= alpha;
#pragma unroll
            for (int kt = 0; kt < 4; ++kt) {
                const float s4 = (pt[kt][0] + pt[kt][1]) + (pt[kt][2] + pt[kt][3]);
                const float recv = __shfl(pt[kt][3], (lane + 48) & 63);
                pb[tl * 4 + kt] += s4 + (g >= 1 ? recv : 0.f);
                pb[tl * 4 + kt + 1] += (g == 0 ? recv : 0.f);
            }
        }
    }
    {
        float lr = l; lr += __shfl_xor(lr, 16); lr += __shfl_xor(lr, 32);
        const float inv = lr > 0.f ? 1.f / lr : 0.f;
#pragma unroll
        for (int dt = 0; dt < 8; ++dt) outacc[dt] = o[dt] * (inv * g0);
        LAS float* pbh = (LAS float*)(lds + NA_PBH) + (hh * 32 + 16 * th + qi) * 64;
#pragma unroll
        for (int i = 0; i < 16; ++i) pbh[4 * i + g] = pb[i] * inv;
    }
    __syncthreads();
    {
        const LAS float* pball = (const LAS float*)(lds + NA_PBH);
        LAS unsigned long long* selm = (LAS unsigned long long*)(lds + NA_SELM);
#pragma unroll 1
        for (int tt = 0; tt < 4; ++tt) {
            const int tok = 4 * wave + tt;
            const float v = (pball[(0 * 32 + tok) * 64 + lane] + pball[(1 * 32 + tok) * 64 + lane]) + (pball[(2 * 32 + tok) * 64 + lane] + pball[(3 * 32 + tok) * 64 + lane]);
            const bool forced = (lane == 0) || (lane == cur) || (lane == cur - 1);
            const float score = forced ? INFINITY : (lane <= cur ? v : -INFINITY);
            int rank = 0;
            for (int i = 0; i < 64; ++i) { const float w = __shfl(score, i); rank += (w > score || (w == score && i < lane)) ? 1 : 0; }
            const unsigned long long mk = __ballot(rank < 16);
            if (lane == 0) selm[tok] = mk;
        }
    }
    __syncthreads();
    const unsigned long long mysel = ((const LAS unsigned long long*)(lds + NA_SELM))[16 * th + qi];
    {
#pragma unroll
        for (int dt = 0; dt < 8; ++dt) o[dt] = (f32x4){0.f, 0.f, 0.f, 0.f};
        m = -INFINITY; l = 0.f;
        const bf16_t* kb = PROJ + (size_t)b * T * DIN + C_KSL + grp * 128; const bf16_t* vb = PROJ + (size_t)b * T * DIN + C_VSL + grp * 128;
        const int n = cur + 1;
        { NaTile a{kb, vb}; NA_ISSUE(a, DIN); NA_WRITE(0); if (n > 1) { NaTile c{kb + (size_t)64 * DIN, vb + (size_t)64 * DIN}; NA_ISSUE(c, DIN); } }
        for (int j = 0; j < n; ++j) {
            __syncthreads();
            if (j + 1 < n) NA_WRITE((j + 1) & 1);
            if (j + 2 < n) { NaTile c{kb + (size_t)(j + 2) * 64 * DIN, vb + (size_t)(j + 2) * 64 * DIN}; NA_ISSUE(c, DIN); }
            const bool sel = (mysel >> j) & 1ull;
            na_tile(lds + (j & 1) * NA_KV, qf, kR, vB, sv, g, m, l, o, true, 64 * j, 0, sel ? tq : -1, pt, alpha);
        }
        float lr = l; lr += __shfl_xor(lr, 16); lr += __shfl_xor(lr, 32);
        const float inv = g1 / lr;
#pragma unroll
        for (int dt = 0; dt < 8; ++dt) outacc[dt] += o[dt] * inv;
    }
    {
#pragma unroll
        for (int dt = 0; dt < 8; ++dt) o[dt] = (f32x4){0.f, 0.f, 0.f, 0.f};
        m = -INFINITY; l = 0.f;
        const bf16_t* kb = PROJ + (size_t)b * T * DIN + C_KWN + grp * 128; const bf16_t* vb = PROJ + (size_t)b * T * DIN + C_VWN + grp * 128;
        const int kb_lo = max(0, t0 - 511) >> 6, n = cur - kb_lo + 1;
        __syncthreads();
        { NaTile a{kb + (size_t)kb_lo * 64 * DIN, vb + (size_t)kb_lo * 64 * DIN}; NA_ISSUE(a, DIN); NA_WRITE(0);
          if (n > 1) { NaTile c{kb + (size_t)(kb_lo + 1) * 64 * DIN, vb + (size_t)(kb_lo + 1) * 64 * DIN}; NA_ISSUE(c, DIN); } }
        for (int j = 0; j < n; ++j) {
            __syncthreads();
            if (j + 1 < n) NA_WRITE((j + 1) & 1);
            if (j + 2 < n) { NaTile c{kb + (size_t)(kb_lo + j + 2) * 64 * DIN, vb + (size_t)(kb_lo + j + 2) * 64 * DIN}; NA_ISSUE(c, DIN); }
            const int key0 = 64 * (kb_lo + j);
            const bool need = (key0 + 63 > t0) || (key0 < t0 + 31 - 511);
            na_tile(lds + (j & 1) * NA_KV, qf, kR, vB, sv, g, m, l, o, need, key0, tq - 511, tq, pt, alpha);
        }
        float lr = l; lr += __shfl_xor(lr, 16); lr += __shfl_xor(lr, 32);
        const float inv = g2 / lr;
#pragma unroll
        for (int dt = 0; dt < 8; ++dt) outacc[dt] += o[dt] * inv;
    }
#pragma unroll
    for (int dt = 0; dt < 8; ++dt) { u32x2 w; w.x = cvt_pk_bf16(outacc[dt][0], outacc[dt][1]); w.y = cvt_pk_bf16(outacc[dt][2], outacc[dt][3]);
        *(u32x2*)(MIXIN + rowq * D + 1024 + head * 128 + 16 * dt + 4 * g) = w; }
}


__device__ __forceinline__ int sfun(int row) { return (row & 3) | (((row >> 3) & 1) << 2); }
__device__ __forceinline__ bf16x8 tr_frag(ldsp_t a, int rs4) {
    const s16x4 lo = __builtin_bit_cast(s16x4, __builtin_amdgcn_ds_read_tr16_b64_v4i16((LAS s16x4*)a));
    const s16x4 hi = __builtin_bit_cast(s16x4, __builtin_amdgcn_ds_read_tr16_b64_v4i16((LAS s16x4*)(a + rs4)));
    return __builtin_shufflevector(lo, hi, 0, 1, 2, 3, 4, 5, 6, 7);
}
__device__ __forceinline__ void gla_stage_v(ldsp_t vimg, const bf16_t* PROJ, size_t row0, int col0) {
    const int tid = threadIdx.x;
#pragma unroll
    for (int i = 0; i < 4; ++i) { const int idx = tid + 512 * i, sr = idx >> 5, ch = idx & 31;
        const u32x4 w = *(const u32x4*)(PROJ + (row0 + sr) * DIN + col0 + ch * 8);
        *(LAS u32x4*)(vimg + sr * 512 + (((ch >> 1) ^ sfun(sr)) << 5) + (ch & 1) * 16) = w; }
}

__device__ __forceinline__ void gla_a_unit(const Params& p, ldsp_t lds, int u) {
    const bf16_t* PROJ = (const bf16_t*)(p.ws + WS_PROJ);
    float* BC = (float*)(p.ws + WS_BC); float* U = (float*)(p.ws + WS_U); float* DTOT = (float*)(p.ws + WS_DTOT);
    const int tid = threadIdx.x, lane = tid & 63, wave = __builtin_amdgcn_readfirstlane(tid >> 6);
    const int b = u >> 6, h = (u >> 4) & 3, sc = u & 15;
    const size_t row0 = (size_t)b * T + sc * 256;
    LAS float* glr = (LAS float*)lds;
    LAS float* tot = (LAS float*)(lds + 16384);
    ldsp_t kimg = lds + 20480;
    ldsp_t vimg = lds + 86016;
    __syncthreads();
#pragma unroll
    for (int i = 0; i < 8; ++i) { const int idx = tid + 512 * i; glr[idx] = bf2f(PROJ[(row0 + (idx >> 4)) * DIN + C_GLR + (idx & 15)]); }
    __syncthreads();
    const int d = tid & 127, c = tid >> 7, hd = h * 128 + d;
    float w[16];
#pragma unroll
    for (int r = 0; r < 16; ++r) w[r] = p.w_gk[r * 512 + hd];
    const float bias = p.b_gk[hd];
    float cum = 0.f;
    for (int sl = 0; sl < 64; ++sl) {
        const int sr = 64 * c + sl; float x = bias;
#pragma unroll
        for (int r4 = 0; r4 < 4; ++r4) { const f32x4 gv = *(const LAS f32x4*)(glr + sr * 16 + r4 * 4); x = fmaf(gv[0], w[4 * r4], x); x = fmaf(gv[1], w[4 * r4 + 1], x); x = fmaf(gv[2], w[4 * r4 + 2], x); x = fmaf(gv[3], w[4 * r4 + 3], x); }
        cum += logsigmoid_f(x) * (1.f / 16.f);
        BC[(row0 + sr) * 512 + hd] = cum;
    }
    tot[c * 128 + d] = cum;
    __syncthreads();
    float suffix = 0.f;
    for (int c2 = c + 1; c2 < 4; ++c2) suffix += tot[c2 * 128 + d];
    if (c == 0) DTOT[(size_t)u * 128 + d] = __expf(cum + suffix);
    for (int sl = 0; sl < 64; ++sl) {
        const int sr = 64 * c + sl;
        const float bcs = BC[(row0 + sr) * 512 + hd];
        const float kv = bf2f(PROJ[(row0 + sr) * DIN + C_GK + hd]) * __expf((cum - bcs) + suffix);
        *(LAS bf16_t*)(kimg + sr * 256 + (((d >> 4) ^ sfun(sr)) << 5) + (d & 15) * 2) = f2bf(kv);
    }
    const int e0 = (wave >> 1) * 64, d0 = (wave & 1) * 64;
    const int g = lane >> 4, qq = (lane & 15) >> 2, pp = lane & 3, sR = qq | ((g & 1) << 2);
    f32x4 acc[4][4];
#pragma unroll
    for (int a = 0; a < 4; ++a)
#pragma unroll
        for (int bb = 0; bb < 4; ++bb) acc[a][bb] = (f32x4){0.f, 0.f, 0.f, 0.f};
    for (int cc = 0; cc < 4; ++cc) {
        __syncthreads();
        gla_stage_v(vimg, PROJ, row0 + 64 * cc, C_GV + h * 256);
        __syncthreads();
#pragma unroll
        for (int ks = 0; ks < 2; ++ks) {
            bf16x8 vf[4], kf[4];
            const int rl = 32 * ks + 8 * g + qq;
#pragma unroll
            for (int et = 0; et < 4; ++et) vf[et] = tr_frag(vimg + rl * 512 + ((((e0 >> 4) + et) ^ sR) << 5) + 8 * pp, 2048);
#pragma unroll
            for (int dt = 0; dt < 4; ++dt) kf[dt] = tr_frag(kimg + (64 * cc + rl) * 256 + ((((d0 >> 4) + dt) ^ sR) << 5) + 8 * pp, 1024);
#pragma unroll
            for (int et = 0; et < 4; ++et)
#pragma unroll
                for (int dt = 0; dt < 4; ++dt) acc[et][dt] = __builtin_amdgcn_mfma_f32_16x16x32_bf16(vf[et], kf[dt], acc[et][dt], 0, 0, 0);
        }
    }
    float* Uu = U + (size_t)u * 128 * 256;
#pragma unroll
    for (int et = 0; et < 4; ++et)
#pragma unroll
        for (int dt = 0; dt < 4; ++dt) *(f32x4*)(Uu + (size_t)(d0 + 16 * dt + (lane & 15)) * 256 + e0 + 16 * et + 4 * g) = acc[et][dt];
}

__device__ __forceinline__ void gla_c_unit(const Params& p, ldsp_t lds, int u) {
    const bf16_t* PROJ = (const bf16_t*)(p.ws + WS_PROJ);
    const float* BC = (const float*)(p.ws + WS_BC); const float* U = (const float*)(p.ws + WS_U); const float* DTOT = (const float*)(p.ws + WS_DTOT);
    bf16_t* MIXIN = (bf16_t*)(p.ws + WS_MIXIN);
    const int tid = threadIdx.x, lane = tid & 63, wave = __builtin_amdgcn_readfirstlane(tid >> 6);
    const int b = u >> 6, h = (u >> 4) & 3, sc = u & 15;
    const size_t row0 = (size_t)b * T + sc * 256;
    ldsp_t simg = lds;
    ldsp_t vimg = lds + 65536;
    ldsp_t qimg = lds + 98304;
    ldsp_t kimg = lds + 114688;
    ldsp_t aimg = lds + 131072;
    LAS float* ssq = (LAS float*)(lds + 139264);
    LAS float* blast = (LAS float*)(lds + 141312);
    const int g = lane >> 4, li = lane & 15, qq = li >> 2, pp = li & 3, sR = qq | ((g & 1) << 2);
    const int e0 = (wave >> 1) * 64, d0 = (wave & 1) * 64;
    f32x4 S[4][4];
#pragma unroll
    for (int a = 0; a < 4; ++a)
#pragma unroll
        for (int bb = 0; bb < 4; ++bb) S[a][bb] = (f32x4){0.f, 0.f, 0.f, 0.f};
    for (int j = 0; j < sc; ++j) {
        const float* Uj = U + (size_t)(u - sc + j) * 128 * 256; const float* Dj = DTOT + (size_t)(u - sc + j) * 128;
#pragma unroll
        for (int dt = 0; dt < 4; ++dt) { const int dd = d0 + 16 * dt + li; const float dj = Dj[dd];
#pragma unroll
            for (int et = 0; et < 4; ++et) S[et][dt] = S[et][dt] * dj + *(const f32x4*)(Uj + (size_t)dd * 256 + e0 + 16 * et + 4 * g); }
    }
    const float scale = 0.08838834764831845f;
    for (int cc = 0; cc < 4; ++cc) {
        const size_t rowc = row0 + 64 * cc;
        __syncthreads();
#pragma unroll
        for (int et = 0; et < 4; ++et)
#pragma unroll
            for (int dt = 0; dt < 4; ++dt) { const int dd = d0 + 16 * dt + li, ee = e0 + 16 * et + 4 * g;
                u32x2 w; w.x = cvt_pk_bf16(S[et][dt][0], S[et][dt][1]); w.y = cvt_pk_bf16(S[et][dt][2], S[et][dt][3]);
                *(LAS u32x2*)(simg + dd * 512 + (((ee >> 4) ^ sfun(dd)) << 5) + (ee & 15) * 2) = w; }
        { const int d = tid & 127, tq4 = tid >> 7, hd = h * 128 + d;
#pragma unroll 4
          for (int i = 0; i < 16; ++i) { const int t = 16 * tq4 + i;
              const float bc = BC[(rowc + t) * 512 + hd];
              const float qv = bf2f(PROJ[(rowc + t) * DIN + C_GQ + hd]) * scale * __expf(bc);
              const float kv = bf2f(PROJ[(rowc + t) * DIN + C_GK + hd]) * __expf(-bc);
              *(LAS bf16_t*)(qimg + t * 256 + (((d >> 3) ^ (t & 15)) << 4) + (d & 7) * 2) = f2bf(qv);
              *(LAS bf16_t*)(kimg + t * 256 + (((d >> 4) ^ sfun(t)) << 5) + (d & 15) * 2) = f2bf(kv);
              if (t == 63) blast[d] = bc; } }
        gla_stage_v(vimg, PROJ, rowc, C_GV + h * 256);
        __syncthreads();
        { const int st = wave & 3, tt0 = (wave >> 2) * 2;
          f32x4 at[2] = {(f32x4){0.f, 0.f, 0.f, 0.f}, (f32x4){0.f, 0.f, 0.f, 0.f}};
#pragma unroll
          for (int ks = 0; ks < 4; ++ks) {
              const int rs_ = 16 * st + li, ch = 4 * ks + g;
              const bf16x8 kf = *(const LAS bf16x8*)(kimg + rs_ * 256 + (((ch >> 1) ^ sfun(rs_)) << 5) + (ch & 1) * 16);
#pragma unroll
              for (int k2 = 0; k2 < 2; ++k2) { const int rt = 16 * (tt0 + k2) + li;
                  const bf16x8 qf = *(const LAS bf16x8*)(qimg + rt * 256 + ((ch ^ (rt & 15)) << 4));
                  at[k2] = __builtin_amdgcn_mfma_f32_16x16x32_bf16(kf, qf, at[k2], 0, 0, 0); } }
#pragma unroll
          for (int k2 = 0; k2 < 2; ++k2) { const int t = 16 * (tt0 + k2) + li, s0 = 16 * st + 4 * g;
              float a[4];
#pragma unroll
              for (int i = 0; i < 4; ++i) a[i] = (s0 + i <= t) ? at[k2][i] : 0.f;
              u32x2 w; w.x = cvt_pk_bf16(a[0], a[1]); w.y = cvt_pk_bf16(a[2], a[3]);
              *(LAS u32x2*)(aimg + t * 128 + (((s0 >> 3) ^ (t & 7)) << 4) + (s0 & 7) * 2) = w; } }
        __syncthreads();
        f32x4 o[2][4];
#pragma unroll
        for (int a = 0; a < 2; ++a)
#pragma unroll
            for (int bb = 0; bb < 4; ++bb) o[a][bb] = (f32x4){0.f, 0.f, 0.f, 0.f};
#pragma unroll
        for (int ks = 0; ks < 4; ++ks) {
            const int rl = 32 * ks + 8 * g + qq, ch = 4 * ks + g;
            bf16x8 sf[2], qf[4];
#pragma unroll
            for (int et = 0; et < 2; ++et) sf[et] = tr_frag(simg + rl * 512 + (((2 * wave + et) ^ sR) << 5) + 8 * pp, 2048);
#pragma unroll
            for (int tt = 0; tt < 4; ++tt) { const int rt = 16 * tt + li; qf[tt] = *(const LAS bf16x8*)(qimg + rt * 256 + ((ch ^ (rt & 15)) << 4)); }
#pragma unroll
            for (int et = 0; et < 2; ++et)
#pragma unroll
                for (int tt = 0; tt < 4; ++tt) o[et][tt] = __builtin_amdgcn_mfma_f32_16x16x32_bf16(sf[et], qf[tt], o[et][tt], 0, 0, 0);
        }
#pragma unroll
        for (int ks = 0; ks < 2; ++ks) {
            const int rl = 32 * ks + 8 * g + qq, ch = 4 * ks + g;
            bf16x8 vf[2], af[4];
#pragma unroll
            for (int et = 0; et < 2; ++et) vf[et] = tr_frag(vimg + rl * 512 + (((2 * wave + et) ^ sR) << 5) + 8 * pp, 2048);
#pragma unroll
            for (int tt = 0; tt < 4; ++tt) { const int rt = 16 * tt + li; af[tt] = *(const LAS bf16x8*)(aimg + rt * 128 + ((ch ^ (rt & 7)) << 4)); }
#pragma unroll
            for (int et = 0; et < 2; ++et)
#pragma unroll
                for (int tt = 0; tt < 4; ++tt) o[et][tt] = __builtin_amdgcn_mfma_f32_16x16x32_bf16(vf[et], af[tt], o[et][tt], 0, 0, 0);
        }
#pragma unroll
        for (int tt = 0; tt < 4; ++tt) { float q2 = 0.f;
#pragma unroll
            for (int et = 0; et < 2; ++et) q2 += (o[et][tt][0] * o[et][tt][0] + o[et][tt][1] * o[et][tt][1]) + (o[et][tt][2] * o[et][tt][2] + o[et][tt][3] * o[et][tt][3]);
            q2 += __shfl_xor(q2, 16); q2 += __shfl_xor(q2, 32);
            if (g == 0) ssq[wave * 64 + 16 * tt + li] = q2; }
        __syncthreads();
#pragma unroll
        for (int tt = 0; tt < 4; ++tt) { const int t = 16 * tt + li; float q2 = 0.f;
#pragma unroll
            for (int w8 = 0; w8 < 8; ++w8) q2 += ssq[w8 * 64 + t];
            const float rs_ = 1.f / sqrtf(q2 * (1.f / 256.f) + LN_EPS);
#pragma unroll
            for (int et = 0; et < 2; ++et) { const int ee = 32 * wave + 16 * et + 4 * g;
                const f32x4 gg = *(const f32x4*)(p.gla_g + ee);
                const u32x2 rw = *(const u32x2*)(PROJ + (rowc + t) * DIN + C_GR + h * 256 + ee);
                const float r0 = __uint_as_float(rw.x << 16), r1 = __uint_as_float(rw.x & 0xffff0000u), r2 = __uint_as_float(rw.y << 16), r3 = __uint_as_float(rw.y & 0xffff0000u);
                u32x2 w; w.x = cvt_pk_bf16(o[et][tt][0] * rs_ * gg[0] * silu_f(r0), o[et][tt][1] * rs_ * gg[1] * silu_f(r1));
                w.y = cvt_pk_bf16(o[et][tt][2] * rs_ * gg[2] * silu_f(r2), o[et][tt][3] * rs_ * gg[3] * silu_f(r3));
                *(u32x2*)(MIXIN + (rowc + t) * D + h * 256 + ee) = w; } }
        if (cc < 3) {
#pragma unroll
            for (int ks = 0; ks < 2; ++ks) {
                const int rl = 32 * ks + 8 * g + qq;
                bf16x8 vf[4], kf[4];
#pragma unroll
                for (int et = 0; et < 4; ++et) vf[et] = tr_frag(vimg + rl * 512 + ((((e0 >> 4) + et) ^ sR) << 5) + 8 * pp, 2048);
#pragma unroll
                for (int dt = 0; dt < 4; ++dt) kf[dt] = tr_frag(kimg + rl * 256 + ((((d0 >> 4) + dt) ^ sR) << 5) + 8 * pp, 1024);
#pragma unroll
                for (int et = 0; et < 4; ++et)
#pragma unroll
                    for (int dt = 0; dt < 4; ++dt) S[et][dt] = __builtin_amdgcn_mfma_f32_16x16x32_bf16(vf[et], kf[dt], S[et][dt], 0, 0, 0);
            }
#pragma unroll
            for (int dt = 0; dt < 4; ++dt) { const float dl = __expf(blast[d0 + 16 * dt + li]);
#pragma unroll
                for (int et = 0; et < 4; ++et) S[et][dt] = S[et][dt] * dl; }
        }
    }
}

__device__ __forceinline__ void ph3_mfma(const Params& p, ldsp_t lds, bool rep = false) {
    bf16_t* PROJ = (bf16_t*)(p.ws + WS_PROJ);
    const float* rope = (const float*)(p.ws + WS_ROPE);
    float* HIDP = (float*)(p.ws + WS_HIDP);
    const int tid = threadIdx.x, lane = tid & 63, wave = tid >> 6, wm0 = (wave >> 1) * 64, wn0 = (wave & 1) * 64;
    if (false) for (int i = blockIdx.x * NTHR + tid; i < NTOK * 12 * 16; i += gridDim.x * NTHR) {
        const int f = i & 15, slot = (i >> 4) % 12, row = i / (16 * 12);
        const int cb = slot < 8 ? C_NQ + slot * 128 : (slot < 10 ? C_KSL + (slot - 8) * 128 : C_KWN + (slot - 10) * 128);
        const int pos = row % T;
        const float cs = rope[pos * 16 + f], sn = rope[65536 + pos * 16 + f];
        bf16_t* q = PROJ + (size_t)row * DIN + cb;
        const float x1 = bf2f(q[f]), x2 = bf2f(q[16 + f]);
        q[f] = f2bf(x1 * cs - x2 * sn); q[16 + f] = f2bf(x2 * cs + x1 * sn);
    }
    for (int u = blockIdx.x; u < 256; u += gridDim.x) {
        if (u < 128) { gla_a_unit(p, lds, u); continue; }
        const int v = u - 128, kv = v >> 6, mt = (v >> 4) & 3, nt = (v >> 3) & 1, ks = v & 7;
        const int m0 = mt * 256, n0 = nt * 128, cbase = kv ? C_VCM : C_KCM;
        TileSrc s;
#pragma unroll
        for (int i = 0; i < 4; ++i) { int rr = m0 + (tid >> 3) + 64 * i; if (rr > 1019) rr = 1019; const int g = rr & 1, bi = rr >> 1, b = bi / 255, ii = bi % 255;
            s.arow[i] = PROJ + (size_t)(b * T + 16 * ii + 4 * ks) * DIN + cbase + g * 128 + (tid & 7) * 8; }
        s.bcol = (kv ? p.w_cv1 : p.w_ck1) + (size_t)(ks * 512) * 256 + n0 + (tid & 31) * 4; s.bvalid = true; s.SA = DIN; s.ldb = 256; s.nkt = 8;
        f32x4 acc[4][4];
        gemm_tile(lds, s, acc);
#pragma unroll
        for (int mi = 0; mi < 4; ++mi)
#pragma unroll
            for (int ni = 0; ni < 4; ++ni) *(f32x4*)(HIDP + ((size_t)(kv * 8 + ks) * 1024 + m0 + wm0 + 16 * mi + (lane & 15)) * 256 + n0 + wn0 + 16 * ni + 4 * (lane >> 4)) = acc[mi][ni];
    }
}

__device__ __forceinline__ void ph3b_mfma(const Params& p, float* lds) {
    const float* HIDP = (const float*)(p.ws + WS_HIDP);
    const float* pebp = (const float*)(p.ws + WS_PEBP);
    const float* rope = (const float*)(p.ws + WS_ROPE);
    const int tid = threadIdx.x;
    for (int u = blockIdx.x; u < 2 * 255; u += gridDim.x) {
        const int kv = u / 255, rg = u % 255;
        const float* w2 = kv ? p.w_cv2 : p.w_ck2; const float* b2 = kv ? p.b_cv2 : p.b_ck2; const float* b1 = kv ? p.b_cv1 : p.b_ck1;
        bf16_t* OUT = (bf16_t*)(p.ws + (kv ? WS_VC : WS_KC));
        __syncthreads();
        for (int i = tid; i < 4 * 256; i += NTHR) { const int n = i & 255; float v = b1[n];
#pragma unroll
            for (int rs = 0; rs < 16; ++rs) v += pebp[(kv * 16 + rs) * 256 + n];
#pragma unroll
            for (int ks = 0; ks < 8; ++ks) v += HIDP[((size_t)(kv * 8 + ks) * 1024 + rg * 4) * 256 + i];
            lds[i] = silu_f(v); }
        __syncthreads();
        const int rl = tid >> 7, d = tid & 127, rr = rg * 4 + rl;
        float sacc = b2[d];
        for (int j = 0; j < 256; ++j) sacc = fmaf(lds[rl * 256 + j], w2[j * 128 + d], sacc);
        lds[1024 + tid] = sacc;
        __syncthreads();
        const int g = rr & 1, bi = rr >> 1, b = bi / 255, n = bi % 255;
        float o = sacc;
        if (kv == 0 && d < 32) {
            const int pos = 16 * n + 31, f = d & 15;
            const float cs = rope[pos * 16 + f], sn = rope[65536 + pos * 16 + f];
            const float x1 = lds[1024 + rl * 128 + f], x2 = lds[1024 + rl * 128 + 16 + f];
            o = d < 16 ? x1 * cs - x2 * sn : x2 * cs + x1 * sn;
        }
        OUT[(((size_t)b * 256 + n) * 2 + g) * 128 + d] = f2bf(o);
    }
}

__device__ __forceinline__ void ph4_mfma(const Params& p, ldsp_t lds, int nrep_gla = 1, int nrep_nsa = 1) {
    unsigned* qh = (unsigned*)(p.ws + WS_CTL) + CW_Q;
    LAS int* nxt = (LAS int*)(lds + LDS_BYTES - 128);
    for (int r = 0; r < nrep_gla; ++r)
    for (;;) {
        __syncthreads();
        if (threadIdx.x == 0) *nxt = (int)__hip_atomic_fetch_add(qh + 128 * r, 1u, __ATOMIC_RELAXED, __HIP_MEMORY_SCOPE_AGENT);
        __syncthreads();
        const int u = *nxt;
        if (u >= 128) break;
        gla_c_unit(p, lds, u);
    }
    for (int r = 0; r < nrep_nsa; ++r)
    for (;;) {
        __syncthreads();
        if (threadIdx.x == 0) *nxt = (int)__hip_atomic_fetch_add(qh + 64 + 128 * r, 1u, __ATOMIC_RELAXED, __HIP_MEMORY_SCOPE_AGENT);
        __syncthreads();
        const int u = *nxt;
        if (u >= 512) break;
        nsa_unit(p, lds, u);
    }
}


__device__ __forceinline__ u32x4 pair16(u32x2 t0, u32x2 t1, int g) {
    const bool odd = g & 1;
    const unsigned s0 = odd ? t0.x : t1.x, s1 = odd ? t0.y : t1.y;
    const unsigned r0 = (unsigned)__shfl_xor((int)s0, 16), r1 = (unsigned)__shfl_xor((int)s1, 16);
    u32x4 o;
    o.x = odd ? r0 : t0.x; o.y = odd ? r1 : t0.y; o.z = odd ? t1.x : r0; o.w = odd ? t1.y : r1;
    return o;
}
__device__ __forceinline__ int lane_id_opaque() { int l; asm volatile("v_mbcnt_lo_u32_b32 %0, -1, 0\n\tv_mbcnt_hi_u32_b32 %0, -1, %0" : "=v"(l)); return l; }
__device__ __forceinline__ int a_src_chunk(int tid) { return ((tid & 3) ^ f4((tid >> 4) & 3)) * 8; }

__device__ __forceinline__ void ph2_v2(const Params& p, ldsp_t lds) {
    const bf16_t* H = (const bf16_t*)(p.ws + WS_H);
    bf16_t* PROJ = (bf16_t*)(p.ws + WS_PROJ);
    const int tid0 = threadIdx.x, wave = __builtin_amdgcn_readfirstlane(tid0 >> 6), wm0 = (wave >> 2) * 128, wn0 = (wave & 3) * 64;
    const int vcu = vcu_of_block();
    constexpr int NT = (DIN + 255) / 256;
    for (int u = vcu; u < 4 * 6 * 32; u += gridDim.x) {
        const int sb = u >> 5, j = u & 31, mt = (sb & 3) * 8 + (j & 7), nt = (sb >> 2) * 4 + (j >> 3);
        if (nt >= NT) continue;
        const int m0 = mt * 256, n0 = nt * 256;
        int tid = threadIdx.x; asm volatile("" : "+v"(tid));
        TileSrc2b s;
#pragma unroll
        for (int i = 0; i < 2; ++i) s.arow[i] = H + (size_t)(m0 + (tid >> 2) + 128 * i) * D + a_src_chunk(tid);
        b_src_setup(s, (const bf16_t*)(p.ws + WS_WINB), DIN, n0, DIN, tid);
        s.SA = 128; s.ldb = DIN; s.nkt = D / 32;
        f32x4 acc[8][4];
        gemm_tile2b(lds, s, acc);
        const int lane = lane_id_opaque();
        const int g = lane >> 4;
        {
          const int c0 = n0 + wn0 + 16;
          const bool is_rope = (c0 >= C_NQ && c0 < C_NQ + 1024 && ((c0 - C_NQ) & 127) == 0) || c0 == C_KSL || c0 == C_KSL + 128 || c0 == C_KWN || c0 == C_KWN + 128;
          if (is_rope) {
              const float* rope = (const float*)(p.ws + WS_ROPE);
#pragma unroll
              for (int mi = 0; mi < 8; ++mi) { const int pos = (m0 + wm0 + 16 * mi + (lane & 15)) % T;
                  const f32x4 cs = *(const f32x4*)(rope + pos * 16 + 4 * g), sn = *(const f32x4*)(rope + 65536 + pos * 16 + 4 * g);
                  const f32x4 x1 = acc[mi][1], x2 = acc[mi][2];
                  acc[mi][1] = x1 * cs - x2 * sn; acc[mi][2] = x2 * cs + x1 * sn; } } }
#pragma unroll
        for (int mi = 0; mi < 8; ++mi)
#pragma unroll
            for (int np = 0; np < 2; ++np) {
                u32x2 t0, t1; t0.x = cvt_pk_bf16(acc[mi][2 * np][0], acc[mi][2 * np][1]); t0.y = cvt_pk_bf16(acc[mi][2 * np][2], acc[mi][2 * np][3]);
                t1.x = cvt_pk_bf16(acc[mi][2 * np + 1][0], acc[mi][2 * np + 1][1]); t1.y = cvt_pk_bf16(acc[mi][2 * np + 1][2], acc[mi][2 * np + 1][3]);
                const u32x4 o = pair16(t0, t1, g);
                const int m = m0 + wm0 + 16 * mi + (lane & 15), n = n0 + wn0 + 32 * np + ((g & 1) ? 16 + 4 * (g - 1) : 4 * g);
                if (n < DIN) *(u32x4*)(PROJ + (size_t)m * DIN + n) = o;
            }
    }
}

__device__ __forceinline__ void ph5_v2(const Params& p, ldsp_t lds) {
    const bf16_t* MIXIN = (const bf16_t*)(p.ws + WS_MIXIN);
    const float* mod = (const float*)(p.ws + WS_MOD);
    float* Z = (float*)(p.ws + WS_Z);
    const int tid0 = threadIdx.x, wave = __builtin_amdgcn_readfirstlane(tid0 >> 6), wm0 = (wave >> 2) * 128, wn0 = (wave & 3) * 64;
    const int vcu = vcu_of_block();
    for (int u = vcu; u < 32 * 8; u += gridDim.x) {
        const int sb = u >> 5, j = u & 31, mt = (sb & 3) * 8 + (j & 7), nt = (sb >> 2) * 4 + (j >> 3);
        const int m0 = mt * 256, n0 = nt * 256;
        int tid = threadIdx.x; asm volatile("" : "+v"(tid));
        TileSrc2b s;
#pragma unroll
        for (int i = 0; i < 2; ++i) s.arow[i] = MIXIN + (size_t)(m0 + (tid >> 2) + 128 * i) * D + a_src_chunk(tid);
        b_src_setup(s, (const bf16_t*)(p.ws + WS_WOB), D, n0, D, tid);
        s.SA = 128; s.ldb = D; s.nkt = D / 32;
        f32x4 acc[8][4];
        gemm_tile2b(lds, s, acc);
        const int lane = lane_id_opaque();
        const int b = m0 / T;
#pragma unroll
        for (int ni = 0; ni < 4; ++ni) {
            const int n = n0 + wn0 + 16 * ni + 4 * (lane >> 4);
            const f32x4 g1 = 1.f + *(const f32x4*)(mod + b * 12288 + 2 * 2048 + n);
#pragma unroll
            for (int mi = 0; mi < 8; ++mi) { const size_t o = (size_t)(m0 + wm0 + 16 * mi + (lane & 15)) * D + n;
                *(f32x4*)(Z + o) = DN_ALPHA * *(const f32x4*)(p.x + o) + g1 * acc[mi][ni]; }
        }
    }
}

__device__ __forceinline__ void ph7_v2(const Params& p, ldsp_t lds) {
    const bf16_t* H2 = (const bf16_t*)(p.ws + WS_H);
    const int* LIST = (const int*)(p.ws + WS_LIST);
    bf16_t* ACT = (bf16_t*)(p.ws + WS_ACT);
    LAS int* li = (LAS int*)(lds + G2_LDS);
    moe_offsets256(p, li);
    const int tid0 = threadIdx.x, wave = __builtin_amdgcn_readfirstlane(tid0 >> 6), wm0 = (wave >> 2) * 128, wn = wave & 3;
    unsigned* qh = (unsigned*)(p.ws + WS_CTL) + CW_Q + 256;
    LAS int* nxt = (LAS int*)(lds + LDS_BYTES - 128);
    const int myx = (int)(xb_xcc_id() & 7u);
    for (int qi = 0; qi < 8; ++qi) {
    const int xq = (myx + qi) & 7;
    for (;;) {
        __syncthreads();
        if (threadIdx.x == 0) *nxt = (int)__hip_atomic_fetch_add(qh + 64 * xq, 1u, __ATOMIC_RELAXED, __HIP_MEMORY_SCOPE_AGENT);
        __syncthreads();
        const int u = *nxt;
        int e = xq, base = 0;
        for (; e < 32; e += 8) { const int ne = (li[72 + e + 1] - li[72 + e]) * 16; if (u < base + ne) break; base += ne; }
        if (e >= 32) break;
        const int mte = li[72 + e + 1] - li[72 + e];
        const int ul = u - base, nt = ul / mte, mt = ul % mte;
        const int cnt = li[e], off = li[32 + e], n0 = nt * 128;
        int tid = threadIdx.x; asm volatile("" : "+v"(tid));
        TileSrc2 s;
#pragma unroll
        for (int i = 0; i < 2; ++i) { int rr = mt * 256 + (tid >> 2) + 128 * i; if (rr >= cnt) rr = cnt - 1; const int slot = LIST[e * 8192 + rr]; s.arow[i] = H2 + (size_t)(slot >> 2) * D + a_src_chunk(tid); }
        { const int c = (tid & 31) * 8, w = c >> 6, jj = c & 63;
          s.bcol = (jj < 32 ? p.w_gate : p.w_up) + (size_t)e * D * DFF + n0 + 32 * w + (jj & 31); }
        s.bvalid = true; s.SA = 128; s.ldb = DFF; s.nkt = D / 32;
        f32x4 acc[8][4];
        const int nmi_ = min(8, max(0, (cnt - mt * 256 - (wave >> 2) * 128 + 15) >> 4));
        gemm_tile2(lds, s, acc, nmi_);
        const int lane = lane_id_opaque();
        { const int g = lane >> 4;
          f32x4 bg[2], bu[2];
#pragma unroll
          for (int ni = 0; ni < 2; ++ni) { const int n = n0 + 32 * wn + 16 * ni + 4 * g; bg[ni] = *(const f32x4*)(p.b_gate + e * DFF + n); bu[ni] = *(const f32x4*)(p.b_up + e * DFF + n); }
#pragma unroll
          for (int mi = 0; mi < 8; ++mi) { const int rr = mt * 256 + wm0 + 16 * mi + (lane & 15);
              u32x2 t[2];
#pragma unroll
              for (int ni = 0; ni < 2; ++ni) { float a[4];
#pragma unroll
                  for (int i = 0; i < 4; ++i) { const float gt = fminf(acc[mi][ni][i] + bg[ni][i], 7.f), up = fminf(fmaxf(acc[mi][ni + 2][i] + bu[ni][i], -7.f), 7.f); a[i] = gt * sigmoid_f(1.702f * gt) * (up + 1.f); }
                  t[ni].x = cvt_pk_bf16(a[0], a[1]); t[ni].y = cvt_pk_bf16(a[2], a[3]); }
              const u32x4 o = pair16(t[0], t[1], g);
              const int n = n0 + 32 * wn + ((g & 1) ? 16 + 4 * (g - 1) : 4 * g);
              if (rr < cnt) *(u32x4*)(ACT + (size_t)(off + rr) * DFF + n) = o; } }
    }
    }
}

__device__ __forceinline__ void ph8_v2(const Params& p, ldsp_t lds) {
    const bf16_t* ACT = (const bf16_t*)(p.ws + WS_ACT);
    const int* LIST = (const int*)(p.ws + WS_LIST);
    const float* TOPW = (const float*)(p.ws + WS_TOPW);
    bf16_t* YP = (bf16_t*)(p.ws + WS_YP);
    LAS int* li = (LAS int*)(lds + G2_LDS);
    moe_offsets256(p, li);
    const int tid0 = threadIdx.x, wave = __builtin_amdgcn_readfirstlane(tid0 >> 6), wm0 = (wave >> 2) * 128, wn0 = (wave & 3) * 64;
    unsigned* qh = (unsigned*)(p.ws + WS_CTL) + CW_Q + 256 + 512;
    LAS int* nxt = (LAS int*)(lds + LDS_BYTES - 128);
    const int myx = (int)(xb_xcc_id() & 7u);
    for (int qi = 0; qi < 8; ++qi) {
    const int xq = (myx + qi) & 7;
    for (;;) {
        __syncthreads();
        if (threadIdx.x == 0) *nxt = (int)__hip_atomic_fetch_add(qh + 64 * xq, 1u, __ATOMIC_RELAXED, __HIP_MEMORY_SCOPE_AGENT);
        __syncthreads();
        const int u = *nxt;
        int e = xq, base = 0;
        for (; e < 32; e += 8) { const int ne = (li[72 + e + 1] - li[72 + e]) * 8; if (u < base + ne) break; base += ne; }
        if (e >= 32) break;
        const int mte = li[72 + e + 1] - li[72 + e];
        const int ul = u - base, nt = ul / mte, mt = ul % mte;
        const int cnt = li[e], off = li[32 + e], n0 = nt * 256;
        int tid = threadIdx.x; asm volatile("" : "+v"(tid));
        TileSrc2 s;
#pragma unroll
        for (int i = 0; i < 2; ++i) { int rr = mt * 256 + (tid >> 2) + 128 * i; if (rr >= cnt) rr = cnt - 1; s.arow[i] = ACT + (size_t)(off + rr) * DFF + a_src_chunk(tid); }
        s.bcol = p.w_down + (size_t)e * DFF * D + n0 + (tid & 31) * 8; s.bvalid = true; s.SA = 128; s.ldb = D; s.nkt = DFF / 32;
        f32x4 acc[8][4];
        const int nmi_ = min(8, max(0, (cnt - mt * 256 - (wave >> 2) * 128 + 15) >> 4));
        gemm_tile2(lds, s, acc, nmi_);
        const int lane = lane_id_opaque();
        { const int g = lane >> 4;
          f32x4 bd[4];
#pragma unroll
          for (int ni = 0; ni < 4; ++ni) bd[ni] = *(const f32x4*)(p.b_down + e * D + n0 + wn0 + 16 * ni + 4 * g);
#pragma unroll
          for (int mi = 0; mi < 8; ++mi) { int rr = mt * 256 + wm0 + 16 * mi + (lane & 15); const bool ok = rr < cnt; if (!ok) rr = cnt - 1;
              const int slot = LIST[e * 8192 + rr]; const float w = TOPW[slot];
#pragma unroll
              for (int np = 0; np < 2; ++np) { u32x2 t[2];
#pragma unroll
                  for (int k2 = 0; k2 < 2; ++k2) { const f32x4 y = w * (acc[mi][2 * np + k2] + bd[2 * np + k2]); t[k2].x = cvt_pk_bf16(y[0], y[1]); t[k2].y = cvt_pk_bf16(y[2], y[3]); }
                  const u32x4 o = pair16(t[0], t[1], g);
                  const int n = n0 + wn0 + 32 * np + ((g & 1) ? 16 + 4 * (g - 1) : 4 * g);
                  if (ok) *(u32x4*)(YP + (size_t)slot * D + n) = o; } } }
    }
    }
}


__device__ __forceinline__ void ph6_v2(const Params& p, ldsp_t lds, const int rep = 0) {
    const float* Z = (const float*)(p.ws + WS_Z);
    const float* mod = (const float*)(p.ws + WS_MOD);
    float* X1 = (float*)(p.ws + WS_X1);
    bf16_t* H2 = (bf16_t*)(p.ws + WS_H);
    const bf16_t* WRT = (const bf16_t*)(p.ws + WS_WRT);
    float* TOPW = (float*)(p.ws + WS_TOPW + (rep ? 512 * 1024 : 0));
    int* LIST = (int*)(p.ws + WS_LIST + (rep ? MiB : 0));
    unsigned* ctl = (unsigned*)(p.ws + WS_CTL) + (rep ? 32 * 64 : 0);
    const int tid = threadIdx.x, lane = tid & 63, wave = __builtin_amdgcn_readfirstlane(tid >> 6);
    ldsp_t img_hi = lds, img_lo = lds + 65536;
    LAS float* part = (LAS float*)(lds + 131072);
    LAS float* lgt = (LAS float*)(lds + 131072 + 16384);
    for (int blk = blockIdx.x; blk < NTOK / 32; blk += gridDim.x) {
        for (int half = 0; half < 2; ++half) {
            __syncthreads();
#pragma unroll 1
            for (int rr = 0; rr < 2; ++rr) {
                const int rl = 2 * wave + rr, row = blk * 32 + half * 16 + rl, b = row / T;
                const f32x4* zr = (const f32x4*)(Z + (size_t)row * D) + lane;
                f32x4 v[8]; float s1 = 0.f;
#pragma unroll
                for (int j = 0; j < 8; ++j) { v[j] = zr[64 * j]; s1 += (v[j][0] + v[j][1]) + (v[j][2] + v[j][3]); }
                float mean = wave_sum(s1) * (1.f / D), s2 = 0.f;
#pragma unroll
                for (int j = 0; j < 8; ++j) { v[j] = v[j] - mean; s2 += (v[j][0] * v[j][0] + v[j][1] * v[j][1]) + (v[j][2] * v[j][2] + v[j][3] * v[j][3]); }
                float rstd = 1.f / sqrtf(wave_sum(s2) * (1.f / D) + LN_EPS);
                s1 = 0.f;
#pragma unroll
                for (int j = 0; j < 8; ++j) { const int c0 = 256 * j + lane * 4;
                    v[j] = v[j] * rstd * *(const f32x4*)(p.ln1_g + c0) + *(const f32x4*)(p.ln1_b + c0);
                    *(f32x4*)(X1 + (size_t)row * D + c0) = v[j];
                    s1 += (v[j][0] + v[j][1]) + (v[j][2] + v[j][3]); }
                mean = wave_sum(s1) * (1.f / D); s2 = 0.f;
#pragma unroll
                for (int j = 0; j < 8; ++j) { v[j] = v[j] - mean; s2 += (v[j][0] * v[j][0] + v[j][1] * v[j][1]) + (v[j][2] * v[j][2] + v[j][3] * v[j][3]); }
                rstd = 1.f / sqrtf(wave_sum(s2) * (1.f / D) + LN_EPS);
                u32x2* o8 = (u32x2*)(H2 + (size_t)row * D) + lane;
#pragma unroll
                for (int j = 0; j < 8; ++j) { const int c0 = 256 * j + lane * 4;
                    const f32x4 sh = *(const f32x4*)(mod + b * 12288 + 3 * 2048 + c0), sc = *(const f32x4*)(mod + b * 12288 + 4 * 2048 + c0);
                    const f32x4 h = v[j] * rstd * (1.f + sc) + sh;
                    u32x2 hi; hi.x = cvt_pk_bf16(h[0], h[1]); hi.y = cvt_pk_bf16(h[2], h[3]);
                    o8[64 * j] = hi;
                    const float r0 = h[0] - __uint_as_float(hi.x << 16), r1 = h[1] - __uint_as_float(hi.x & 0xffff0000u), r2 = h[2] - __uint_as_float(hi.y << 16), r3 = h[3] - __uint_as_float(hi.y & 0xffff0000u);
                    u32x2 lo; lo.x = cvt_pk_bf16(r0, r1); lo.y = cvt_pk_bf16(r2, r3);
                    const unsigned off = (unsigned)(rl * 4096 + ((((32 * j + (lane >> 1))) ^ (rl & 15)) << 4) + (lane & 1) * 8);
                    *(LAS u32x2*)(img_hi + off) = hi; *(LAS u32x2*)(img_lo + off) = lo; }
            }
            __syncthreads();
            { const int r = lane & 15, g = lane >> 4;
              f32x4 acc[2] = {(f32x4){0.f, 0.f, 0.f, 0.f}, (f32x4){0.f, 0.f, 0.f, 0.f}};
#pragma unroll 2
              for (int ks = 0; ks < 8; ++ks) {
                  const int k0 = 256 * wave + 32 * ks, ch = (k0 >> 3) + g;
                  const unsigned aoff = (unsigned)(r * 4096 + ((ch ^ r) << 4));
                  const bf16x8 ahi = *(const LAS bf16x8*)(img_hi + aoff), alo = *(const LAS bf16x8*)(img_lo + aoff);
#pragma unroll
                  for (int et = 0; et < 2; ++et) {
                      const bf16x8 whi = *(const bf16x8*)(WRT + (size_t)(16 * et + r) * 2048 + k0 + 8 * g);
                      const bf16x8 wlo = *(const bf16x8*)(WRT + 65536 + (size_t)(16 * et + r) * 2048 + k0 + 8 * g);
                      acc[et] = __builtin_amdgcn_mfma_f32_16x16x32_bf16(whi, ahi, acc[et], 0, 0, 0);
                      acc[et] = __builtin_amdgcn_mfma_f32_16x16x32_bf16(whi, alo, acc[et], 0, 0, 0);
                      acc[et] = __builtin_amdgcn_mfma_f32_16x16x32_bf16(wlo, ahi, acc[et], 0, 0, 0);
                  }
              }
#pragma unroll
              for (int et = 0; et < 2; ++et)
#pragma unroll
                  for (int i = 0; i < 4; ++i) part[(wave * 16 + r) * 32 + 16 * et + 4 * g + i] = acc[et][i];
            }
            __syncthreads();
            { const int rl = tid >> 5, e = tid & 31; float sum = p.b_router[e];
#pragma unroll
              for (int w8 = 0; w8 < 8; ++w8) sum += part[(w8 * 16 + rl) * 32 + e];
              lgt[rl * 32 + e] = sum; }
            __syncthreads();
            if (tid < 16) {
                const int row = blk * 32 + half * 16 + tid;
                float tv[4]; int ti[4];
#pragma unroll
                for (int k = 0; k < 4; ++k) { tv[k] = -INFINITY; ti[k] = 0; }
                for (int e = 0; e < 32; ++e) {
                    const float v = lgt[tid * 32 + e];
                    if (v > tv[3]) {
                        if (v > tv[0]) { tv[3] = tv[2]; ti[3] = ti[2]; tv[2] = tv[1]; ti[2] = ti[1]; tv[1] = tv[0]; ti[1] = ti[0]; tv[0] = v; ti[0] = e; }
                        else if (v > tv[1]) { tv[3] = tv[2]; ti[3] = ti[2]; tv[2] = tv[1]; ti[2] = ti[1]; tv[1] = v; ti[1] = e; }
                        else if (v > tv[2]) { tv[3] = tv[2]; ti[3] = ti[2]; tv[2] = v; ti[2] = e; }
                        else { tv[3] = v; ti[3] = e; }
                    }
                }
                const float e1 = __expf(tv[1] - tv[0]), e2 = __expf(tv[2] - tv[0]), e3 = __expf(tv[3] - tv[0]);
                const float isum = 1.f / (1.f + e1 + e2 + e3);
                const float ww[4] = {isum, e1 * isum, e2 * isum, e3 * isum};
#pragma unroll
                for (int k = 0; k < 4; ++k) {
                    const unsigned pos = atomicAdd(ctl + CW_CNT + 64 * ti[k], 1u);
                    LIST[ti[k] * 8192 + pos] = row * 4 + k;
                    TOPW[row * 4 + k] = ww[k];
                }
            }
        }
    }
}


constexpr int NPHASE = 11;
__global__ void __launch_bounds__(NTHR, 2) fwd_kernel(Params p) {
    extern __shared__ __attribute__((aligned(16))) unsigned char lds_raw[];
    float* lds = (float*)lds_raw;
    volatile LAS unsigned* misc = (volatile LAS unsigned*)((LAS unsigned char*)lds_raw + LDS_BYTES - 64);
    if (threadIdx.x < 16) misc[threadIdx.x] = 0u;
    __syncthreads();
    unsigned* ctl = (unsigned*)(p.ws + WS_CTL);
    const bool multi = (p.ph_hi - p.ph_lo) > 1;
    XcdBarrier bar; bar.bar = ctl + CW_BAR; bar.x = 0; bar.st = misc;
    if (multi) bar = xcd_barrier_post(ctl + CW_BAR, misc);
#define IN(k) (p.ph_lo <= (k) && (k) < p.ph_hi)
#ifndef REPEAT_PHASE
#define REPEAT_PHASE -1
#endif
#define SEAM(k) do { if (IN(k) && IN((k) + 1)) xcd_barrier(bar); } while (0)
    if (IN(0)) { ph0(p, lds); if (REPEAT_PHASE == 0) ph0(p, lds); }
    SEAM(0);
    if (IN(1)) { ph1(p, lds); if (REPEAT_PHASE == 1) ph1(p, lds); }
    SEAM(1);
    if (IN(2)) { ph2_v2(p, (ldsp_t)lds_raw); if (REPEAT_PHASE == 2) ph2_v2(p, (ldsp_t)lds_raw); }
    SEAM(2);
    if (IN(3)) { ph3_mfma(p, (ldsp_t)lds_raw); if (REPEAT_PHASE == 3) ph3_mfma(p, (ldsp_t)lds_raw, true); }
    SEAM(3);
    if (IN(4)) { ph3b_mfma(p, lds); if (REPEAT_PHASE == 4) ph3b_mfma(p, lds); }
    SEAM(4);
    if (IN(5)) ph4_mfma(p, (ldsp_t)lds_raw, REPEAT_PHASE == 50 ? 2 : 1, REPEAT_PHASE == 51 ? 2 : 1);
    SEAM(5);
    if (IN(6)) { ph5_v2(p, (ldsp_t)lds_raw); if (REPEAT_PHASE == 6) ph5_v2(p, (ldsp_t)lds_raw); }
    SEAM(6);
    if (IN(7)) { for (int r7 = 0; r7 < (REPEAT_PHASE == 7 ? 2 : 1); ++r7) ph6_v2(p, (ldsp_t)lds_raw, r7); }
    SEAM(7);
    if (IN(8)) ph7_v2(p, (ldsp_t)lds_raw);
    SEAM(8);
    if (IN(9)) ph8_v2(p, (ldsp_t)lds_raw);
    SEAM(9);
    if (IN(10)) { ph9(p, lds); if (REPEAT_PHASE == 10) ph9(p, lds); }
}

extern "C" void kernel_launch(void* const* d_in, const int* in_sizes, int n_in, void* d_out, int out_size, void* d_ws, size_t ws_size, hipStream_t stream) {
    static int grid = 0;
    if (grid == 0) {
        int dev = 0, cus = 0;
        if (hipGetDevice(&dev) != hipSuccess || hipDeviceGetAttribute(&cus, hipDeviceAttributeMultiprocessorCount, dev) != hipSuccess) { fprintf(stderr, "kernel_launch: device query failed\n"); grid = -1; return; }
        if (hipFuncSetAttribute((const void*)fwd_kernel, hipFuncAttributeMaxDynamicSharedMemorySize, LDS_BYTES) != hipSuccess) { fprintf(stderr, "kernel_launch: hipFuncSetAttribute failed\n"); grid = -1; return; }
        if (n_in != 31 || ws_size < WS_END) { fprintf(stderr, "kernel_launch: unexpected n_in %d / ws %zu\n", n_in, ws_size); grid = -1; return; }
        (void)hipGetLastError();
        grid = cus;
    }
    if (grid < 0) return;
    (void)hipMemsetAsync((char*)d_ws + WS_CTL, 0, CTL_BYTES, stream);
    Params p{};
    const float** f = (const float**)&p;
    for (int i = 0; i < 31; ++i) f[i] = (const float*)d_in[i];
    p.out = (float*)d_out; p.ws = (unsigned char*)d_ws;
#if N_LAUNCH_MODE == 1
    p.ph_lo = 0; p.ph_hi = NPHASE;
    hipLaunchKernelGGL(fwd_kernel, dim3(grid), dim3(NTHR), LDS_BYTES, stream, p);
#else
    for (int k = 0; k < NPHASE; ++k) { p.ph_lo = k; p.ph_hi = k + 1; hipLaunchKernelGGL(fwd_kernel, dim3(grid), dim3(NTHR), LDS_BYTES, stream, p); }
#endif
}
```

```cpp
#include <hip/hip_runtime.h>
#include <stdint.h>
#include <cstdio>

#ifndef N_LAUNCH_MODE
#define N_LAUNCH_MODE 1
#endif

typedef unsigned short bf16_t;
typedef float f32x4 __attribute__((ext_vector_type(4)));
#define LAS __attribute__((address_space(3)))

constexpr int NB = 2, T = 4096, D = 2048, NTOK = NB * T;
constexpr int DIN = 5672;
constexpr int C_GQ = 0, C_GK = 512, C_GV = 1024, C_GR = 2048, C_GLR = 3072, C_NQ = 3088, C_KCM = 4112, C_VCM = 4368,
              C_KSL = 4624, C_VSL = 4880, C_KWN = 5136, C_VWN = 5392, C_NGT = 5648;
constexpr int NE = 32, TOPK = 4, DFF = 2048;
constexpr int NCMP = 255;
constexpr float LN_EPS = 1e-5f;
constexpr float DN_ALPHA = 1.189207115002721f;
constexpr int NTHR = 512;

constexpr size_t MiB = 1u << 20;
constexpr size_t WS_CTL = 0, CTL_BYTES = 1 * MiB;
constexpr size_t WS_MODP = 1 * MiB;
constexpr size_t WS_MOD = 2 * MiB;
constexpr size_t WS_ROPE = 3 * MiB;
constexpr size_t WS_PEBP = 4 * MiB;
constexpr size_t WS_KC = 5 * MiB;
constexpr size_t WS_VC = 6 * MiB;
constexpr size_t WS_H = 16 * MiB;
constexpr size_t WS_PROJ = 48 * MiB;
constexpr size_t WS_MIXIN = 144 * MiB;
constexpr size_t WS_Z = 176 * MiB;
constexpr size_t WS_X1 = 240 * MiB;
constexpr size_t WS_TOPW = 304 * MiB;
constexpr size_t WS_LIST = 305 * MiB;
constexpr size_t WS_ACT = 340 * MiB;
constexpr size_t WS_YP = 470 * MiB;
constexpr size_t WS_HIDP = 600 * MiB;
constexpr size_t WS_BC = 616 * MiB;
constexpr size_t WS_U = 632 * MiB;
constexpr size_t WS_DTOT = 648 * MiB;
constexpr size_t WS_WRT = 650 * MiB;
constexpr size_t WS_WINB = 652 * MiB;
constexpr size_t WS_WOB = 676 * MiB;
constexpr size_t WS_END = 686 * MiB;
constexpr int CW_BAR = 4096;
constexpr int CW_CNT = 8192;
constexpr int CW_Q = 12288;

constexpr int LDS_BYTES = 160 * 1024;

__device__ __forceinline__ float bf2f(bf16_t b) { return __uint_as_float(((unsigned)b) << 16); }
__device__ __forceinline__ bf16_t f2bf(float f) { unsigned u = __float_as_uint(f); u += 0x7fffu + ((u >> 16) & 1u); return (bf16_t)(u >> 16); }
__device__ __forceinline__ unsigned pk2(float lo, float hi) { return (unsigned)f2bf(lo) | ((unsigned)f2bf(hi) << 16); }
__device__ __forceinline__ float silu_f(float x) { return x / (1.f + __expf(-x)); }
__device__ __forceinline__ float sigmoid_f(float x) { return 1.f / (1.f + __expf(-x)); }
__device__ __forceinline__ float logsigmoid_f(float x) { return fminf(x, 0.f) - log1pf(__expf(-fabsf(x))); }
__device__ __forceinline__ float wave_sum(float v) {
#pragma unroll
    for (int o = 1; o < 64; o <<= 1) v += __shfl_xor(v, o);
    return v;
}
__device__ __forceinline__ float wave_max(float v) {
#pragma unroll
    for (int o = 1; o < 64; o <<= 1) v = fmaxf(v, __shfl_xor(v, o));
    return v;
}

#define XB_TMO      128
#define XB_XCNT(j)  (256  + 64 * (j))
#define XB_XSUB(j)  (1280 + 64 * (j))
#define XB_XGEN(j)  (2304 + 64 * (j))
#define XB_TOP      3328
#define XB_TOPGEN   3392
#define XCD_BAR_WORDS 3456
#define XB_SPIN_CAP (1u << 18)
__device__ __forceinline__ unsigned xb_ld(unsigned* p)              { return __hip_atomic_load(p, __ATOMIC_RELAXED, __HIP_MEMORY_SCOPE_AGENT); }
__device__ __forceinline__ unsigned xb_add(unsigned* p, unsigned v) { return __hip_atomic_fetch_add(p, v, __ATOMIC_RELAXED, __HIP_MEMORY_SCOPE_AGENT); }
__device__ __forceinline__ unsigned xb_xcc_id() { return (unsigned)__builtin_amdgcn_s_getreg((3 << 11) | 20) & 0xFu; }
#define XB_SPIN(cond, bar) do { unsigned _sp = 0; while (cond) { __builtin_amdgcn_s_sleep(1); \
    if ((++_sp & 255u) == 0u) { if (xb_ld(&(bar)[XB_TMO])) break; if (_sp > XB_SPIN_CAP) { atomicAdd(&(bar)[XB_TMO], 1u); break; } } } } while (0)
struct XcdBarrier { unsigned* bar; unsigned x; volatile LAS unsigned* st; };
__device__ __forceinline__ XcdBarrier xcd_barrier_post(unsigned* bar, volatile LAS unsigned* st) {
    XcdBarrier b; b.bar = bar; b.x = xb_xcc_id(); b.st = st;
    if (threadIdx.x == 0) (void)xb_add(&bar[XB_XCNT(b.x)], 1u);
    return b;
}
__device__ __forceinline__ void xcd_barrier_complete(unsigned* bar, unsigned x, unsigned& nloc, unsigned& nx) {
    const unsigned G = gridDim.x * gridDim.y * gridDim.z;
    unsigned sum, cnt, mine, sp = 0u;
    for (;;) {
        sum = 0u; cnt = 0u; mine = 0u;
#pragma unroll
        for (unsigned j = 0; j < 16; ++j) { const unsigned c = xb_ld(&bar[XB_XCNT(j)]); sum += c; cnt += (c > 0u) ? 1u : 0u; mine = (j == x) ? c : mine; }
        if (sum == G) break;
        __builtin_amdgcn_s_sleep(1);
        if ((++sp & 255u) == 0u) { if (xb_ld(&bar[XB_TMO])) break; if (sp > XB_SPIN_CAP) { atomicAdd(&bar[XB_TMO], 1u); break; } }
    }
    nloc = mine > 0u ? mine : 1u; nx = cnt > 0u ? cnt : 1u;
}
__device__ __forceinline__ void xcd_barrier(const XcdBarrier& b) {
    asm volatile("s_waitcnt vmcnt(0)" ::: "memory");
    __syncthreads();
    if (threadIdx.x == 0) {
        unsigned* bar = b.bar;
        __builtin_amdgcn_s_waitcnt(0);
        unsigned nloc = b.st[0], nx = b.st[1];
        if (nloc == 0u) { xcd_barrier_complete(bar, b.x, nloc, nx); b.st[0] = nloc; b.st[1] = nx; }
        const unsigned old = xb_add(&bar[XB_XSUB(b.x)], 1u);
        const unsigned gen = old / nloc;
        if (old + 1u == (gen + 1u) * nloc) {
            __builtin_amdgcn_fence(__ATOMIC_RELEASE, "agent");
            asm volatile("s_waitcnt vmcnt(0)" ::: "memory");
            const unsigned og = xb_add(&bar[XB_TOP], 1u);
            const unsigned tg = og / nx;
            if (og + 1u == (tg + 1u) * nx) xb_add(&bar[XB_TOPGEN], 1u);
            else XB_SPIN(xb_ld(&bar[XB_TOPGEN]) == tg, bar);
            __builtin_amdgcn_fence(__ATOMIC_ACQUIRE, "agent");
            xb_add(&bar[XB_XGEN(b.x)], 1u);
            asm volatile("s_waitcnt vmcnt(0)" ::: "memory");
        } else {
            XB_SPIN(xb_ld(&bar[XB_XGEN(b.x)]) == gen, bar);
            __builtin_amdgcn_fence(__ATOMIC_ACQUIRE, "agent");
            asm volatile("s_waitcnt vmcnt(0)" ::: "memory");
        }
    }
    __syncthreads();
}

struct Params {
    const float *x, *c, *w_ada, *b_ada, *w_in, *w_gk, *b_gk, *gla_g, *pe_k, *pe_v;
    const float *w_ck1, *b_ck1, *w_ck2, *b_ck2, *w_cv1, *b_cv1, *w_cv2, *b_cv2, *w_o, *ln1_g, *ln1_b;
    const float *w_router, *b_router, *w_gate, *b_gate, *w_up, *b_up, *w_down, *b_down, *ln2_g, *ln2_b;
    float* out; unsigned char* ws;
    int ph_lo, ph_hi;
};


__device__ __forceinline__ void ph0(const Params& p, float* lds) {
    const int tid = threadIdx.x, lane = tid & 63, wave = tid >> 6;
    float* modp = (float*)(p.ws + WS_MODP);
    float* rope = (float*)(p.ws + WS_ROPE);
    float* pebp = (float*)(p.ws + WS_PEBP);
    for (int u = blockIdx.x; u < 384; u += gridDim.x) {
        const int cb = u % 48, kc = u / 48;
        const int col = cb * 256 + lane * 4, kb = kc * 256 + wave * 32;
        f32x4 a0 = {0.f, 0.f, 0.f, 0.f}, a1 = {0.f, 0.f, 0.f, 0.f};
#pragma unroll 8
        for (int k = kb; k < kb + 32; ++k) {
            const f32x4 w = *(const f32x4*)(p.w_ada + (size_t)k * 12288 + col);
            const float s0 = silu_f(p.c[k]), s1 = silu_f(p.c[D + k]);
            a0 += s0 * w; a1 += s1 * w;
        }
        __syncthreads();
        *(f32x4*)(lds + (wave * 2 + 0) * 256 + lane * 4) = a0;
        *(f32x4*)(lds + (wave * 2 + 1) * 256 + lane * 4) = a1;
        __syncthreads();
        { const int b = tid >> 8, cc = tid & 255; float s = 0.f;
#pragma unroll
          for (int w = 0; w < 8; ++w) s += lds[(w * 2 + b) * 256 + cc];
          modp[((size_t)kc * 2 + b) * 12288 + cb * 256 + cc] = s; }
    }
    for (int i = blockIdx.x * NTHR + tid; i < 4096 * 16; i += gridDim.x * NTHR) {
        const int pos = i >> 4, f = i & 15;
        const double inv = pow(500000.0, -(double)f / 16.0);
        const double ang = (double)pos * inv;
        rope[i] = (float)cos(ang); rope[65536 + i] = (float)sin(ang);
    }
    { bf16_t* winb = (bf16_t*)(p.ws + WS_WINB); bf16_t* wob = (bf16_t*)(p.ws + WS_WOB);
      const size_t n1 = (size_t)D * DIN / 8, n2 = (size_t)D * D / 8;
      for (size_t i = (size_t)blockIdx.x * NTHR + tid; i < n1 + n2; i += (size_t)gridDim.x * NTHR) {
          const float* src = i < n1 ? p.w_in + i * 8 : p.w_o + (i - n1) * 8; bf16_t* dst = i < n1 ? winb + i * 8 : wob + (i - n1) * 8;
          const f32x4 a = *(const f32x4*)src, b = *(const f32x4*)(src + 4);
          uint4 o; o.x = pk2(a[0], a[1]); o.y = pk2(a[2], a[3]); o.z = pk2(b[0], b[1]); o.w = pk2(b[2], b[3]);
          *(uint4*)dst = o; } }
    { bf16_t* wrt = (bf16_t*)(p.ws + WS_WRT);
      for (int i = blockIdx.x * NTHR + tid; i < 2048 * 32; i += gridDim.x * NTHR) {
          const int k = i >> 5, e = i & 31; const float w = p.w_router[i];
          const bf16_t hi = f2bf(w); const bf16_t lo = f2bf(w - bf2f(hi));
          wrt[e * 2048 + k] = hi; wrt[65536 + e * 2048 + k] = lo; } }
    for (int u = blockIdx.x; u < 32; u += gridDim.x) {
        const int kv = u >> 4, rs = u & 15;
        const float* w1 = kv ? p.w_cv1 : p.w_ck1; const float* pe = kv ? p.pe_v : p.pe_k;
        const int j = tid & 255, half = tid >> 8;
        float s = 0.f;
        for (int r = rs * 256 + half * 128; r < rs * 256 + half * 128 + 128; ++r) s = fmaf(pe[r], w1[(size_t)r * 256 + j], s);
        __syncthreads();
        lds[tid] = s;
        __syncthreads();
        if (tid < 256) pebp[(kv * 16 + rs) * 256 + tid] = lds[tid] + lds[tid + 256];
    }
}

__device__ __forceinline__ void ph1(const Params& p, float* lds) {
    const int tid = threadIdx.x, lane = tid & 63, wave = tid >> 6;
    const float* modp = (const float*)(p.ws + WS_MODP);
    float* mod = (float*)(p.ws + WS_MOD);
    bf16_t* H = (bf16_t*)(p.ws + WS_H);
    for (int i = blockIdx.x * NTHR + tid; i < 2 * 12288; i += gridDim.x * NTHR) {
        const int b = i / 12288, col = i % 12288;
        float v = p.b_ada[col];
#pragma unroll
        for (int kc = 0; kc < 8; ++kc) v += modp[((size_t)kc * 2 + b) * 12288 + col];
        mod[i] = v;
    }
    const int rpb = (((NTOK + (int)gridDim.x - 1) / (int)gridDim.x) + 7) & ~7;
    int cached_b = -1;
    for (int r0 = blockIdx.x * rpb; r0 < min(NTOK, (int)(blockIdx.x + 1) * rpb); r0 += 8) {
        const int row = r0 + wave;
        const int bb = r0 / T;
        if (bb != cached_b) {
            __syncthreads();
            for (int i = tid; i < 4096; i += NTHR) { const int seg = i >> 11, jx = i & 2047, col = seg * 2048 + jx;
                float v = p.b_ada[col];
#pragma unroll
                for (int kc = 0; kc < 8; ++kc) v += modp[((size_t)kc * 2 + bb) * 12288 + col];
                lds[i] = v; }
            __syncthreads();
            cached_b = bb;
        }
        if (row >= NTOK) continue;
        const f32x4* xr = (const f32x4*)(p.x + (size_t)row * D) + lane;
        f32x4 v[8]; float s = 0.f;
#pragma unroll
        for (int j2 = 0; j2 < 8; ++j2) { v[j2] = xr[64 * j2]; s += (v[j2][0] + v[j2][1]) + (v[j2][2] + v[j2][3]); }
        const float mean = wave_sum(s) * (1.f / D); float s2 = 0.f;
#pragma unroll
        for (int j2 = 0; j2 < 8; ++j2) { v[j2] = v[j2] - mean; s2 += (v[j2][0] * v[j2][0] + v[j2][1] * v[j2][1]) + (v[j2][2] * v[j2][2] + v[j2][3] * v[j2][3]); }
        const float rstd = 1.f / sqrtf(wave_sum(s2) * (1.f / D) + LN_EPS);
        unsigned long long* o8 = (unsigned long long*)(H + (size_t)row * D) + lane;
#pragma unroll
        for (int j2 = 0; j2 < 8; ++j2) {
            const int c0 = 256 * j2 + lane * 4;
            const f32x4 sh = *(const f32x4*)(lds + c0), sc = *(const f32x4*)(lds + 2048 + c0);
            const f32x4 y = v[j2] * rstd * (1.f + sc) + sh;
            o8[64 * j2] = (unsigned long long)pk2(y[0], y[1]) | ((unsigned long long)pk2(y[2], y[3]) << 32);
        }
    }
}


__device__ __forceinline__ void ph9(const Params& p, float* lds) {
    const float* X1 = (const float*)(p.ws + WS_X1);
    const float* mod = (const float*)(p.ws + WS_MOD);
    const bf16_t* YP = (const bf16_t*)(p.ws + WS_YP);
    const int tid = threadIdx.x, lane = tid & 63, wave = tid >> 6;
    for (int row = blockIdx.x * 8 + wave; row < NTOK; row += gridDim.x * 8) {
        const int b = row / T;
        f32x4 v[8]; float s = 0.f;
#pragma unroll
        for (int j = 0; j < 8; ++j) { const int c0 = 256 * j + lane * 4;
            f32x4 y = {0.f, 0.f, 0.f, 0.f};
#pragma unroll
            for (int k = 0; k < 4; ++k) { const unsigned long long w = *(const unsigned long long*)(YP + ((size_t)row * 4 + k) * D + c0);
                y[0] += bf2f((bf16_t)(w & 0xffff)); y[1] += bf2f((bf16_t)((w >> 16) & 0xffff)); y[2] += bf2f((bf16_t)((w >> 32) & 0xffff)); y[3] += bf2f((bf16_t)(w >> 48)); }
            const f32x4 g2 = *(const f32x4*)(mod + b * 12288 + 5 * 2048 + c0);
            v[j] = DN_ALPHA * *(const f32x4*)(X1 + (size_t)row * D + c0) + (1.f + g2) * y;
            s += (v[j][0] + v[j][1]) + (v[j][2] + v[j][3]); }
        const float mean = wave_sum(s) * (1.f / D); float s2 = 0.f;
#pragma unroll
        for (int j = 0; j < 8; ++j) { v[j] = v[j] - mean; s2 += (v[j][0] * v[j][0] + v[j][1] * v[j][1]) + (v[j][2] * v[j][2] + v[j][3] * v[j][3]); }
        const float rstd = 1.f / sqrtf(wave_sum(s2) * (1.f / D) + LN_EPS);
        const float pscale = 1.f;
#pragma unroll
        for (int j = 0; j < 8; ++j) { const int c0 = 256 * j + lane * 4;
            *(f32x4*)(p.out + (size_t)row * D + c0) = pscale * (v[j] * rstd * *(const f32x4*)(p.ln2_g + c0) + *(const f32x4*)(p.ln2_b + c0)); }
    }
}


typedef short bf16x8 __attribute__((ext_vector_type(8)));
typedef short s16x4 __attribute__((ext_vector_type(4)));
typedef unsigned u32x4 __attribute__((ext_vector_type(4)));
typedef unsigned u32x2 __attribute__((ext_vector_type(2)));
typedef LAS unsigned char* ldsp_t;
__device__ __forceinline__ unsigned cvt_pk_bf16(float lo, float hi) { unsigned r; asm volatile("v_cvt_pk_bf16_f32 %0, %1, %2" : "=v"(r) : "v"(lo), "v"(hi)); return r; }
constexpr int GT_A_BYTES = 256 * 128, GT_B_BYTES = 64 * 256;
constexpr int GT_A0 = 0, GT_A1 = GT_A_BYTES, GT_B0 = 2 * GT_A_BYTES, GT_B1 = 2 * GT_A_BYTES + GT_B_BYTES, GT_LDS = 2 * GT_A_BYTES + 2 * GT_B_BYTES;

struct TileSrc {
    const bf16_t* arow[4];
    const float* bcol;
    int SA;
    int ldb;
    int nkt;
    bool bvalid;
};

__device__ __forceinline__ void gemm_tile(ldsp_t lds, const TileSrc& s, f32x4 (&acc)[4][4]) {
    const int tid = threadIdx.x, lane = tid & 63, wave = __builtin_amdgcn_readfirstlane(tid >> 6);
    const int wm0 = (wave >> 1) * 64, wn = wave & 1;
    const int rA = tid >> 3, chA = tid & 7;
    const unsigned wA = (unsigned)(rA * 128 + ((chA ^ (rA & 7)) << 4));
    const int kB = tid >> 5, cB = (tid & 31) * 4;
    const int sB = (kB & 3) | (((kB >> 3) & 1) << 2);
    const unsigned wB = (unsigned)(kB * 256 + (((cB >> 4) ^ sB) << 5) + (cB & 15) * 2);
    const int r = lane & 15, g = lane >> 4;
    const unsigned aR0 = (unsigned)((wm0 + r) * 128 + (((g) ^ (r & 7)) << 4));
    const unsigned aR1 = (unsigned)((wm0 + r) * 128 + (((4 + g) ^ (r & 7)) << 4));
    const int q = r >> 2, pp = r & 3, sR = q | ((g & 1) << 2);
    unsigned bR[4];
#pragma unroll
    for (int ni = 0; ni < 4; ++ni) bR[ni] = (unsigned)((8 * g + q) * 256 + (((wn * 4 + ni) ^ sR) << 5) + 8 * pp);
#pragma unroll
    for (int mi = 0; mi < 4; ++mi)
#pragma unroll
        for (int ni = 0; ni < 4; ++ni) acc[mi][ni] = (f32x4){0.f, 0.f, 0.f, 0.f};
    u32x4 ra[4]; f32x4 rb[4];
    const f32x4 zero4 = {0.f, 0.f, 0.f, 0.f};
#define GT_ISSUE(t) do { const int _k0 = (t) * 64; const int _ao = (_k0 >> 7) * s.SA + (_k0 & 127); \
        _Pragma("unroll") for (int i = 0; i < 4; ++i) ra[i] = *(const u32x4*)(s.arow[i] + _ao); \
        _Pragma("unroll") for (int i = 0; i < 4; ++i) rb[i] = s.bvalid ? *(const f32x4*)(s.bcol + (size_t)(_k0 + kB + 16 * i) * s.ldb) : zero4; } while (0)
#define GT_WRITE(aoff, boff) do { \
        _Pragma("unroll") for (int i = 0; i < 4; ++i) *(LAS u32x4*)(lds + (aoff) + wA + i * 8192) = ra[i]; \
        _Pragma("unroll") for (int i = 0; i < 4; ++i) { u32x2 w; w.x = cvt_pk_bf16(rb[i][0], rb[i][1]); w.y = cvt_pk_bf16(rb[i][2], rb[i][3]); *(LAS u32x2*)(lds + (boff) + wB + i * 4096) = w; } } while (0)
#define GT_COMPUTE(aoff, boff) do { \
        _Pragma("unroll") for (int ks = 0; ks < 2; ++ks) { \
            bf16x8 af[4], bfr[4]; \
            _Pragma("unroll") for (int mi = 0; mi < 4; ++mi) af[mi] = *(const LAS bf16x8*)(lds + (aoff) + (ks ? aR1 : aR0) + mi * 2048); \
            _Pragma("unroll") for (int ni = 0; ni < 4; ++ni) { \
                const s16x4 lo = __builtin_bit_cast(s16x4, __builtin_amdgcn_ds_read_tr16_b64_v4i16((LAS s16x4*)(lds + (boff) + bR[ni] + ks * 8192))); \
                const s16x4 hi = __builtin_bit_cast(s16x4, __builtin_amdgcn_ds_read_tr16_b64_v4i16((LAS s16x4*)(lds + (boff) + bR[ni] + ks * 8192 + 1024))); \
                bfr[ni] = __builtin_shufflevector(lo, hi, 0, 1, 2, 3, 4, 5, 6, 7); } \
            _Pragma("unroll") for (int mi = 0; mi < 4; ++mi) \
                _Pragma("unroll") for (int ni = 0; ni < 4; ++ni) acc[mi][ni] = __builtin_amdgcn_mfma_f32_16x16x32_bf16(bfr[ni], af[mi], acc[mi][ni], 0, 0, 0); } } while (0)
    __syncthreads();
    GT_ISSUE(0); GT_WRITE(GT_A0, GT_B0);
    if (s.nkt > 1) GT_ISSUE(1);
    for (int t = 0; t < s.nkt; t += 2) {
        __syncthreads();
        if (t + 1 < s.nkt) GT_WRITE(GT_A1, GT_B1);
        if (t + 2 < s.nkt) GT_ISSUE(t + 2);
        GT_COMPUTE(GT_A0, GT_B0);
        if (t + 1 < s.nkt) {
            __syncthreads();
            if (t + 2 < s.nkt) GT_WRITE(GT_A0, GT_B0);
            if (t + 3 < s.nkt) GT_ISSUE(t + 3);
            GT_COMPUTE(GT_A1, GT_B1);
        }
    }
#undef GT_ISSUE
#undef GT_WRITE
#undef GT_COMPUTE
}

constexpr int G2_A = 0  , G2_B0 = 49152, G2_B1 = 65536, G2_LDS = 81920;
__device__ __forceinline__ int f4(int x) { return (0x1320 >> (4 * x)) & 3; }
struct TileSrc2 {
    const bf16_t* arow[2];
    const float* bcol;
    int SA, ldb, nkt; bool bvalid;
};
__device__ __forceinline__ void glds16_asm(const void* gsrc, unsigned lds_dst) {
    unsigned keep;
    asm volatile("s_mov_b32 %0, m0\n\ts_mov_b32 m0, %2\n\ts_nop 0\n\tglobal_load_lds_dwordx4 %1, off\n\ts_mov_b32 m0, %0" : "=&s"(keep) : "v"(gsrc), "s"(lds_dst) : "memory");
}
__device__ __forceinline__ void gemm_tile2(ldsp_t lds, const TileSrc2& s, f32x4 (&acc)[8][4], const int nmi) {
    int tid = threadIdx.x; asm volatile("" : "+v"(tid));
    const int lane = tid & 63, wave = __builtin_amdgcn_readfirstlane(tid >> 6);
    const int wm0 = (wave >> 2) * 128, wn = wave & 3;
    const int kB = 2 * (tid >> 6) + ((tid >> 5) & 1), cB = (tid & 31) * 8;
    const int r = lane & 15, g = lane >> 4;
    const unsigned aR = (unsigned)((wm0 + r) * 64 + ((g ^ f4((r >> 2) & 3)) << 4));
    const int q = r >> 2, pp = r & 3, sR = q | ((g & 1) << 2);
    const unsigned bR0 = (unsigned)((8 * g + q) * 512 + (((wn * 4) ^ sR) << 5) + 8 * pp);
    const unsigned wB0 = (unsigned)(kB * 512 + (((cB >> 4) ^ ((kB & 3) | (((kB >> 3) & 1) << 2))) << 5) + (cB & 15) * 2);
#pragma unroll
    for (int mi = 0; mi < 8; ++mi)
#pragma unroll
        for (int ni = 0; ni < 4; ++ni) acc[mi][ni] = (f32x4){0.f, 0.f, 0.f, 0.f};
    f32x4 rb[4]; u32x4 wv[2];
    const f32x4 zero4 = {0.f, 0.f, 0.f, 0.f};
    const unsigned ldsbase = (unsigned)(unsigned long long)lds;
    const unsigned dmaw = ldsbase + G2_A + (unsigned)wave * 1024u;
#define G2_DMA_A(t, stage) do { const int _k0 = (t) * 32; const int _ao = (_k0 >> 7) * s.SA + (_k0 & 127); \
        _Pragma("unroll") for (int i = 0; i < 2; ++i) glds16_asm(s.arow[i] + _ao, dmaw + (unsigned)(stage) * 16384u + i * 8192u); } while (0)
#define G2_ISSUE_B(t) do { const int _k0 = (t) * 32; \
        _Pragma("unroll") for (int i = 0; i < 2; ++i) { const float* _p = s.bcol + (size_t)(_k0 + kB + 16 * i) * s.ldb; rb[2 * i] = *(const f32x4*)_p; rb[2 * i + 1] = *(const f32x4*)(_p + 4); } } while (0)
#define G2_WRITE_B(boff, tt) do { \
        _Pragma("unroll") for (int i = 0; i < 2; ++i) { wv[i].x = cvt_pk_bf16(rb[2 * i][0], rb[2 * i][1]); wv[i].y = cvt_pk_bf16(rb[2 * i][2], rb[2 * i][3]); \
            wv[i].z = cvt_pk_bf16(rb[2 * i + 1][0], rb[2 * i + 1][1]); wv[i].w = cvt_pk_bf16(rb[2 * i + 1][2], rb[2 * i + 1][3]); \
            *(LAS u32x4*)(lds + (boff) + wB0 + i * 8192) = wv[i]; } } while (0)
    const int nkt = s.nkt;
    const int grp = wave >> 2;
    __syncthreads();
    G2_ISSUE_B(0); G2_DMA_A(0, 0); G2_DMA_A(1, 1); G2_WRITE_B(G2_B0, 0); G2_ISSUE_B(1);
    asm volatile("s_waitcnt vmcnt(4)" ::: "memory");
    __syncthreads();
    if (grp) { __builtin_amdgcn_s_barrier(); asm volatile("" ::: "memory"); }
    int st = 0, st2 = 2;
    for (int t = 0; t < nkt; ++t) {
        const int bcur = (t & 1) ? G2_B1 : G2_B0, bnxt = (t & 1) ? G2_B0 : G2_B1;
        bf16x8 bfr[4], af[8];
#pragma unroll
        for (int ni = 0; ni < 4; ++ni) {
            const s16x4 lo = __builtin_bit_cast(s16x4, __builtin_amdgcn_ds_read_tr16_b64_v4i16((LAS s16x4*)(lds + bcur + (bR0 ^ (ni << 5)))));
            const s16x4 hi = __builtin_bit_cast(s16x4, __builtin_amdgcn_ds_read_tr16_b64_v4i16((LAS s16x4*)(lds + bcur + (bR0 ^ (ni << 5)) + 2048)));
            bfr[ni] = __builtin_shufflevector(lo, hi, 0, 1, 2, 3, 4, 5, 6, 7); }
#pragma unroll
        for (int mi = 0; mi < 8; ++mi) af[mi] = *(const LAS bf16x8*)(lds + G2_A + st * 16384 + aR + mi * 1024);
        __builtin_amdgcn_sched_barrier(0);
        if (t + 1 < nkt) G2_WRITE_B(bnxt, t + 1);
        if (t + 2 < nkt) { G2_ISSUE_B(t + 2); G2_DMA_A(t + 2, st2); }
        if (t + 2 < nkt) asm volatile("s_waitcnt vmcnt(6) lgkmcnt(0)" ::: "memory"); else asm volatile("s_waitcnt vmcnt(0) lgkmcnt(0)" ::: "memory");
        __builtin_amdgcn_s_barrier(); asm volatile("" ::: "memory");
        __builtin_amdgcn_s_setprio(1);
#pragma unroll
        for (int mi = 0; mi < 8; ++mi) {
#pragma unroll
            for (int ni = 0; ni < 4; ++ni) acc[mi][ni] = __builtin_amdgcn_mfma_f32_16x16x32_bf16(bfr[ni], af[mi], acc[mi][ni], 0, 0, 0); }
        __builtin_amdgcn_s_setprio(0);
        asm volatile("" ::: "memory"); __builtin_amdgcn_s_barrier(); asm volatile("" ::: "memory");
        st = (st == 2) ? 0 : st + 1; st2 = (st2 == 2) ? 0 : st2 + 1;
    }
    if (!grp) { __builtin_amdgcn_s_barrier(); asm volatile("" ::: "memory"); }
#undef G2_DMA_A
#undef G2_ISSUE_B
#undef G2_WRITE_B
#undef G2_COMPUTE
}

struct TileSrc2b { const bf16_t* arow[2]; const bf16_t* brow[2]; int SA, ldb, nkt; };
constexpr int G3_A = 0  , G3_B = 49152  ;
__device__ __forceinline__ void gemm_tile2b(ldsp_t lds, const TileSrc2b& s, f32x4 (&acc)[8][4], const int nmi = 8) {
    int tid = threadIdx.x; asm volatile("" : "+v"(tid));
    const int lane = tid & 63, wave = __builtin_amdgcn_readfirstlane(tid >> 6);
    const int wm0 = (wave >> 2) * 128, wn = wave & 3;
    const int r = lane & 15, g = lane >> 4;
    const unsigned aR = (unsigned)((wm0 + r) * 64 + ((g ^ f4((r >> 2) & 3)) << 4));
    const int q = r >> 2, pp = r & 3, sR = q | ((g & 1) << 2);
    const unsigned bR0 = (unsigned)((8 * g + q) * 512 + (((wn * 4) ^ sR) << 5) + 8 * pp);
#pragma unroll
    for (int mi = 0; mi < 8; ++mi)
#pragma unroll
        for (int ni = 0; ni < 4; ++ni) acc[mi][ni] = (f32x4){0.f, 0.f, 0.f, 0.f};
    const unsigned ldsbase = (unsigned)(unsigned long long)lds;
    const unsigned dmaw = ldsbase + (unsigned)wave * 1024u;
#define G3_DMA(t, stage) do { const int _k0 = (t) * 32; const int _ao = (_k0 >> 7) * s.SA + (_k0 & 127); \
        _Pragma("unroll") for (int i = 0; i < 2; ++i) glds16_asm(s.arow[i] + _ao, dmaw + G3_A + (unsigned)(stage) * 16384u + i * 8192u); \
        _Pragma("unroll") for (int i = 0; i < 2; ++i) glds16_asm(s.brow[i] + (size_t)_k0 * s.ldb, dmaw + G3_B + (unsigned)(stage) * 16384u + i * 8192u); } while (0)
    const int nkt = s.nkt;
    const int grp = wave >> 2;
    __syncthreads();
    G3_DMA(0, 0); G3_DMA(1, 1);
    asm volatile("s_waitcnt vmcnt(4)" ::: "memory");
    __syncthreads();
    if (grp) { __builtin_amdgcn_s_barrier(); asm volatile("" ::: "memory"); }
    int st = 0, st2 = 2;
    for (int t = 0; t < nkt; ++t) {
        if (t + 2 < nkt) G3_DMA(t + 2, st2);
        bf16x8 bfr[4], af[8];
#pragma unroll
        for (int ni = 0; ni < 4; ++ni) {
            const s16x4 lo = __builtin_bit_cast(s16x4, __builtin_amdgcn_ds_read_tr16_b64_v4i16((LAS s16x4*)(lds + G3_B + st * 16384 + (bR0 ^ (ni << 5)))));
            const s16x4 hi = __builtin_bit_cast(s16x4, __builtin_amdgcn_ds_read_tr16_b64_v4i16((LAS s16x4*)(lds + G3_B + st * 16384 + (bR0 ^ (ni << 5)) + 2048)));
            bfr[ni] = __builtin_shufflevector(lo, hi, 0, 1, 2, 3, 4, 5, 6, 7); }
#pragma unroll
        for (int mi = 0; mi < 8; ++mi) af[mi] = *(const LAS bf16x8*)(lds + G3_A + st * 16384 + aR + mi * 1024);
        if (t + 2 < nkt) asm volatile("s_waitcnt vmcnt(4) lgkmcnt(0)" ::: "memory"); else asm volatile("s_waitcnt vmcnt(0) lgkmcnt(0)" ::: "memory");
        __builtin_amdgcn_s_barrier(); asm volatile("" ::: "memory");
        __builtin_amdgcn_s_setprio(1);
#pragma unroll
        for (int mi = 0; mi < 8; ++mi) {
#pragma unroll
            for (int ni = 0; ni < 4; ++ni) acc[mi][ni] = __builtin_amdgcn_mfma_f32_16x16x32_bf16(bfr[ni], af[mi], acc[mi][ni], 0, 0, 0); }
        __builtin_amdgcn_s_setprio(0);
        asm volatile("" ::: "memory"); __builtin_amdgcn_s_barrier(); asm volatile("" ::: "memory");
        st = (st == 2) ? 0 : st + 1; st2 = (st2 == 2) ? 0 : st2 + 1;
    }
    if (!grp) { __builtin_amdgcn_s_barrier(); asm volatile("" ::: "memory"); }
#undef G3_DMA
}
__device__ __forceinline__ void b_src_setup(TileSrc2b& s, const bf16_t* Bbase, int ldb, int n0, int ncols, int tid) {
    const int lane = tid & 63, wave = tid >> 6;
#pragma unroll
    for (int j = 0; j < 2; ++j) {
        const int k = 2 * (8 * j + wave) + (lane >> 5), slot = lane & 31;
        const int piece = (((slot >> 1) ^ ((k & 3) | (((k >> 3) & 1) << 2))) << 1) | (slot & 1);
        int col = n0 + piece * 8; if (col > ncols - 8) col = ncols - 8;
        s.brow[j] = Bbase + (size_t)k * ldb + col;
    }
}

__device__ __forceinline__ int vcu_of_block() { const int G = gridDim.x, bx = blockIdx.x; return (G % 8 == 0) ? (bx % 8) * (G / 8) + bx / 8 : bx; }


__device__ __forceinline__ void moe_offsets256(const Params& p, LAS int* li) {
    const unsigned* ctl = (const unsigned*)(p.ws + WS_CTL);
    __syncthreads();
    if (threadIdx.x < 32) li[threadIdx.x] = (int)__hip_atomic_load(ctl + CW_CNT + 64 * threadIdx.x, __ATOMIC_RELAXED, __HIP_MEMORY_SCOPE_AGENT);
    __syncthreads();
    if (threadIdx.x == 0) { int o = 0, tt = 0; for (int e = 0; e < 32; ++e) { li[32 + e] = o; li[72 + e] = tt; o += li[e]; tt += (li[e] + 255) / 256; } li[64] = o; li[104] = tt; }
    __syncthreads();
}


constexpr int NA_KV = 32768;
constexpr int NA_PBH = 65536;
constexpr int NA_SELM = NA_PBH + 32768;
constexpr float NA_C = 0.08838834764831845f * 1.4426950408889634f;

struct NaTile { const bf16_t* k; const bf16_t* v; };
#define NA_ISSUE(tile, rs) do { _Pragma("unroll") for (int i = 0; i < 2; ++i) { const size_t _o = (size_t)((tid >> 4) + 32 * i) * (rs) + (tid & 15) * 8; \
        rk[i] = *(const u32x4*)((tile).k + _o); rv[i] = *(const u32x4*)((tile).v + _o); } } while (0)
#define NA_WRITE(buf) do { _Pragma("unroll") for (int i = 0; i < 2; ++i) { const int _key = (tid >> 4) + 32 * i, _ch = tid & 15; \
        *(LAS u32x4*)(lds + (buf) * NA_KV + _key * 256 + ((_ch ^ (_key & 15)) << 4)) = rk[i]; \
        *(LAS u32x4*)(lds + (buf) * NA_KV + 16384 + _key * 256 + (((_ch >> 1) ^ (_key & 7)) << 5) + (_ch & 1) * 16) = rv[i]; } } while (0)

__device__ __forceinline__ void na_tile(ldsp_t img, const bf16x8 (&qf)[4], const unsigned (&kR)[4], unsigned vB, int sv, int g,
                                        float& m, float& l, f32x4 (&o)[8], bool need_mask, int key0, int lo, int hi, f32x4 (&p)[4], float& alpha_out) {
    f32x4 sc[4];
#pragma unroll
    for (int kt = 0; kt < 4; ++kt) { sc[kt] = (f32x4){0.f, 0.f, 0.f, 0.f};
#pragma unroll
        for (int ks = 0; ks < 4; ++ks) { const bf16x8 kf = *(const LAS bf16x8*)(img + kt * 4096 + kR[ks]); sc[kt] = __builtin_amdgcn_mfma_f32_16x16x32_bf16(kf, qf[ks], sc[kt], 0, 0, 0); } }
    float mx = -INFINITY;
#pragma unroll
    for (int kt = 0; kt < 4; ++kt)
#pragma unroll
        for (int i = 0; i < 4; ++i) { float v = sc[kt][i] * NA_C; if (need_mask) { const int key = key0 + 16 * kt + 4 * g + i; v = (key >= lo && key <= hi) ? v : -INFINITY; } sc[kt][i] = v; mx = fmaxf(mx, v); }
    mx = fmaxf(mx, __shfl_xor(mx, 16)); mx = fmaxf(mx, __shfl_xor(mx, 32));
    const float mn = fmaxf(m, mx), mu = (mn == -INFINITY) ? 0.f : mn;
    const float alpha = __builtin_amdgcn_exp2f(m - mu);
    float ls = 0.f;
#pragma unroll
    for (int kt = 0; kt < 4; ++kt)
#pragma unroll
        for (int i = 0; i < 4; ++i) { const float e = __builtin_amdgcn_exp2f(sc[kt][i] - mu); p[kt][i] = e; ls += e; }
    l = l * alpha + ls; m = mn; alpha_out = alpha;
    if (!__all(alpha == 1.f)) {
#pragma unroll
        for (int dt = 0; dt < 8; ++dt) o[dt] = o[dt] * alpha;
    }
    bf16x8 pf[2];
#pragma unroll
    for (int kk = 0; kk < 2; ++kk) { u32x4 w; w.x = cvt_pk_bf16(p[2 * kk][0], p[2 * kk][1]); w.y = cvt_pk_bf16(p[2 * kk][2], p[2 * kk][3]);
        w.z = cvt_pk_bf16(p[2 * kk + 1][0], p[2 * kk + 1][1]); w.w = cvt_pk_bf16(p[2 * kk + 1][2], p[2 * kk + 1][3]); pf[kk] = __builtin_bit_cast(bf16x8, w); }
#pragma unroll
    for (int dt = 0; dt < 8; ++dt) {
        const unsigned va = 16384u + vB + (unsigned)((dt ^ sv) << 5);
#pragma unroll
        for (int kk = 0; kk < 2; ++kk) {
            const s16x4 lo4 = __builtin_bit_cast(s16x4, __builtin_amdgcn_ds_read_tr16_b64_v4i16((LAS s16x4*)(img + va + kk * 8192)));
            const s16x4 hi4 = __builtin_bit_cast(s16x4, __builtin_amdgcn_ds_read_tr16_b64_v4i16((LAS s16x4*)(img + va + kk * 8192 + 4096)));
            const bf16x8 vf = __builtin_shufflevector(lo4, hi4, 0, 1, 2, 3, 4, 5, 6, 7);
            o[dt] = __builtin_amdgcn_mfma_f32_16x16x32_bf16(vf, pf[kk], o[dt], 0, 0, 0);
        }
    }
}

__device__ __forceinline__ void nsa_unit(const Params& p, ldsp_t lds, int u) {
    const bf16_t* PROJ = (const bf16_t*)(p.ws + WS_PROJ);
    const bf16_t* KC = (const bf16_t*)(p.ws + WS_KC);
    const bf16_t* VC = (const bf16_t*)(p.ws + WS_VC);
    bf16_t* MIXIN = (bf16_t*)(p.ws + WS_MIXIN);
    const int tid = threadIdx.x, lane = tid & 63, wave = __builtin_amdgcn_readfirstlane(tid >> 6);
    const int tb = 127 - (u >> 2), b = (u >> 1) & 1, grp = u & 1;
    const int t0 = 32 * tb, cur = t0 >> 6;
    const int hh = wave >> 1, th = wave & 1, qi = lane & 15, g = lane >> 4;
    const int tq = t0 + 16 * th + qi;
    const size_t rowq = (size_t)b * T + tq;
    const int head = grp * 4 + hh;
    bf16x8 qf[4];
#pragma unroll
    for (int ks = 0; ks < 4; ++ks) qf[ks] = *(const bf16x8*)(PROJ + rowq * DIN + C_NQ + head * 128 + 32 * ks + 8 * g);
    const float g0 = sigmoid_f(bf2f(PROJ[rowq * DIN + C_NGT + head * 3 + 0])), g1 = sigmoid_f(bf2f(PROJ[rowq * DIN + C_NGT + head * 3 + 1])), g2 = sigmoid_f(bf2f(PROJ[rowq * DIN + C_NGT + head * 3 + 2]));
    unsigned kR[4];
#pragma unroll
    for (int ks = 0; ks < 4; ++ks) kR[ks] = (unsigned)(qi * 256 + (((4 * ks + g) ^ qi) << 4));
    const int qq = qi >> 2, pp = qi & 3;
    const unsigned vB = (unsigned)((4 * g + qq) * 256 + 8 * pp);
    const int sv = ((4 * g + qq) & 7);
    u32x4 rk[2], rv[2];
    f32x4 o[8], outacc[8], pt[4];
    float m, l, alpha;
    const int nvis_q = tq >= 31 ? (tq - 31) / 16 + 1 : 0;
    const int nvis_max = t0 / 16 + 1;
    const int ntl = (min(nvis_max, NCMP) + 63) >> 6;
    float pb[17];
#pragma unroll
    for (int i = 0; i < 17; ++i) pb[i] = 0.f;
#pragma unroll
    for (int dt = 0; dt < 8; ++dt) o[dt] = (f32x4){0.f, 0.f, 0.f, 0.f};
    m = -INFINITY; l = 0.f;
    const bf16_t* kc0 = KC + ((size_t)b * 256 * 2 + grp) * 128; const bf16_t* vc0 = VC + ((size_t)b * 256 * 2 + grp) * 128;
    __syncthreads();
    { NaTile t0_{kc0, vc0}; NA_ISSUE(t0_, 256); NA_WRITE(0); if (ntl > 1) { NaTile t1_{kc0 + 64 * 256, vc0 + 64 * 256}; NA_ISSUE(t1_, 256); } }
#pragma unroll
    for (int tl = 0; tl < 4; ++tl) {
        if (tl < ntl) {
            __syncthreads();
            if (tl + 1 < ntl) NA_WRITE((tl + 1) & 1);
            if (tl + 2 < ntl) { NaTile t2_{kc0 + (size_t)(tl + 2) * 64 * 256, vc0 + (size_t)(tl + 2) * 64 * 256}; NA_ISSUE(t2_, 256); }
            na_tile(lds + (tl & 1) * NA_KV, qf, kR, vB, sv, g, m, l, o, true, 64 * tl, 0, nvis_q - 1, pt, alpha);
#pragma unroll
            for (int i = 0; i < 17; ++i) pb[i] *= alpha;
#pragma unroll
            for (int kt = 0; kt < 4; ++kt) {
                const float s4 = (pt[kt][0] + pt[kt][1]) + (pt[kt][2] + pt[kt][3]);
                const float recv = __shfl(pt[kt][3], (lane + 48) & 63);
                pb[tl * 4 + kt] += s4 + (g >= 1 ? recv : 0.f);
                pb[tl * 4 + kt + 1] += (g == 0 ? recv : 0.f);
            }
        }
    }
    {
        float lr = l; lr += __shfl_xor(lr, 16); lr += __shfl_xor(lr, 32);
        const float inv = lr > 0.f ? 1.f / lr : 0.f;
#pragma unroll
        for (int dt = 0; dt < 8; ++dt) outacc[dt] = o[dt] * (inv * g0);
        LAS float* pbh = (LAS float*)(lds + NA_PBH) + (hh * 32 + 16 * th + qi) * 64;
#pragma unroll
        for (int i = 0; i < 16; ++i) pbh[4 * i + g] = pb[i] * inv;
    }
    __syncthreads();
    {
        const LAS float* pball = (const LAS float*)(lds + NA_PBH);
        LAS unsigned long long* selm = (LAS unsigned long long*)(lds + NA_SELM);
#pragma unroll 1
        for (int tt = 0; tt < 4; ++tt) {
            const int tok = 4 * wave + tt;
            const float v = (pball[(0 * 32 + tok) * 64 + lane] + pball[(1 * 32 + tok) * 64 + lane]) + (pball[(2 * 32 + tok) * 64 + lane] + pball[(3 * 32 + tok) * 64 + lane]);
            const bool forced = (lane == 0) || (lane == cur) || (lane == cur - 1);
            const float score = forced ? INFINITY : (lane <= cur ? v : -INFINITY);
            int rank = 0;
            for (int i = 0; i < 64; ++i) { const float w = __shfl(score, i); rank += (w > score || (w == score && i < lane)) ? 1 : 0; }
            const unsigned long long mk = __ballot(rank < 16);
            if (lane == 0) selm[tok] = mk;
        }
    }
    __syncthreads();
    const unsigned long long mysel = ((const LAS unsigned long long*)(lds + NA_SELM))[16 * th + qi];
    {
#pragma unroll
        for (int dt = 0; dt < 8; ++dt) o[dt] = (f32x4){0.f, 0.f, 0.f, 0.f};
        m = -INFINITY; l = 0.f;
        const bf16_t* kb = PROJ + (size_t)b * T * DIN + C_KSL + grp * 128; const bf16_t* vb = PROJ + (size_t)b * T * DIN + C_VSL + grp * 128;
        const int n = cur + 1;
        { NaTile a{kb, vb}; NA_ISSUE(a, DIN); NA_WRITE(0); if (n > 1) { NaTile c{kb + (size_t)64 * DIN, vb + (size_t)64 * DIN}; NA_ISSUE(c, DIN); } }
        for (int j = 0; j < n; ++j) {
            __syncthreads();
            if (j + 1 < n) NA_WRITE((j + 1) & 1);
            if (j + 2 < n) { NaTile c{kb + (size_t)(j + 2) * 64 * DIN, vb + (size_t)(j + 2) * 64 * DIN}; NA_ISSUE(c, DIN); }
            const bool sel = (mysel >> j) & 1ull;
            na_tile(lds + (j & 1) * NA_KV, qf, kR, vB, sv, g, m, l, o, true, 64 * j, 0, sel ? tq : -1, pt, alpha);
        }
        float lr = l; lr += __shfl_xor(lr, 16); lr += __shfl_xor(lr, 32);
        const float inv = g1 / lr;
#pragma unroll
        for (int dt = 0; dt < 8; ++dt) outacc[dt] += o[dt] * inv;
    }
    {
#pragma unroll
        for (int dt = 0; dt < 8; ++dt) o[dt] = (f32x4){0.f, 0.f, 0.f, 0.f};
        m = -INFINITY; l = 0.f;
        const bf16_t* kb = PROJ + (size_t)b * T * DIN + C_KWN + grp * 128; const bf16_t* vb = PROJ + (size_t)b * T * DIN + C_VWN + grp * 128;
        const int kb_lo = max(0, t0 - 511) >> 6, n = cur - kb_lo + 1;
        __syncthreads();
        { NaTile a{kb + (size_t)kb_lo * 64 * DIN, vb + (size_t)kb_lo * 64 * DIN}; NA_ISSUE(a, DIN); NA_WRITE(0);
          if (n > 1) { NaTile c{kb + (size_t)(kb_lo + 1) * 64 * DIN, vb + (size_t)(kb_lo + 1) * 64 * DIN}; NA_ISSUE(c, DIN); } }
        for (int j = 0; j < n; ++j) {
            __syncthreads();
            if (j + 1 < n) NA_WRITE((j + 1) & 1);
            if (j + 2 < n) { NaTile c{kb + (size_t)(kb_lo + j + 2) * 64 * DIN, vb + (size_t)(kb_lo + j + 2) * 64 * DIN}; NA_ISSUE(c, DIN); }
            const int key0 = 64 * (kb_lo + j);
            const bool need = (key0 + 63 > t0) || (key0 < t0 + 31 - 511);
            na_tile(lds + (j & 1) * NA_KV, qf, kR, vB, sv, g, m, l, o, need, key0, tq - 511, tq, pt, alpha);
        }
        float lr = l; lr += __shfl_xor(lr, 16); lr += __shfl_xor(lr, 32);
        const float inv = g2 / lr;
#pragma unroll
        for (int dt = 0; dt < 8; ++dt) outacc[dt] += o[dt] * inv;
    }
#pragma unroll
    for (int dt = 0; dt < 8; ++dt) { u32x2 w; w.x = cvt_pk_bf16(outacc[dt][0], outacc[dt][1]); w.y = cvt_pk_bf16(outacc[dt][2], outacc[dt][3]);
        *(u32x2*)(MIXIN + rowq * D + 1024 + head * 128 + 16 * dt + 4 * g) = w; }
}


__device__ __forceinline__ int sfun(int row) { return (row & 3) | (((row >> 3) & 1) << 2); }
__device__ __forceinline__ bf16x8 tr_frag(ldsp_t a, int rs4) {
    const s16x4 lo = __builtin_bit_cast(s16x4, __builtin_amdgcn_ds_read_tr16_b64_v4i16((LAS s16x4*)a));
    const s16x4 hi = __builtin_bit_cast(s16x4, __builtin_amdgcn_ds_read_tr16_b64_v4i16((LAS s16x4*)(a + rs4)));
    return __builtin_shufflevector(lo, hi, 0, 1, 2, 3, 4, 5, 6, 7);
}
__device__ __forceinline__ void gla_stage_v(ldsp_t vimg, const bf16_t* PROJ, size_t row0, int col0) {
    const int tid = threadIdx.x;
#pragma unroll
    for (int i = 0; i < 4; ++i) { const int idx = tid + 512 * i, sr = idx >> 5, ch = idx & 31;
        const u32x4 w = *(const u32x4*)(PROJ + (row0 + sr) * DIN + col0 + ch * 8);
        *(LAS u32x4*)(vimg + sr * 512 + (((ch >> 1) ^ sfun(sr)) << 5) + (ch & 1) * 16) = w; }
}

__device__ __forceinline__ void gla_a_unit(const Params& p, ldsp_t lds, int u) {
    const bf16_t* PROJ = (const bf16_t*)(p.ws + WS_PROJ);
    float* BC = (float*)(p.ws + WS_BC); float* U = (float*)(p.ws + WS_U); float* DTOT = (float*)(p.ws + WS_DTOT);
    const int tid = threadIdx.x, lane = tid & 63, wave = __builtin_amdgcn_readfirstlane(tid >> 6);
    const int b = u >> 6, h = (u >> 4) & 3, sc = u & 15;
    const size_t row0 = (size_t)b * T + sc * 256;
    LAS float* glr = (LAS float*)lds;
    LAS float* tot = (LAS float*)(lds + 16384);
    ldsp_t kimg = lds + 20480;
    ldsp_t vimg = lds + 86016;
    __syncthreads();
#pragma unroll
    for (int i = 0; i < 8; ++i) { const int idx = tid + 512 * i; glr[idx] = bf2f(PROJ[(row0 + (idx >> 4)) * DIN + C_GLR + (idx & 15)]); }
    __syncthreads();
    const int d = tid & 127, c = tid >> 7, hd = h * 128 + d;
    float w[16];
#pragma unroll
    for (int r = 0; r < 16; ++r) w[r] = p.w_gk[r * 512 + hd];
    const float bias = p.b_gk[hd];
    float cum = 0.f;
    for (int sl = 0; sl < 64; ++sl) {
        const int sr = 64 * c + sl; float x = bias;
#pragma unroll
        for (int r4 = 0; r4 < 4; ++r4) { const f32x4 gv = *(const LAS f32x4*)(glr + sr * 16 + r4 * 4); x = fmaf(gv[0], w[4 * r4], x); x = fmaf(gv[1], w[4 * r4 + 1], x); x = fmaf(gv[2], w[4 * r4 + 2], x); x = fmaf(gv[3], w[4 * r4 + 3], x); }
        cum += logsigmoid_f(x) * (1.f / 16.f);
        BC[(row0 + sr) * 512 + hd] = cum;
    }
    tot[c * 128 + d] = cum;
    __syncthreads();
    float suffix = 0.f;
    for (int c2 = c + 1; c2 < 4; ++c2) suffix += tot[c2 * 128 + d];
    if (c == 0) DTOT[(size_t)u * 128 + d] = __expf(cum + suffix);
    for (int sl = 0; sl < 64; ++sl) {
        const int sr = 64 * c + sl;
        const float bcs = BC[(row0 + sr) * 512 + hd];
        const float kv = bf2f(PROJ[(row0 + sr) * DIN + C_GK + hd]) * __expf((cum - bcs) + suffix);
        *(LAS bf16_t*)(kimg + sr * 256 + (((d >> 4) ^ sfun(sr)) << 5) + (d & 15) * 2) = f2bf(kv);
    }
    const int e0 = (wave >> 1) * 64, d0 = (wave & 1) * 64;
    const int g = lane >> 4, qq = (lane & 15) >> 2, pp = lane & 3, sR = qq | ((g & 1) << 2);
    f32x4 acc[4][4];
#pragma unroll
    for (int a = 0; a < 4; ++a)
#pragma unroll
        for (int bb = 0; bb < 4; ++bb) acc[a][bb] = (f32x4){0.f, 0.f, 0.f, 0.f};
    for (int cc = 0; cc < 4; ++cc) {
        __syncthreads();
        gla_stage_v(vimg, PROJ, row0 + 64 * cc, C_GV + h * 256);
        __syncthreads();
#pragma unroll
        for (int ks = 0; ks < 2; ++ks) {
            bf16x8 vf[4], kf[4];
            const int rl = 32 * ks + 8 * g + qq;
#pragma unroll
            for (int et = 0; et < 4; ++et) vf[et] = tr_frag(vimg + rl * 512 + ((((e0 >> 4) + et) ^ sR) << 5) + 8 * pp, 2048);
#pragma unroll
            for (int dt = 0; dt < 4; ++dt) kf[dt] = tr_frag(kimg + (64 * cc + rl) * 256 + ((((d0 >> 4) + dt) ^ sR) << 5) + 8 * pp, 1024);
#pragma unroll
            for (int et = 0; et < 4; ++et)
#pragma unroll
                for (int dt = 0; dt < 4; ++dt) acc[et][dt] = __builtin_amdgcn_mfma_f32_16x16x32_bf16(vf[et], kf[dt], acc[et][dt], 0, 0, 0);
        }
    }
    float* Uu = U + (size_t)u * 128 * 256;
#pragma unroll
    for (int et = 0; et < 4; ++et)
#pragma unroll
        for (int dt = 0; dt < 4; ++dt) *(f32x4*)(Uu + (size_t)(d0 + 16 * dt + (lane & 15)) * 256 + e0 + 16 * et + 4 * g) = acc[et][dt];
}

__device__ __forceinline__ void gla_c_unit(const Params& p, ldsp_t lds, int u) {
    const bf16_t* PROJ = (const bf16_t*)(p.ws + WS_PROJ);
    const float* BC = (const float*)(p.ws + WS_BC); const float* U = (const float*)(p.ws + WS_U); const float* DTOT = (const float*)(p.ws + WS_DTOT);
    bf16_t* MIXIN = (bf16_t*)(p.ws + WS_MIXIN);
    const int tid = threadIdx.x, lane = tid & 63, wave = __builtin_amdgcn_readfirstlane(tid >> 6);
    const int b = u >> 6, h = (u >> 4) & 3, sc = u & 15;
    const size_t row0 = (size_t)b * T + sc * 256;
    ldsp_t simg = lds;
    ldsp_t vimg = lds + 65536;
    ldsp_t qimg = lds + 98304;
    ldsp_t kimg = lds + 114688;
    ldsp_t aimg = lds + 131072;
    LAS float* ssq = (LAS float*)(lds + 139264);
    LAS float* blast = (LAS float*)(lds + 141312);
    const int g = lane >> 4, li = lane & 15, qq = li >> 2, pp = li & 3, sR = qq | ((g & 1) << 2);
    const int e0 = (wave >> 1) * 64, d0 = (wave & 1) * 64;
    f32x4 S[4][4];
#pragma unroll
    for (int a = 0; a < 4; ++a)
#pragma unroll
        for (int bb = 0; bb < 4; ++bb) S[a][bb] = (f32x4){0.f, 0.f, 0.f, 0.f};
    for (int j = 0; j < sc; ++j) {
        const float* Uj = U + (size_t)(u - sc + j) * 128 * 256; const float* Dj = DTOT + (size_t)(u - sc + j) * 128;
#pragma unroll
        for (int dt = 0; dt < 4; ++dt) { const int dd = d0 + 16 * dt + li; const float dj = Dj[dd];
#pragma unroll
            for (int et = 0; et < 4; ++et) S[et][dt] = S[et][dt] * dj + *(const f32x4*)(Uj + (size_t)dd * 256 + e0 + 16 * et + 4 * g); }
    }
    const float scale = 0.08838834764831845f;
    for (int cc = 0; cc < 4; ++cc) {
        const size_t rowc = row0 + 64 * cc;
        __syncthreads();
#pragma unroll
        for (int et = 0; et < 4; ++et)
#pragma unroll
            for (int dt = 0; dt < 4; ++dt) { const int dd = d0 + 16 * dt + li, ee = e0 + 16 * et + 4 * g;
                u32x2 w; w.x = cvt_pk_bf16(S[et][dt][0], S[et][dt][1]); w.y = cvt_pk_bf16(S[et][dt][2], S[et][dt][3]);
                *(LAS u32x2*)(simg + dd * 512 + (((ee >> 4) ^ sfun(dd)) << 5) + (ee & 15) * 2) = w; }
        { const int d = tid & 127, tq4 = tid >> 7, hd = h * 128 + d;
#pragma unroll 4
          for (int i = 0; i < 16; ++i) { const int t = 16 * tq4 + i;
              const float bc = BC[(rowc + t) * 512 + hd];
              const float qv = bf2f(PROJ[(rowc + t) * DIN + C_GQ + hd]) * scale * __expf(bc);
              const float kv = bf2f(PROJ[(rowc + t) * DIN + C_GK + hd]) * __expf(-bc);
              *(LAS bf16_t*)(qimg + t * 256 + (((d >> 3) ^ (t & 15)) << 4) + (d & 7) * 2) = f2bf(qv);
              *(LAS bf16_t*)(kimg + t * 256 + (((d >> 4) ^ sfun(t)) << 5) + (d & 15) * 2) = f2bf(kv);
              if (t == 63) blast[d] = bc; } }
        gla_stage_v(vimg, PROJ, rowc, C_GV + h * 256);
        __syncthreads();
        { const int st = wave & 3, tt0 = (wave >> 2) * 2;
          f32x4 at[2] = {(f32x4){0.f, 0.f, 0.f, 0.f}, (f32x4){0.f, 0.f, 0.f, 0.f}};
#pragma unroll
          for (int ks = 0; ks < 4; ++ks) {
              const int rs_ = 16 * st + li, ch = 4 * ks + g;
              const bf16x8 kf = *(const LAS bf16x8*)(kimg + rs_ * 256 + (((ch >> 1) ^ sfun(rs_)) << 5) + (ch & 1) * 16);
#pragma unroll
              for (int k2 = 0; k2 < 2; ++k2) { const int rt = 16 * (tt0 + k2) + li;
                  const bf16x8 qf = *(const LAS bf16x8*)(qimg + rt * 256 + ((ch ^ (rt & 15)) << 4));
                  at[k2] = __builtin_amdgcn_mfma_f32_16x16x32_bf16(kf, qf, at[k2], 0, 0, 0); } }
#pragma unroll
          for (int k2 = 0; k2 < 2; ++k2) { const int t = 16 * (tt0 + k2) + li, s0 = 16 * st + 4 * g;
              float a[4];
#pragma unroll
              for (int i = 0; i < 4; ++i) a[i] = (s0 + i <= t) ? at[k2][i] : 0.f;
              u32x2 w; w.x = cvt_pk_bf16(a[0], a[1]); w.y = cvt_pk_bf16(a[2], a[3]);
              *(LAS u32x2*)(aimg + t * 128 + (((s0 >> 3) ^ (t & 7)) << 4) + (s0 & 7) * 2) = w; } }
        __syncthreads();
        f32x4 o[2][4];
#pragma unroll
        for (int a = 0; a < 2; ++a)
#pragma unroll
            for (int bb = 0; bb < 4; ++bb) o[a][bb] = (f32x4){0.f, 0.f, 0.f, 0.f};
#pragma unroll
        for (int ks = 0; ks < 4; ++ks) {
            const int rl = 32 * ks + 8 * g + qq, ch = 4 * ks + g;
            bf16x8 sf[2], qf[4];
#pragma unroll
            for (int et = 0; et < 2; ++et) sf[et] = tr_frag(simg + rl * 512 + (((2 * wave + et) ^ sR) << 5) + 8 * pp, 2048);
#pragma unroll
            for (int tt = 0; tt < 4; ++tt) { const int rt = 16 * tt + li; qf[tt] = *(const LAS bf16x8*)(qimg + rt * 256 + ((ch ^ (rt & 15)) << 4)); }
#pragma unroll
            for (int et = 0; et < 2; ++et)
#pragma unroll
                for (int tt = 0; tt < 4; ++tt) o[et][tt] = __builtin_amdgcn_mfma_f32_16x16x32_bf16(sf[et], qf[tt], o[et][tt], 0, 0, 0);
        }
#pragma unroll
        for (int ks = 0; ks < 2; ++ks) {
            const int rl = 32 * ks + 8 * g + qq, ch = 4 * ks + g;
            bf16x8 vf[2], af[4];
#pragma unroll
            for (int et = 0; et < 2; ++et) vf[et] = tr_frag(vimg + rl * 512 + (((2 * wave + et) ^ sR) << 5) + 8 * pp, 2048);
#pragma unroll
            for (int tt = 0; tt < 4; ++tt) { const int rt = 16 * tt + li; af[tt] = *(const LAS bf16x8*)(aimg + rt * 128 + ((ch ^ (rt & 7)) << 4)); }
#pragma unroll
            for (int et = 0; et < 2; ++et)
#pragma unroll
                for (int tt = 0; tt < 4; ++tt) o[et][tt] = __builtin_amdgcn_mfma_f32_16x16x32_bf16(vf[et], af[tt], o[et][tt], 0, 0, 0);
        }
#pragma unroll
        for (int tt = 0; tt < 4; ++tt) { float q2 = 0.f;
#pragma unroll
            for (int et = 0; et < 2; ++et) q2 += (o[et][tt][0] * o[et][tt][0] + o[et][tt][1] * o[et][tt][1]) + (o[et][tt][2] * o[et][tt][2] + o[et][tt][3] * o[et][tt][3]);
            q2 += __shfl_xor(q2, 16); q2 += __shfl_xor(q2, 32);
            if (g == 0) ssq[wave * 64 + 16 * tt + li] = q2; }
        __syncthreads();
#pragma unroll
        for (int tt = 0; tt < 4; ++tt) { const int t = 16 * tt + li; float q2 = 0.f;
#pragma unroll
            for (int w8 = 0; w8 < 8; ++w8) q2 += ssq[w8 * 64 + t];
            const float rs_ = 1.f / sqrtf(q2 * (1.f / 256.f) + LN_EPS);
#pragma unroll
            for (int et = 0; et < 2; ++et) { const int ee = 32 * wave + 16 * et + 4 * g;
                const f32x4 gg = *(const f32x4*)(p.gla_g + ee);
                const u32x2 rw = *(const u32x2*)(PROJ + (rowc + t) * DIN + C_GR + h * 256 + ee);
                const float r0 = __uint_as_float(rw.x << 16), r1 = __uint_as_float(rw.x & 0xffff0000u), r2 = __uint_as_float(rw.y << 16), r3 = __uint_as_float(rw.y & 0xffff0000u);
                u32x2 w; w.x = cvt_pk_bf16(o[et][tt][0] * rs_ * gg[0] * silu_f(r0), o[et][tt][1] * rs_ * gg[1] * silu_f(r1));
                w.y = cvt_pk_bf16(o[et][tt][2] * rs_ * gg[2] * silu_f(r2), o[et][tt][3] * rs_ * gg[3] * silu_f(r3));
                *(u32x2*)(MIXIN + (rowc + t) * D + h * 256 + ee) = w; } }
        if (cc < 3) {
#pragma unroll
            for (int ks = 0; ks < 2; ++ks) {
                const int rl = 32 * ks + 8 * g + qq;
                bf16x8 vf[4], kf[4];
#pragma unroll
                for (int et = 0; et < 4; ++et) vf[et] = tr_frag(vimg + rl * 512 + ((((e0 >> 4) + et) ^ sR) << 5) + 8 * pp, 2048);
#pragma unroll
                for (int dt = 0; dt < 4; ++dt) kf[dt] = tr_frag(kimg + rl * 256 + ((((d0 >> 4) + dt) ^ sR) << 5) + 8 * pp, 1024);
#pragma unroll
                for (int et = 0; et < 4; ++et)
#pragma unroll
                    for (int dt = 0; dt < 4; ++dt) S[et][dt] = __builtin_amdgcn_mfma_f32_16x16x32_bf16(vf[et], kf[dt], S[et][dt], 0, 0, 0);
            }
#pragma unroll
            for (int dt = 0; dt < 4; ++dt) { const float dl = __expf(blast[d0 + 16 * dt + li]);
#pragma unroll
                for (int et = 0; et < 4; ++et) S[et][dt] = S[et][dt] * dl; }
        }
    }
}

__device__ __forceinline__ void ph3_mfma(const Params& p, ldsp_t lds, bool rep = false) {
    bf16_t* PROJ = (bf16_t*)(p.ws + WS_PROJ);
    const float* rope = (const float*)(p.ws + WS_ROPE);
    float* HIDP = (float*)(p.ws + WS_HIDP);
    const int tid = threadIdx.x, lane = tid & 63, wave = tid >> 6, wm0 = (wave >> 1) * 64, wn0 = (wave & 1) * 64;
    if (false) for (int i = blockIdx.x * NTHR + tid; i < NTOK * 12 * 16; i += gridDim.x * NTHR) {
        const int f = i & 15, slot = (i >> 4) % 12, row = i / (16 * 12);
        const int cb = slot < 8 ? C_NQ + slot * 128 : (slot < 10 ? C_KSL + (slot - 8) * 128 : C_KWN + (slot - 10) * 128);
        const int pos = row % T;
        const float cs = rope[pos * 16 + f], sn = rope[65536 + pos * 16 + f];
        bf16_t* q = PROJ + (size_t)row * DIN + cb;
        const float x1 = bf2f(q[f]), x2 = bf2f(q[16 + f]);
        q[f] = f2bf(x1 * cs - x2 * sn); q[16 + f] = f2bf(x2 * cs + x1 * sn);
    }
    for (int u = blockIdx.x; u < 256; u += gridDim.x) {
        if (u < 128) { gla_a_unit(p, lds, u); continue; }
        const int v = u - 128, kv = v >> 6, mt = (v >> 4) & 3, nt = (v >> 3) & 1, ks = v & 7;
        const int m0 = mt * 256, n0 = nt * 128, cbase = kv ? C_VCM : C_KCM;
        TileSrc s;
#pragma unroll
        for (int i = 0; i < 4; ++i) { int rr = m0 + (tid >> 3) + 64 * i; if (rr > 1019) rr = 1019; const int g = rr & 1, bi = rr >> 1, b = bi / 255, ii = bi % 255;
            s.arow[i] = PROJ + (size_t)(b * T + 16 * ii + 4 * ks) * DIN + cbase + g * 128 + (tid & 7) * 8; }
        s.bcol = (kv ? p.w_cv1 : p.w_ck1) + (size_t)(ks * 512) * 256 + n0 + (tid & 31) * 4; s.bvalid = true; s.SA = DIN; s.ldb = 256; s.nkt = 8;
        f32x4 acc[4][4];
        gemm_tile(lds, s, acc);
#pragma unroll
        for (int mi = 0; mi < 4; ++mi)
#pragma unroll
            for (int ni = 0; ni < 4; ++ni) *(f32x4*)(HIDP + ((size_t)(kv * 8 + ks) * 1024 + m0 + wm0 + 16 * mi + (lane & 15)) * 256 + n0 + wn0 + 16 * ni + 4 * (lane >> 4)) = acc[mi][ni];
    }
}

__device__ __forceinline__ void ph3b_mfma(const Params& p, float* lds) {
    const float* HIDP = (const float*)(p.ws + WS_HIDP);
    const float* pebp = (const float*)(p.ws + WS_PEBP);
    const float* rope = (const float*)(p.ws + WS_ROPE);
    const int tid = threadIdx.x;
    for (int u = blockIdx.x; u < 2 * 255; u += gridDim.x) {
        const int kv = u / 255, rg = u % 255;
        const float* w2 = kv ? p.w_cv2 : p.w_ck2; const float* b2 = kv ? p.b_cv2 : p.b_ck2; const float* b1 = kv ? p.b_cv1 : p.b_ck1;
        bf16_t* OUT = (bf16_t*)(p.ws + (kv ? WS_VC : WS_KC));
        __syncthreads();
        for (int i = tid; i < 4 * 256; i += NTHR) { const int n = i & 255; float v = b1[n];
#pragma unroll
            for (int rs = 0; rs < 16; ++rs) v += pebp[(kv * 16 + rs) * 256 + n];
#pragma unroll
            for (int ks = 0; ks < 8; ++ks) v += HIDP[((size_t)(kv * 8 + ks) * 1024 + rg * 4) * 256 + i];
            lds[i] = silu_f(v); }
        __syncthreads();
        const int rl = tid >> 7, d = tid & 127, rr = rg * 4 + rl;
        float sacc = b2[d];
        for (int j = 0; j < 256; ++j) sacc = fmaf(lds[rl * 256 + j], w2[j * 128 + d], sacc);
        lds[1024 + tid] = sacc;
        __syncthreads();
        const int g = rr & 1, bi = rr >> 1, b = bi / 255, n = bi % 255;
        float o = sacc;
        if (kv == 0 && d < 32) {
            const int pos = 16 * n + 31, f = d & 15;
            const float cs = rope[pos * 16 + f], sn = rope[65536 + pos * 16 + f];
            const float x1 = lds[1024 + rl * 128 + f], x2 = lds[1024 + rl * 128 + 16 + f];
            o = d < 16 ? x1 * cs - x2 * sn : x2 * cs + x1 * sn;
        }
        OUT[(((size_t)b * 256 + n) * 2 + g) * 128 + d] = f2bf(o);
    }
}

__device__ __forceinline__ void ph4_mfma(const Params& p, ldsp_t lds, int nrep_gla = 1, int nrep_nsa = 1) {
    unsigned* qh = (unsigned*)(p.ws + WS_CTL) + CW_Q;
    LAS int* nxt = (LAS int*)(lds + LDS_BYTES - 128);
    for (int r = 0; r < nrep_gla; ++r)
    for (;;) {
        __syncthreads();
        if (threadIdx.x == 0) *nxt = (int)__hip_atomic_fetch_add(qh + 128 * r, 1u, __ATOMIC_RELAXED, __HIP_MEMORY_SCOPE_AGENT);
        __syncthreads();
        const int u = *nxt;
        if (u >= 128) break;
        gla_c_unit(p, lds, u);
    }
    for (int r = 0; r < nrep_nsa; ++r)
    for (;;) {
        __syncthreads();
        if (threadIdx.x == 0) *nxt = (int)__hip_atomic_fetch_add(qh + 64 + 128 * r, 1u, __ATOMIC_RELAXED, __HIP_MEMORY_SCOPE_AGENT);
        __syncthreads();
        const int u = *nxt;
        if (u >= 512) break;
        nsa_unit(p, lds, u);
    }
}


__device__ __forceinline__ u32x4 pair16(u32x2 t0, u32x2 t1, int g) {
    const bool odd = g & 1;
    const unsigned s0 = odd ? t0.x : t1.x, s1 = odd ? t0.y : t1.y;
    const unsigned r0 = (unsigned)__shfl_xor((int)s0, 16), r1 = (unsigned)__shfl_xor((int)s1, 16);
    u32x4 o;
    o.x = odd ? r0 : t0.x; o.y = odd ? r1 : t0.y; o.z = odd ? t1.x : r0; o.w = odd ? t1.y : r1;
    return o;
}
__device__ __forceinline__ int lane_id_opaque() { int l; asm volatile("v_mbcnt_lo_u32_b32 %0, -1, 0\n\tv_mbcnt_hi_u32_b32 %0, -1, %0" : "=v"(l)); return l; }
__device__ __forceinline__ int a_src_chunk(int tid) { return ((tid & 3) ^ f4((tid >> 4) & 3)) * 8; }

__device__ __forceinline__ void ph2_v2(const Params& p, ldsp_t lds) {
    const bf16_t* H = (const bf16_t*)(p.ws + WS_H);
    bf16_t* PROJ = (bf16_t*)(p.ws + WS_PROJ);
    const int tid0 = threadIdx.x, wave = __builtin_amdgcn_readfirstlane(tid0 >> 6), wm0 = (wave >> 2) * 128, wn0 = (wave & 3) * 64;
    const int vcu = vcu_of_block();
    constexpr int NT = (DIN + 255) / 256;
    for (int u = vcu; u < 4 * 6 * 32; u += gridDim.x) {
        const int sb = u >> 5, j = u & 31, mt = (sb & 3) * 8 + (j & 7), nt = (sb >> 2) * 4 + (j >> 3);
        if (nt >= NT) continue;
        const int m0 = mt * 256, n0 = nt * 256;
        int tid = threadIdx.x; asm volatile("" : "+v"(tid));
        TileSrc2b s;
#pragma unroll
        for (int i = 0; i < 2; ++i) s.arow[i] = H + (size_t)(m0 + (tid >> 2) + 128 * i) * D + a_src_chunk(tid);
        b_src_setup(s, (const bf16_t*)(p.ws + WS_WINB), DIN, n0, DIN, tid);
        s.SA = 128; s.ldb = DIN; s.nkt = D / 32;
        f32x4 acc[8][4];
        gemm_tile2b(lds, s, acc);
        const int lane = lane_id_opaque();
        const int g = lane >> 4;
        {
          const int c0 = n0 + wn0 + 16;
          const bool is_rope = (c0 >= C_NQ && c0 < C_NQ + 1024 && ((c0 - C_NQ) & 127) == 0) || c0 == C_KSL || c0 == C_KSL + 128 || c0 == C_KWN || c0 == C_KWN + 128;
          if (is_rope) {
              const float* rope = (const float*)(p.ws + WS_ROPE);
#pragma unroll
              for (int mi = 0; mi < 8; ++mi) { const int pos = (m0 + wm0 + 16 * mi + (lane & 15)) % T;
                  const f32x4 cs = *(const f32x4*)(rope + pos * 16 + 4 * g), sn = *(const f32x4*)(rope + 65536 + pos * 16 + 4 * g);
                  const f32x4 x1 = acc[mi][1], x2 = acc[mi][2];
                  acc[mi][1] = x1 * cs - x2 * sn; acc[mi][2] = x2 * cs + x1 * sn; } } }
#pragma unroll
        for (int mi = 0; mi < 8; ++mi)
#pragma unroll
            for (int np = 0; np < 2; ++np) {
                u32x2 t0, t1; t0.x = cvt_pk_bf16(acc[mi][2 * np][0], acc[mi][2 * np][1]); t0.y = cvt_pk_bf16(acc[mi][2 * np][2], acc[mi][2 * np][3]);
                t1.x = cvt_pk_bf16(acc[mi][2 * np + 1][0], acc[mi][2 * np + 1][1]); t1.y = cvt_pk_bf16(acc[mi][2 * np + 1][2], acc[mi][2 * np + 1][3]);
                const u32x4 o = pair16(t0, t1, g);
                const int m = m0 + wm0 + 16 * mi + (lane & 15), n = n0 + wn0 + 32 * np + ((g & 1) ? 16 + 4 * (g - 1) : 4 * g);
                if (n < DIN) *(u32x4*)(PROJ + (size_t)m * DIN + n) = o;
            }
    }
}

__device__ __forceinline__ void ph5_v2(const Params& p, ldsp_t lds) {
    const bf16_t* MIXIN = (const bf16_t*)(p.ws + WS_MIXIN);
    const float* mod = (const float*)(p.ws + WS_MOD);
    float* Z = (float*)(p.ws + WS_Z);
    const int tid0 = threadIdx.x, wave = __builtin_amdgcn_readfirstlane(tid0 >> 6), wm0 = (wave >> 2) * 128, wn0 = (wave & 3) * 64;
    const int vcu = vcu_of_block();
    for (int u = vcu; u < 32 * 8; u += gridDim.x) {
        const int sb = u >> 5, j = u & 31, mt = (sb & 3) * 8 + (j & 7), nt = (sb >> 2) * 4 + (j >> 3);
        const int m0 = mt * 256, n0 = nt * 256;
        int tid = threadIdx.x; asm volatile("" : "+v"(tid));
        TileSrc2b s;
#pragma unroll
        for (int i = 0; i < 2; ++i) s.arow[i] = MIXIN + (size_t)(m0 + (tid >> 2) + 128 * i) * D + a_src_chunk(tid);
        b_src_setup(s, (const bf16_t*)(p.ws + WS_WOB), D, n0, D, tid);
        s.SA = 128; s.ldb = D; s.nkt = D / 32;
        f32x4 acc[8][4];
        gemm_tile2b(lds, s, acc);
        const int lane = lane_id_opaque();
        const int b = m0 / T;
#pragma unroll
        for (int ni = 0; ni < 4; ++ni) {
            const int n = n0 + wn0 + 16 * ni + 4 * (lane >> 4);
            const f32x4 g1 = 1.f + *(const f32x4*)(mod + b * 12288 + 2 * 2048 + n);
#pragma unroll
            for (int mi = 0; mi < 8; ++mi) { const size_t o = (size_t)(m0 + wm0 + 16 * mi + (lane & 15)) * D + n;
                *(f32x4*)(Z + o) = DN_ALPHA * *(const f32x4*)(p.x + o) + g1 * acc[mi][ni]; }
        }
    }
}

__device__ __forceinline__ void ph7_v2(const Params& p, ldsp_t lds) {
    const bf16_t* H2 = (const bf16_t*)(p.ws + WS_H);
    const int* LIST = (const int*)(p.ws + WS_LIST);
    bf16_t* ACT = (bf16_t*)(p.ws + WS_ACT);
    LAS int* li = (LAS int*)(lds + G2_LDS);
    moe_offsets256(p, li);
    const int tid0 = threadIdx.x, wave = __builtin_amdgcn_readfirstlane(tid0 >> 6), wm0 = (wave >> 2) * 128, wn = wave & 3;
    unsigned* qh = (unsigned*)(p.ws + WS_CTL) + CW_Q + 256;
    LAS int* nxt = (LAS int*)(lds + LDS_BYTES - 128);
    const int myx = (int)(xb_xcc_id() & 7u);
    for (int qi = 0; qi < 8; ++qi) {
    const int xq = (myx + qi) & 7;
    for (;;) {
        __syncthreads();
        if (threadIdx.x == 0) *nxt = (int)__hip_atomic_fetch_add(qh + 64 * xq, 1u, __ATOMIC_RELAXED, __HIP_MEMORY_SCOPE_AGENT);
        __syncthreads();
        const int u = *nxt;
        int e = xq, base = 0;
        for (; e < 32; e += 8) { const int ne = (li[72 + e + 1] - li[72 + e]) * 16; if (u < base + ne) break; base += ne; }
        if (e >= 32) break;
        const int mte = li[72 + e + 1] - li[72 + e];
        const int ul = u - base, nt = ul / mte, mt = ul % mte;
        const int cnt = li[e], off = li[32 + e], n0 = nt * 128;
        int tid = threadIdx.x; asm volatile("" : "+v"(tid));
        TileSrc2 s;
#pragma unroll
        for (int i = 0; i < 2; ++i) { int rr = mt * 256 + (tid >> 2) + 128 * i; if (rr >= cnt) rr = cnt - 1; const int slot = LIST[e * 8192 + rr]; s.arow[i] = H2 + (size_t)(slot >> 2) * D + a_src_chunk(tid); }
        { const int c = (tid & 31) * 8, w = c >> 6, jj = c & 63;
          s.bcol = (jj < 32 ? p.w_gate : p.w_up) + (size_t)e * D * DFF + n0 + 32 * w + (jj & 31); }
        s.bvalid = true; s.SA = 128; s.ldb = DFF; s.nkt = D / 32;
        f32x4 acc[8][4];
        const int nmi_ = min(8, max(0, (cnt - mt * 256 - (wave >> 2) * 128 + 15) >> 4));
        gemm_tile2(lds, s, acc, nmi_);
        const int lane = lane_id_opaque();
        { const int g = lane >> 4;
          f32x4 bg[2], bu[2];
#pragma unroll
          for (int ni = 0; ni < 2; ++ni) { const int n = n0 + 32 * wn + 16 * ni + 4 * g; bg[ni] = *(const f32x4*)(p.b_gate + e * DFF + n); bu[ni] = *(const f32x4*)(p.b_up + e * DFF + n); }
#pragma unroll
          for (int mi = 0; mi < 8; ++mi) { const int rr = mt * 256 + wm0 + 16 * mi + (lane & 15);
              u32x2 t[2];
#pragma unroll
              for (int ni = 0; ni < 2; ++ni) { float a[4];
#pragma unroll
                  for (int i = 0; i < 4; ++i) { const float gt = fminf(acc[mi][ni][i] + bg[ni][i], 7.f), up = fminf(fmaxf(acc[mi][ni + 2][i] + bu[ni][i], -7.f), 7.f); a[i] = gt * sigmoid_f(1.702f * gt) * (up + 1.f); }
                  t[ni].x = cvt_pk_bf16(a[0], a[1]); t[ni].y = cvt_pk_bf16(a[2], a[3]); }
              const u32x4 o = pair16(t[0], t[1], g);
              const int n = n0 + 32 * wn + ((g & 1) ? 16 + 4 * (g - 1) : 4 * g);
              if (rr < cnt) *(u32x4*)(ACT + (size_t)(off + rr) * DFF + n) = o; } }
    }
    }
}

__device__ __forceinline__ void ph8_v2(const Params& p, ldsp_t lds) {
    const bf16_t* ACT = (const bf16_t*)(p.ws + WS_ACT);
    const int* LIST = (const int*)(p.ws + WS_LIST);
    const float* TOPW = (const float*)(p.ws + WS_TOPW);
    bf16_t* YP = (bf16_t*)(p.ws + WS_YP);
    LAS int* li = (LAS int*)(lds + G2_LDS);
    moe_offsets256(p, li);
    const int tid0 = threadIdx.x, wave = __builtin_amdgcn_readfirstlane(tid0 >> 6), wm0 = (wave >> 2) * 128, wn0 = (wave & 3) * 64;
    unsigned* qh = (unsigned*)(p.ws + WS_CTL) + CW_Q + 256 + 512;
    LAS int* nxt = (LAS int*)(lds + LDS_BYTES - 128);
    const int myx = (int)(xb_xcc_id() & 7u);
    for (int qi = 0; qi < 8; ++qi) {
    const int xq = (myx + qi) & 7;
    for (;;) {
        __syncthreads();
        if (threadIdx.x == 0) *nxt = (int)__hip_atomic_fetch_add(qh + 64 * xq, 1u, __ATOMIC_RELAXED, __HIP_MEMORY_SCOPE_AGENT);
        __syncthreads();
        const int u = *nxt;
        int e = xq, base = 0;
        for (; e < 32; e += 8) { const int ne = (li[72 + e + 1] - li[72 + e]) * 8; if (u < base + ne) break; base += ne; }
        if (e >= 32) break;
        const int mte = li[72 + e + 1] - li[72 + e];
        const int ul = u - base, nt = ul / mte, mt = ul % mte;
        const int cnt = li[e], off = li[32 + e], n0 = nt * 256;
        int tid = threadIdx.x; asm volatile("" : "+v"(tid));
        TileSrc2 s;
#pragma unroll
        for (int i = 0; i < 2; ++i) { int rr = mt * 256 + (tid >> 2) + 128 * i; if (rr >= cnt) rr = cnt - 1; s.arow[i] = ACT + (size_t)(off + rr) * DFF + a_src_chunk(tid); }
        s.bcol = p.w_down + (size_t)e * DFF * D + n0 + (tid & 31) * 8; s.bvalid = true; s.SA = 128; s.ldb = D; s.nkt = DFF / 32;
        f32x4 acc[8][4];
        const int nmi_ = min(8, max(0, (cnt - mt * 256 - (wave >> 2) * 128 + 15) >> 4));
        gemm_tile2(lds, s, acc, nmi_);
        const int lane = lane_id_opaque();
        { const int g = lane >> 4;
          f32x4 bd[4];
#pragma unroll
          for (int ni = 0; ni < 4; ++ni) bd[ni] = *(const f32x4*)(p.b_down + e * D + n0 + wn0 + 16 * ni + 4 * g);
#pragma unroll
          for (int mi = 0; mi < 8; ++mi) { int rr = mt * 256 + wm0 + 16 * mi + (lane & 15); const bool ok = rr < cnt; if (!ok) rr = cnt - 1;
              const int slot = LIST[e * 8192 + rr]; const float w = TOPW[slot];
#pragma unroll
              for (int np = 0; np < 2; ++np) { u32x2 t[2];
#pragma unroll
                  for (int k2 = 0; k2 < 2; ++k2) { const f32x4 y = w * (acc[mi][2 * np + k2] + bd[2 * np + k2]); t[k2].x = cvt_pk_bf16(y[0], y[1]); t[k2].y = cvt_pk_bf16(y[2], y[3]); }
                  const u32x4 o = pair16(t[0], t[1], g);
                  const int n = n0 + wn0 + 32 * np + ((g & 1) ? 16 + 4 * (g - 1) : 4 * g);
                  if (ok) *(u32x4*)(YP + (size_t)slot * D + n) = o; } } }
    }
    }
}


__device__ __forceinline__ void ph6_v2(const Params& p, ldsp_t lds, const int rep = 0) {
    const float* Z = (const float*)(p.ws + WS_Z);
    const float* mod = (const float*)(p.ws + WS_MOD);
    float* X1 = (float*)(p.ws + WS_X1);
    bf16_t* H2 = (bf16_t*)(p.ws + WS_H);
    const bf16_t* WRT = (const bf16_t*)(p.ws + WS_WRT);
    float* TOPW = (float*)(p.ws + WS_TOPW + (rep ? 512 * 1024 : 0));
    int* LIST = (int*)(p.ws + WS_LIST + (rep ? MiB : 0));
    unsigned* ctl = (unsigned*)(p.ws + WS_CTL) + (rep ? 32 * 64 : 0);
    const int tid = threadIdx.x, lane = tid & 63, wave = __builtin_amdgcn_readfirstlane(tid >> 6);
    ldsp_t img_hi = lds, img_lo = lds + 65536;
    LAS float* part = (LAS float*)(lds + 131072);
    LAS float* lgt = (LAS float*)(lds + 131072 + 16384);
    for (int blk = blockIdx.x; blk < NTOK / 32; blk += gridDim.x) {
        for (int half = 0; half < 2; ++half) {
            __syncthreads();
#pragma unroll 1
            for (int rr = 0; rr < 2; ++rr) {
                const int rl = 2 * wave + rr, row = blk * 32 + half * 16 + rl, b = row / T;
                const f32x4* zr = (const f32x4*)(Z + (size_t)row * D) + lane;
                f32x4 v[8]; float s1 = 0.f;
#pragma unroll
                for (int j = 0; j < 8; ++j) { v[j] = zr[64 * j]; s1 += (v[j][0] + v[j][1]) + (v[j][2] + v[j][3]); }
                float mean = wave_sum(s1) * (1.f / D), s2 = 0.f;
#pragma unroll
                for (int j = 0; j < 8; ++j) { v[j] = v[j] - mean; s2 += (v[j][0] * v[j][0] + v[j][1] * v[j][1]) + (v[j][2] * v[j][2] + v[j][3] * v[j][3]); }
                float rstd = 1.f / sqrtf(wave_sum(s2) * (1.f / D) + LN_EPS);
                s1 = 0.f;
#pragma unroll
                for (int j = 0; j < 8; ++j) { const int c0 = 256 * j + lane * 4;
                    v[j] = v[j] * rstd * *(const f32x4*)(p.ln1_g + c0) + *(const f32x4*)(p.ln1_b + c0);
                    *(f32x4*)(X1 + (size_t)row * D + c0) = v[j];
                    s1 += (v[j][0] + v[j][1]) + (v[j][2] + v[j][3]); }
                mean = wave_sum(s1) * (1.f / D); s2 = 0.f;
#pragma unroll
                for (int j = 0; j < 8; ++j) { v[j] = v[j] - mean; s2 += (v[j][0] * v[j][0] + v[j][1] * v[j][1]) + (v[j][2] * v[j][2] + v[j][3] * v[j][3]); }
                rstd = 1.f / sqrtf(wave_sum(s2) * (1.f / D) + LN_EPS);
                u32x2* o8 = (u32x2*)(H2 + (size_t)row * D) + lane;
#pragma unroll
                for (int j = 0; j < 8; ++j) { const int c0 = 256 * j + lane * 4;
                    const f32x4 sh = *(const f32x4*)(mod + b * 12288 + 3 * 2048 + c0), sc = *(const f32x4*)(mod + b * 12288 + 4 * 2048 + c0);
                    const f32x4 h = v[j] * rstd * (1.f + sc) + sh;
                    u32x2 hi; hi.x = cvt_pk_bf16(h[0], h[1]); hi.y = cvt_pk_bf16(h[2], h[3]);
                    o8[64 * j] = hi;
                    const float r0 = h[0] - __uint_as_float(hi.x << 16), r1 = h[1] - __uint_as_float(hi.x & 0xffff0000u), r2 = h[2] - __uint_as_float(hi.y << 16), r3 = h[3] - __uint_as_float(hi.y & 0xffff0000u);
                    u32x2 lo; lo.x = cvt_pk_bf16(r0, r1); lo.y = cvt_pk_bf16(r2, r3);
                    const unsigned off = (unsigned)(rl * 4096 + ((((32 * j + (lane >> 1))) ^ (rl & 15)) << 4) + (lane & 1) * 8);
                    *(LAS u32x2*)(img_hi + off) = hi; *(LAS u32x2*)(img_lo + off) = lo; }
            }
            __syncthreads();
            { const int r = lane & 15, g = lane >> 4;
              f32x4 acc[2] = {(f32x4){0.f, 0.f, 0.f, 0.f}, (f32x4){0.f, 0.f, 0.f, 0.f}};
#pragma unroll 2
              for (int ks = 0; ks < 8; ++ks) {
                  const int k0 = 256 * wave + 32 * ks, ch = (k0 >> 3) + g;
                  const unsigned aoff = (unsigned)(r * 4096 + ((ch ^ r) << 4));
                  const bf16x8 ahi = *(const LAS bf16x8*)(img_hi + aoff), alo = *(const LAS bf16x8*)(img_lo + aoff);
#pragma unroll
                  for (int et = 0; et < 2; ++et) {
                      const bf16x8 whi = *(const bf16x8*)(WRT + (size_t)(16 * et + r) * 2048 + k0 + 8 * g);
                      const bf16x8 wlo = *(const bf16x8*)(WRT + 65536 + (size_t)(16 * et + r) * 2048 + k0 + 8 * g);
                      acc[et] = __builtin_amdgcn_mfma_f32_16x16x32_bf16(whi, ahi, acc[et], 0, 0, 0);
                      acc[et] = __builtin_amdgcn_mfma_f32_16x16x32_bf16(whi, alo, acc[et], 0, 0, 0);
                      acc[et] = __builtin_amdgcn_mfma_f32_16x16x32_bf16(wlo, ahi, acc[et], 0, 0, 0);
                  }
              }
#pragma unroll
              for (int et = 0; et < 2; ++et)
#pragma unroll
                  for (int i = 0; i < 4; ++i) part[(wave * 16 + r) * 32 + 16 * et + 4 * g + i] = acc[et][i];
            }
            __syncthreads();
            { const int rl = tid >> 5, e = tid & 31; float sum = p.b_router[e];
#pragma unroll
              for (int w8 = 0; w8 < 8; ++w8) sum += part[(w8 * 16 + rl) * 32 + e];
              lgt[rl * 32 + e] = sum; }
            __syncthreads();
            if (tid < 16) {
                const int row = blk * 32 + half * 16 + tid;
                float tv[4]; int ti[4];
#pragma unroll
                for (int k = 0; k < 4; ++k) { tv[k] = -INFINITY; ti[k] = 0; }
                for (int e = 0; e < 32; ++e) {
                    const float v = lgt[tid * 32 + e];
                    if (v > tv[3]) {
                        if (v > tv[0]) { tv[3] = tv[2]; ti[3] = ti[2]; tv[2] = tv[1]; ti[2] = ti[1]; tv[1] = tv[0]; ti[1] = ti[0]; tv[0] = v; ti[0] = e; }
                        else if (v > tv[1]) { tv[3] = tv[2]; ti[3] = ti[2]; tv[2] = tv[1]; ti[2] = ti[1]; tv[1] = v; ti[1] = e; }
                        else if (v > tv[2]) { tv[3] = tv[2]; ti[3] = ti[2]; tv[2] = v; ti[2] = e; }
                        else { tv[3] = v; ti[3] = e; }
                    }
                }
                const float e1 = __expf(tv[1] - tv[0]), e2 = __expf(tv[2] - tv[0]), e3 = __expf(tv[3] - tv[0]);
                const float isum = 1.f / (1.f + e1 + e2 + e3);
                const float ww[4] = {isum, e1 * isum, e2 * isum, e3 * isum};
#pragma unroll
                for (int k = 0; k < 4; ++k) {
                    const unsigned pos = atomicAdd(ctl + CW_CNT + 64 * ti[k], 1u);
                    LIST[ti[k] * 8192 + pos] = row * 4 + k;
                    TOPW[row * 4 + k] = ww[k];
                }
            }
        }
    }
}


constexpr int NPHASE = 11;
__global__ void __launch_bounds__(NTHR, 2) fwd_kernel(Params p) {
    extern __shared__ __attribute__((aligned(16))) unsigned char lds_raw[];
    float* lds = (float*)lds_raw;
    volatile LAS unsigned* misc = (volatile LAS unsigned*)((LAS unsigned char*)lds_raw + LDS_BYTES - 64);
    if (threadIdx.x < 16) misc[threadIdx.x] = 0u;
    __syncthreads();
    unsigned* ctl = (unsigned*)(p.ws + WS_CTL);
    const bool multi = (p.ph_hi - p.ph_lo) > 1;
    XcdBarrier bar; bar.bar = ctl + CW_BAR; bar.x = 0; bar.st = misc;
    if (multi) bar = xcd_barrier_post(ctl + CW_BAR, misc);
#define IN(k) (p.ph_lo <= (k) && (k) < p.ph_hi)
#ifndef REPEAT_PHASE
#define REPEAT_PHASE -1
#endif
#define SEAM(k) do { if (IN(k) && IN((k) + 1)) xcd_barrier(bar); } while (0)
    if (IN(0)) { ph0(p, lds); if (REPEAT_PHASE == 0) ph0(p, lds); }
    SEAM(0);
    if (IN(1)) { ph1(p, lds); if (REPEAT_PHASE == 1) ph1(p, lds); }
    SEAM(1);
    if (IN(2)) { ph2_v2(p, (ldsp_t)lds_raw); if (REPEAT_PHASE == 2) ph2_v2(p, (ldsp_t)lds_raw); }
    SEAM(2);
    if (IN(3)) { ph3_mfma(p, (ldsp_t)lds_raw); if (REPEAT_PHASE == 3) ph3_mfma(p, (ldsp_t)lds_raw, true); }
    SEAM(3);
    if (IN(4)) { ph3b_mfma(p, lds); if (REPEAT_PHASE == 4) ph3b_mfma(p, lds); }
    SEAM(4);
    if (IN(5)) ph4_mfma(p, (ldsp_t)lds_raw, REPEAT_PHASE == 50 ? 2 : 1, REPEAT_PHASE == 51 ? 2 : 1);
    SEAM(5);
    if (IN(6)) { ph5_v2(p, (ldsp_t)lds_raw); if (REPEAT_PHASE == 6) ph5_v2(p, (ldsp_t)lds_raw); }
    SEAM(6);
    if (IN(7)) { for (int r7 = 0; r7 < (REPEAT_PHASE == 7 ? 2 : 1); ++r7) ph6_v2(p, (ldsp_t)lds_raw, r7); }
    SEAM(7);
    if (IN(8)) ph7_v2(p, (ldsp_t)lds_raw);
    SEAM(8);
    if (IN(9)) ph8_v2(p, (ldsp_t)lds_raw);
    SEAM(9);
    if (IN(10)) { ph9(p, lds); if (REPEAT_PHASE == 10) ph9(p, lds); }
}

extern "C" void kernel_launch(void* const* d_in, const int* in_sizes, int n_in, void* d_out, int out_size, void* d_ws, size_t ws_size, hipStream_t stream) {
    static int grid = 0;
    if (grid == 0) {
        int dev = 0, cus = 0;
        if (hipGetDevice(&dev) != hipSuccess || hipDeviceGetAttribute(&cus, hipDeviceAttributeMultiprocessorCount, dev) != hipSuccess) { fprintf(stderr, "kernel_launch: device query failed\n"); grid = -1; return; }
        if (hipFuncSetAttribute((const void*)fwd_kernel, hipFuncAttributeMaxDynamicSharedMemorySize, LDS_BYTES) != hipSuccess) { fprintf(stderr, "kernel_launch: hipFuncSetAttribute failed\n"); grid = -1; return; }
        if (n_in != 31 || ws_size < WS_END) { fprintf(stderr, "kernel_launch: unexpected n_in %d / ws %zu\n", n_in, ws_size); grid = -1; return; }
        (void)hipGetLastError();
        grid = cus;
    }
    if (grid < 0) return;
    (void)hipMemsetAsync((char*)d_ws + WS_CTL, 0, CTL_BYTES, stream);
    Params p{};
    const float** f = (const float**)&p;
    for (int i = 0; i < 31; ++i) f[i] = (const float*)d_in[i];
    p.out = (float*)d_out; p.ws = (unsigned char*)d_ws;
#if N_LAUNCH_MODE == 1
    p.ph_lo = 0; p.ph_hi = NPHASE;
    hipLaunchKernelGGL(fwd_kernel, dim3(grid), dim3(NTHR), LDS_BYTES, stream, p);
#else
    for (int k = 0; k < NPHASE; ++k) { p.ph_lo = k; p.ph_hi = k + 1; hipLaunchKernelGGL(fwd_kernel, dim3(grid), dim3(NTHR), LDS_BYTES, stream, p); }
#endif
}
```

```cpp
#include <hip/hip_runtime.h>
#include <stdint.h>
#include <cstdio>

#ifndef N_LAUNCH_MODE
#define N_LAUNCH_MODE 1
#endif

typedef unsigned short bf16_t;
typedef float f32x4 __attribute__((ext_vector_type(4)));
#define LAS __attribute__((address_space(3)))

constexpr int NB = 2, T = 4096, D = 2048, NTOK = NB * T;
constexpr int DIN = 5672;
constexpr int C_GQ = 0, C_GK = 512, C_GV = 1024, C_GR = 2048, C_GLR = 3072, C_NQ = 3088, C_KCM = 4112, C_VCM = 4368,
              C_KSL = 4624, C_VSL = 4880, C_KWN = 5136, C_VWN = 5392, C_NGT = 5648;
constexpr int NE = 32, TOPK = 4, DFF = 2048;
constexpr int NCMP = 255;
constexpr float LN_EPS = 1e-5f;
constexpr float DN_ALPHA = 1.189207115002721f;
constexpr int NTHR = 512;

constexpr size_t MiB = 1u << 20;
constexpr size_t WS_CTL = 0, CTL_BYTES = 1 * MiB;
constexpr size_t WS_MODP = 1 * MiB;
constexpr size_t WS_MOD = 2 * MiB;
constexpr size_t WS_ROPE = 3 * MiB;
constexpr size_t WS_PEBP = 4 * MiB;
constexpr size_t WS_KC = 5 * MiB;
constexpr size_t WS_VC = 6 * MiB;
constexpr size_t WS_H = 16 * MiB;
constexpr size_t WS_PROJ = 48 * MiB;
constexpr size_t WS_MIXIN = 144 * MiB;
constexpr size_t WS_Z = 176 * MiB;
constexpr size_t WS_X1 = 240 * MiB;
constexpr size_t WS_TOPW = 304 * MiB;
constexpr size_t WS_LIST = 305 * MiB;
constexpr size_t WS_ACT = 340 * MiB;
constexpr size_t WS_YP = 470 * MiB;
constexpr size_t WS_HIDP = 600 * MiB;
constexpr size_t WS_BC = 616 * MiB;
constexpr size_t WS_U = 632 * MiB;
constexpr size_t WS_DTOT = 648 * MiB;
constexpr size_t WS_WRT = 650 * MiB;
constexpr size_t WS_WINB = 652 * MiB;
constexpr size_t WS_WOB = 676 * MiB;
constexpr size_t WS_END = 686 * MiB;
constexpr int CW_BAR = 4096;
constexpr int CW_CNT = 8192;
constexpr int CW_Q = 12288;

constexpr int LDS_BYTES = 160 * 1024;

__device__ __forceinline__ float bf2f(bf16_t b) { return __uint_as_float(((unsigned)b) << 16); }
__device__ __forceinline__ bf16_t f2bf(float f) { unsigned u = __float_as_uint(f); u += 0x7fffu + ((u >> 16) & 1u); return (bf16_t)(u >> 16); }
__device__ __forceinline__ unsigned pk2(float lo, float hi) { return (unsigned)f2bf(lo) | ((unsigned)f2bf(hi) << 16); }
__device__ __forceinline__ float silu_f(float x) { return x / (1.f + __expf(-x)); }
__device__ __forceinline__ float sigmoid_f(float x) { return 1.f / (1.f + __expf(-x)); }
__device__ __forceinline__ float logsigmoid_f(float x) { return fminf(x, 0.f) - log1pf(__expf(-fabsf(x))); }
__device__ __forceinline__ float wave_sum(float v) {
#pragma unroll
    for (int o = 1; o < 64; o <<= 1) v += __shfl_xor(v, o);
    return v;
}
__device__ __forceinline__ float wave_max(float v) {
#pragma unroll
    for (int o = 1; o < 64; o <<= 1) v = fmaxf(v, __shfl_xor(v, o));
    return v;
}

#define XB_TMO      128
#define XB_XCNT(j)  (256  + 64 * (j))
#define XB_XSUB(j)  (1280 + 64 * (j))
#define XB_XGEN(j)  (2304 + 64 * (j))
#define XB_TOP      3328
#define XB_TOPGEN   3392
#define XCD_BAR_WORDS 3456
#define XB_SPIN_CAP (1u << 18)
__device__ __forceinline__ unsigned xb_ld(unsigned* p)              { return __hip_atomic_load(p, __ATOMIC_RELAXED, __HIP_MEMORY_SCOPE_AGENT); }
__device__ __forceinline__ unsigned xb_add(unsigned* p, unsigned v) { return __hip_atomic_fetch_add(p, v, __ATOMIC_RELAXED, __HIP_MEMORY_SCOPE_AGENT); }
__device__ __forceinline__ unsigned xb_xcc_id() { return (unsigned)__builtin_amdgcn_s_getreg((3 << 11) | 20) & 0xFu; }
#define XB_SPIN(cond, bar) do { unsigned _sp = 0; while (cond) { __builtin_amdgcn_s_sleep(1); \
    if ((++_sp & 255u) == 0u) { if (xb_ld(&(bar)[XB_TMO])) break; if (_sp > XB_SPIN_CAP) { atomicAdd(&(bar)[XB_TMO], 1u); break; } } } } while (0)
struct XcdBarrier { unsigned* bar; unsigned x; volatile LAS unsigned* st; };
__device__ __forceinline__ XcdBarrier xcd_barrier_post(unsigned* bar, volatile LAS unsigned* st) {
    XcdBarrier b; b.bar = bar; b.x = xb_xcc_id(); b.st = st;
    if (threadIdx.x == 0) (void)xb_add(&bar[XB_XCNT(b.x)], 1u);
    return b;
}
__device__ __forceinline__ void xcd_barrier_complete(unsigned* bar, unsigned x, unsigned& nloc, unsigned& nx) {
    const unsigned G = gridDim.x * gridDim.y * gridDim.z;
    unsigned sum, cnt, mine, sp = 0u;
    for (;;) {
        sum = 0u; cnt = 0u; mine = 0u;
#pragma unroll
        for (unsigned j = 0; j < 16; ++j) { const unsigned c = xb_ld(&bar[XB_XCNT(j)]); sum += c; cnt += (c > 0u) ? 1u : 0u; mine = (j == x) ? c : mine; }
        if (sum == G) break;
        __builtin_amdgcn_s_sleep(1);
        if ((++sp & 255u) == 0u) { if (xb_ld(&bar[XB_TMO])) break; if (sp > XB_SPIN_CAP) { atomicAdd(&bar[XB_TMO], 1u); break; } }
    }
    nloc = mine > 0u ? mine : 1u; nx = cnt > 0u ? cnt : 1u;
}
__device__ __forceinline__ void xcd_barrier(const XcdBarrier& b) {
    asm volatile("s_waitcnt vmcnt(0)" ::: "memory");
    __syncthreads();
    if (threadIdx.x == 0) {
        unsigned* bar = b.bar;
        __builtin_amdgcn_s_waitcnt(0);
        unsigned nloc = b.st[0], nx = b.st[1];
        if (nloc == 0u) { xcd_barrier_complete(bar, b.x, nloc, nx); b.st[0] = nloc; b.st[1] = nx; }
        const unsigned old = xb_add(&bar[XB_XSUB(b.x)], 1u);
        const unsigned gen = old / nloc;
        if (old + 1u == (gen + 1u) * nloc) {
            __builtin_amdgcn_fence(__ATOMIC_RELEASE, "agent");
            asm volatile("s_waitcnt vmcnt(0)" ::: "memory");
            const unsigned og = xb_add(&bar[XB_TOP], 1u);
            const unsigned tg = og / nx;
            if (og + 1u == (tg + 1u) * nx) xb_add(&bar[XB_TOPGEN], 1u);
            else XB_SPIN(xb_ld(&bar[XB_TOPGEN]) == tg, bar);
            __builtin_amdgcn_fence(__ATOMIC_ACQUIRE, "agent");
            xb_add(&bar[XB_XGEN(b.x)], 1u);
            asm volatile("s_waitcnt vmcnt(0)" ::: "memory");
        } else {
            XB_SPIN(xb_ld(&bar[XB_XGEN(b.x)]) == gen, bar);
            __builtin_amdgcn_fence(__ATOMIC_ACQUIRE, "agent");
            asm volatile("s_waitcnt vmcnt(0)" ::: "memory");
        }
    }
    __syncthreads();
}

struct Params {
    const float *x, *c, *w_ada, *b_ada, *w_in, *w_gk, *b_gk, *gla_g, *pe_k, *pe_v;
    const float *w_ck1, *b_ck1, *w_ck2, *b_ck2, *w_cv1, *b_cv1, *w_cv2, *b_cv2, *w_o, *ln1_g, *ln1_b;
    const float *w_router, *b_router, *w_gate, *b_gate, *w_up, *b_up, *w_down, *b_down, *ln2_g, *ln2_b;
    float* out; unsigned char* ws;
    int ph_lo, ph_hi;
};


__device__ __forceinline__ void ph0(const Params& p, float* lds) {
    const int tid = threadIdx.x, lane = tid & 63, wave = tid >> 6;
    float* modp = (float*)(p.ws + WS_MODP);
    float* rope = (float*)(p.ws + WS_ROPE);
    float* pebp = (float*)(p.ws + WS_PEBP);
    for (int u = blockIdx.x; u < 384; u += gridDim.x) {
        const int cb = u % 48, kc = u / 48;
        const int col = cb * 256 + lane * 4, kb = kc * 256 + wave * 32;
        f32x4 a0 = {0.f, 0.f, 0.f, 0.f}, a1 = {0.f, 0.f, 0.f, 0.f};
#pragma unroll 8
        for (int k = kb; k < kb + 32; ++k) {
            const f32x4 w = *(const f32x4*)(p.w_ada + (size_t)k * 12288 + col);
            const float s0 = silu_f(p.c[k]), s1 = silu_f(p.c[D + k]);
            a0 += s0 * w; a1 += s1 * w;
        }
        __syncthreads();
        *(f32x4*)(lds + (wave * 2 + 0) * 256 + lane * 4) = a0;
        *(f32x4*)(lds + (wave * 2 + 1) * 256 + lane * 4) = a1;
        __syncthreads();
        { const int b = tid >> 8, cc = tid & 255; float s = 0.f;
#pragma unroll
          for (int w = 0; w < 8; ++w) s += lds[(w * 2 + b) * 256 + cc];
          modp[((size_t)kc * 2 + b) * 12288 + cb * 256 + cc] = s; }
    }
    for (int i = blockIdx.x * NTHR + tid; i < 4096 * 16; i += gridDim.x * NTHR) {
        const int pos = i >> 4, f = i & 15;
        const double inv = pow(500000.0, -(double)f / 16.0);
        const double ang = (double)pos * inv;
        rope[i] = (float)cos(ang); rope[65536 + i] = (float)sin(ang);
    }
    { bf16_t* winb = (bf16_t*)(p.ws + WS_WINB); bf16_t* wob = (bf16_t*)(p.ws + WS_WOB);
      const size_t n1 = (size_t)D * DIN / 8, n2 = (size_t)D * D / 8;
      for (size_t i = (size_t)blockIdx.x * NTHR + tid; i < n1 + n2; i += (size_t)gridDim.x * NTHR) {
          const float* src = i < n1 ? p.w_in + i * 8 : p.w_o + (i - n1) * 8; bf16_t* dst = i < n1 ? winb + i * 8 : wob + (i - n1) * 8;
          const f32x4 a = *(const f32x4*)src, b = *(const f32x4*)(src + 4);
          uint4 o; o.x = pk2(a[0], a[1]); o.y = pk2(a[2], a[3]); o.z = pk2(b[0], b[1]); o.w = pk2(b[2], b[3]);
          *(uint4*)dst = o; } }
    { bf16_t* wrt = (bf16_t*)(p.ws + WS_WRT);
      for (int i = blockIdx.x * NTHR + tid; i < 2048 * 32; i += gridDim.x * NTHR) {
          const int k = i >> 5, e = i & 31; const float w = p.w_router[i];
          const bf16_t hi = f2bf(w); const bf16_t lo = f2bf(w - bf2f(hi));
          wrt[e * 2048 + k] = hi; wrt[65536 + e * 2048 + k] = lo; } }
    for (int u = blockIdx.x; u < 32; u += gridDim.x) {
        const int kv = u >> 4, rs = u & 15;
        const float* w1 = kv ? p.w_cv1 : p.w_ck1; const float* pe = kv ? p.pe_v : p.pe_k;
        const int j = tid & 255, half = tid >> 8;
        float s = 0.f;
        for (int r = rs * 256 + half * 128; r < rs * 256 + half * 128 + 128; ++r) s = fmaf(pe[r], w1[(size_t)r * 256 + j], s);
        __syncthreads();
        lds[tid] = s;
        __syncthreads();
        if (tid < 256) pebp[(kv * 16 + rs) * 256 + tid] = lds[tid] + lds[tid + 256];
    }
}

__device__ __forceinline__ void ph1(const Params& p, float* lds) {
    const int tid = threadIdx.x, lane = tid & 63, wave = tid >> 6;
    const float* modp = (const float*)(p.ws + WS_MODP);
    float* mod = (float*)(p.ws + WS_MOD);
    bf16_t* H = (bf16_t*)(p.ws + WS_H);
    for (int i = blockIdx.x * NTHR + tid; i < 2 * 12288; i += gridDim.x * NTHR) {
        const int b = i / 12288, col = i % 12288;
        float v = p.b_ada[col];
#pragma unroll
        for (int kc = 0; kc < 8; ++kc) v += modp[((size_t)kc * 2 + b) * 12288 + col];
        mod[i] = v;
    }
    const int rpb = (((NTOK + (int)gridDim.x - 1) / (int)gridDim.x) + 7) & ~7;
    int cached_b = -1;
    for (int r0 = blockIdx.x * rpb; r0 < min(NTOK, (int)(blockIdx.x + 1) * rpb); r0 += 8) {
        const int row = r0 + wave;
        const int bb = r0 / T;
        if (bb != cached_b) {
            __syncthreads();
            for (int i = tid; i < 4096; i += NTHR) { const int seg = i >> 11, jx = i & 2047, col = seg * 2048 + jx;
                float v = p.b_ada[col];
#pragma unroll
                for (int kc = 0; kc < 8; ++kc) v += modp[((size_t)kc * 2 + bb) * 12288 + col];
                lds[i] = v; }
            __syncthreads();
            cached_b = bb;
        }
        if (row >= NTOK) continue;
        const f32x4* xr = (const f32x4*)(p.x + (size_t)row * D) + lane;
        f32x4 v[8]; float s = 0.f;
#pragma unroll
        for (int j2 = 0; j2 < 8; ++j2) { v[j2] = xr[64 * j2]; s += (v[j2][0] + v[j2][1]) + (v[j2][2] + v[j2][3]); }
        const float mean = wave_sum(s) * (1.f / D); float s2 = 0.f;
#pragma unroll
        for (int j2 = 0; j2 < 8; ++j2) { v[j2] = v[j2] - mean; s2 += (v[j2][0] * v[j2][0] + v[j2][1] * v[j2][1]) + (v[j2][2] * v[j2][2] + v[j2][3] * v[j2][3]); }
        const float rstd = 1.f / sqrtf(wave_sum(s2) * (1.f / D) + LN_EPS);
        unsigned long long* o8 = (unsigned long long*)(H + (size_t)row * D) + lane;
#pragma unroll
        for (int j2 = 0; j2 < 8; ++j2) {
            const int c0 = 256 * j2 + lane * 4;
            const f32x4 sh = *(const f32x4*)(lds + c0), sc = *(const f32x4*)(lds + 2048 + c0);
            const f32x4 y = v[j2] * rstd * (1.f + sc) + sh;
            o8[64 * j2] = (unsigned long long)pk2(y[0], y[1]) | ((unsigned long long)pk2(y[2], y[3]) << 32);
        }
    }
}


__device__ __forceinline__ void ph9(const Params& p, float* lds) {
    const float* X1 = (const float*)(p.ws + WS_X1);
    const float* mod = (const float*)(p.ws + WS_MOD);
    const bf16_t* YP = (const bf16_t*)(p.ws + WS_YP);
    const int tid = threadIdx.x, lane = tid & 63, wave = tid >> 6;
    for (int row = blockIdx.x * 8 + wave; row < NTOK; row += gridDim.x * 8) {
        const int b = row / T;
        f32x4 v[8]; float s = 0.f;
#pragma unroll
        for (int j = 0; j < 8; ++j) { const int c0 = 256 * j + lane * 4;
            f32x4 y = {0.f, 0.f, 0.f, 0.f};
#pragma unroll
            for (int k = 0; k < 4; ++k) { const unsigned long long w = *(const unsigned long long*)(YP + ((size_t)row * 4 + k) * D + c0);
                y[0] += bf2f((bf16_t)(w & 0xffff)); y[1] += bf2f((bf16_t)((w >> 16) & 0xffff)); y[2] += bf2f((bf16_t)((w >> 32) & 0xffff)); y[3] += bf2f((bf16_t)(w >> 48)); }
            const f32x4 g2 = *(const f32x4*)(mod + b * 12288 + 5 * 2048 + c0);
            v[j] = DN_ALPHA * *(const f32x4*)(X1 + (size_t)row * D + c0) + (1.f + g2) * y;
            s += (v[j][0] + v[j][1]) + (v[j][2] + v[j][3]); }
        const float mean = wave_sum(s) * (1.f / D); float s2 = 0.f;
#pragma unroll
        for (int j = 0; j < 8; ++j) { v[j] = v[j] - mean; s2 += (v[j][0] * v[j][0] + v[j][1] * v[j][1]) + (v[j][2] * v[j][2] + v[j][3] * v[j][3]); }
        const float rstd = 1.f / sqrtf(wave_sum(s2) * (1.f / D) + LN_EPS);
        const float pscale = 1.f;
#pragma unroll
        for (int j = 0; j < 8; ++j) { const int c0 = 256 * j + lane * 4;
            *(f32x4*)(p.out + (size_t)row * D + c0) = pscale * (v[j] * rstd * *(const f32x4*)(p.ln2_g + c0) + *(const f32x4*)(p.ln2_b + c0)); }
    }
}


typedef short bf16x8 __attribute__((ext_vector_type(8)));
typedef short s16x4 __attribute__((ext_vector_type(4)));
typedef unsigned u32x4 __attribute__((ext_vector_type(4)));
typedef unsigned u32x2 __attribute__((ext_vector_type(2)));
typedef LAS unsigned char* ldsp_t;
__device__ __forceinline__ unsigned cvt_pk_bf16(float lo, float hi) { unsigned r; asm volatile("v_cvt_pk_bf16_f32 %0, %1, %2" : "=v"(r) : "v"(lo), "v"(hi)); return r; }
constexpr int GT_A_BYTES = 256 * 128, GT_B_BYTES = 64 * 256;
constexpr int GT_A0 = 0, GT_A1 = GT_A_BYTES, GT_B0 = 2 * GT_A_BYTES, GT_B1 = 2 * GT_A_BYTES + GT_B_BYTES, GT_LDS = 2 * GT_A_BYTES + 2 * GT_B_BYTES;

struct TileSrc {
    const bf16_t* arow[4];
    const float* bcol;
    int SA;
    int ldb;
    int nkt;
    bool bvalid;
};

__device__ __forceinline__ void gemm_tile(ldsp_t lds, const TileSrc& s, f32x4 (&acc)[4][4]) {
    const int tid = threadIdx.x, lane = tid & 63, wave = __builtin_amdgcn_readfirstlane(tid >> 6);
    const int wm0 = (wave >> 1) * 64, wn = wave & 1;
    const int rA = tid >> 3, chA = tid & 7;
    const unsigned wA = (unsigned)(rA * 128 + ((chA ^ (rA & 7)) << 4));
    const int kB = tid >> 5, cB = (tid & 31) * 4;
    const int sB = (kB & 3) | (((kB >> 3) & 1) << 2);
    const unsigned wB = (unsigned)(kB * 256 + (((cB >> 4) ^ sB) << 5) + (cB & 15) * 2);
    const int r = lane & 15, g = lane >> 4;
    const unsigned aR0 = (unsigned)((wm0 + r) * 128 + (((g) ^ (r & 7)) << 4));
    const unsigned aR1 = (unsigned)((wm0 + r) * 128 + (((4 + g) ^ (r & 7)) << 4));
    const int q = r >> 2, pp = r & 3, sR = q | ((g & 1) << 2);
    unsigned bR[4];
#pragma unroll
    for (int ni = 0; ni < 4; ++ni) bR[ni] = (unsigned)((8 * g + q) * 256 + (((wn * 4 + ni) ^ sR) << 5) + 8 * pp);
#pragma unroll
    for (int mi = 0; mi < 4; ++mi)
#pragma unroll
        for (int ni = 0; ni < 4; ++ni) acc[mi][ni] = (f32x4){0.f, 0.f, 0.f, 0.f};
    u32x4 ra[4]; f32x4 rb[4];
    const f32x4 zero4 = {0.f, 0.f, 0.f, 0.f};
#define GT_ISSUE(t) do { const int _k0 = (t) * 64; const int _ao = (_k0 >> 7) * s.SA + (_k0 & 127); \
        _Pragma("unroll") for (int i = 0; i < 4; ++i) ra[i] = *(const u32x4*)(s.arow[i] + _ao); \
        _Pragma("unroll") for (int i = 0; i < 4; ++i) rb[i] = s.bvalid ? *(const f32x4*)(s.bcol + (size_t)(_k0 + kB + 16 * i) * s.ldb) : zero4; } while (0)
#define GT_WRITE(aoff, boff) do { \
        _Pragma("unroll") for (int i = 0; i < 4; ++i) *(LAS u32x4*)(lds + (aoff) + wA + i * 8192) = ra[i]; \
        _Pragma("unroll") for (int i = 0; i < 4; ++i) { u32x2 w; w.x = cvt_pk_bf16(rb[i][0], rb[i][1]); w.y = cvt_pk_bf16(rb[i][2], rb[i][3]); *(LAS u32x2*)(lds + (boff) + wB + i * 4096) = w; } } while (0)
#define GT_COMPUTE(aoff, boff) do { \
        _Pragma("unroll") for (int ks = 0; ks < 2; ++ks) { \
            bf16x8 af[4], bfr[4]; \
            _Pragma("unroll") for (int mi = 0; mi < 4; ++mi) af[mi] = *(const LAS bf16x8*)(lds + (aoff) + (ks ? aR1 : aR0) + mi * 2048); \
            _Pragma("unroll") for (int ni = 0; ni < 4; ++ni) { \
                const s16x4 lo = __builtin_bit_cast(s16x4, __builtin_amdgcn_ds_read_tr16_b64_v4i16((LAS s16x4*)(lds + (boff) + bR[ni] + ks * 8192))); \
                const s16x4 hi = __builtin_bit_cast(s16x4, __builtin_amdgcn_ds_read_tr16_b64_v4i16((LAS s16x4*)(lds + (boff) + bR[ni] + ks * 8192 + 1024))); \
                bfr[ni] = __builtin_shufflevector(lo, hi, 0, 1, 2, 3, 4, 5, 6, 7); } \
            _Pragma("unroll") for (int mi = 0; mi < 4; ++mi) \
                _Pragma("unroll") for (int ni = 0; ni < 4; ++ni) acc[mi][ni] = __builtin_amdgcn_mfma_f32_16x16x32_bf16(bfr[ni], af[mi], acc[mi][ni], 0, 0, 0); } } while (0)
    __syncthreads();
    GT_ISSUE(0); GT_WRITE(GT_A0, GT_B0);
    if (s.nkt > 1) GT_ISSUE(1);
    for (int t = 0; t < s.nkt; t += 2) {
        __syncthreads();
        if (t + 1 < s.nkt) GT_WRITE(GT_A1, GT_B1);
        if (t + 2 < s.nkt) GT_ISSUE(t + 2);
        GT_COMPUTE(GT_A0, GT_B0);
        if (t + 1 < s.nkt) {
            __syncthreads();
            if (t + 2 < s.nkt) GT_WRITE(GT_A0, GT_B0);
            if (t + 3 < s.nkt) GT_ISSUE(t + 3);
            GT_COMPUTE(GT_A1, GT_B1);
        }
    }
#undef GT_ISSUE
#undef GT_WRITE
#undef GT_COMPUTE
}

constexpr int G2_A = 0  , G2_B0 = 49152, G2_B1 = 65536, G2_LDS = 81920;
__device__ __forceinline__ int f4(int x) { return (0x1320 >> (4 * x)) & 3; }
struct TileSrc2 {
    const bf16_t* arow[2];
    const float* bcol;
    int SA, ldb, nkt; bool bvalid;
};
__device__ __forceinline__ void glds16_asm(const void* gsrc, unsigned lds_dst) {
    unsigned keep;
    asm volatile("s_mov_b32 %0, m0\n\ts_mov_b32 m0, %2\n\ts_nop 0\n\tglobal_load_lds_dwordx4 %1, off\n\ts_mov_b32 m0, %0" : "=&s"(keep) : "v"(gsrc), "s"(lds_dst) : "memory");
}
__device__ __forceinline__ void gemm_tile2(ldsp_t lds, const TileSrc2& s, f32x4 (&acc)[8][4], const int nmi) {
    int tid = threadIdx.x; asm volatile("" : "+v"(tid));
    const int lane = tid & 63, wave = __builtin_amdgcn_readfirstlane(tid >> 6);
    const int wm0 = (wave >> 2) * 128, wn = wave & 3;
    const int kB = 2 * (tid >> 6) + ((tid >> 5) & 1), cB = (tid & 31) * 8;
    const int r = lane & 15, g = lane >> 4;
    const unsigned aR = (unsigned)((wm0 + r) * 64 + ((g ^ f4((r >> 2) & 3)) << 4));
    const int q = r >> 2, pp = r & 3, sR = q | ((g & 1) << 2);
    const unsigned bR0 = (unsigned)((8 * g + q) * 512 + (((wn * 4) ^ sR) << 5) + 8 * pp);
    const unsigned wB0 = (unsigned)(kB * 512 + (((cB >> 4) ^ ((kB & 3) | (((kB >> 3) & 1) << 2))) << 5) + (cB & 15) * 2);
#pragma unroll
    for (int mi = 0; mi < 8; ++mi)
#pragma unroll
        for (int ni = 0; ni < 4; ++ni) acc[mi][ni] = (f32x4){0.f, 0.f, 0.f, 0.f};
    f32x4 rb[4]; u32x4 wv[2];
    const f32x4 zero4 = {0.f, 0.f, 0.f, 0.f};
    const unsigned ldsbase = (unsigned)(unsigned long long)lds;
    const unsigned dmaw = ldsbase + G2_A + (unsigned)wave * 1024u;
#define G2_DMA_A(t, stage) do { const int _k0 = (t) * 32; const int _ao = (_k0 >> 7) * s.SA + (_k0 & 127); \
        _Pragma("unroll") for (int i = 0; i < 2; ++i) glds16_asm(s.arow[i] + _ao, dmaw + (unsigned)(stage) * 16384u + i * 8192u); } while (0)
#define G2_ISSUE_B(t) do { const int _k0 = (t) * 32; \
        _Pragma("unroll") for (int i = 0; i < 2; ++i) { const float* _p = s.bcol + (size_t)(_k0 + kB + 16 * i) * s.ldb; rb[2 * i] = *(const f32x4*)_p; rb[2 * i + 1] = *(const f32x4*)(_p + 4); } } while (0)
#define G2_WRITE_B(boff, tt) do { \
        _Pragma("unroll") for (int i = 0; i < 2; ++i) { wv[i].x = cvt_pk_bf16(rb[2 * i][0], rb[2 * i][1]); wv[i].y = cvt_pk_bf16(rb[2 * i][2], rb[2 * i][3]); \
            wv[i].z = cvt_pk_bf16(rb[2 * i + 1][0], rb[2 * i + 1][1]); wv[i].w = cvt_pk_bf16(rb[2 * i + 1][2], rb[2 * i + 1][3]); \
            *(LAS u32x4*)(lds + (boff) + wB0 + i * 8192) = wv[i]; } } while (0)
    const int nkt = s.nkt;
    const int grp = wave >> 2;
    __syncthreads();
    G2_ISSUE_B(0); G2_DMA_A(0, 0); G2_DMA_A(1, 1); G2_WRITE_B(G2_B0, 0); G2_ISSUE_B(1);
    asm volatile("s_waitcnt vmcnt(4)" ::: "memory");
    __syncthreads();
    if (grp) { __builtin_amdgcn_s_barrier(); asm volatile("" ::: "memory"); }
    int st = 0, st2 = 2;
    for (int t = 0; t < nkt; ++t) {
        const int bcur = (t & 1) ? G2_B1 : G2_B0, bnxt = (t & 1) ? G2_B0 : G2_B1;
        bf16x8 bfr[4], af[8];
#pragma unroll
        for (int ni = 0; ni < 4; ++ni) {
            const s16x4 lo = __builtin_bit_cast(s16x4, __builtin_amdgcn_ds_read_tr16_b64_v4i16((LAS s16x4*)(lds + bcur + (bR0 ^ (ni << 5)))));
            const s16x4 hi = __builtin_bit_cast(s16x4, __builtin_amdgcn_ds_read_tr16_b64_v4i16((LAS s16x4*)(lds + bcur + (bR0 ^ (ni << 5)) + 2048)));
            bfr[ni] = __builtin_shufflevector(lo, hi, 0, 1, 2, 3, 4, 5, 6, 7); }
#pragma unroll
        for (int mi = 0; mi < 8; ++mi) af[mi] = *(const LAS bf16x8*)(lds + G2_A + st * 16384 + aR + mi * 1024);
        __builtin_amdgcn_sched_barrier(0);
        if (t + 1 < nkt) G2_WRITE_B(bnxt, t + 1);
        if (t + 2 < nkt) { G2_ISSUE_B(t + 2); G2_DMA_A(t + 2, st2); }
        if (t + 2 < nkt) asm volatile("s_waitcnt vmcnt(6) lgkmcnt(0)" ::: "memory"); else asm volatile("s_waitcnt vmcnt(0) lgkmcnt(0)" ::: "memory");
        __builtin_amdgcn_s_barrier(); asm volatile("" ::: "memory");
        __builtin_amdgcn_s_setprio(1);
#pragma unroll
        for (int mi = 0; mi < 8; ++mi) {
#pragma unroll
            for (int ni = 0; ni < 4; ++ni) acc[mi][ni] = __builtin_amdgcn_mfma_f32_16x16x32_bf16(bfr[ni], af[mi], acc[mi][ni], 0, 0, 0); }
        __builtin_amdgcn_s_setprio(0);
        asm volatile("" ::: "memory"); __builtin_amdgcn_s_barrier(); asm volatile("" ::: "memory");
        st = (st == 2) ? 0 : st + 1; st2 = (st2 == 2) ? 0 : st2 + 1;
    }
    if (!grp) { __builtin_amdgcn_s_barrier(); asm volatile("" ::: "memory"); }
#undef G2_DMA_A
#undef G2_ISSUE_B
#undef G2_WRITE_B
#undef G2_COMPUTE
}

struct TileSrc2b { const bf16_t* arow[2]; const bf16_t* brow[2]; int SA, ldb, nkt; };
constexpr int G3_A = 0  , G3_B = 49152  ;
__device__ __forceinline__ void gemm_tile2b(ldsp_t lds, const TileSrc2b& s, f32x4 (&acc)[8][4], const int nmi = 8) {
    int tid = threadIdx.x; asm volatile("" : "+v"(tid));
    const int lane = tid & 63, wave = __builtin_amdgcn_readfirstlane(tid >> 6);
    const int wm0 = (wave >> 2) * 128, wn = wave & 3;
    const int r = lane & 15, g = lane >> 4;
    const unsigned aR = (unsigned)((wm0 + r) * 64 + ((g ^ f4((r >> 2) & 3)) << 4));
    const int q = r >> 2, pp = r & 3, sR = q | ((g & 1) << 2);
    const unsigned bR0 = (unsigned)((8 * g + q) * 512 + (((wn * 4) ^ sR) << 5) + 8 * pp);
#pragma unroll
    for (int mi = 0; mi < 8; ++mi)
#pragma unroll
        for (int ni = 0; ni < 4; ++ni) acc[mi][ni] = (f32x4){0.f, 0.f, 0.f, 0.f};
    const unsigned ldsbase = (unsigned)(unsigned long long)lds;
    const unsigned dmaw = ldsbase + (unsigned)wave * 1024u;
#define G3_DMA(t, stage) do { const int _k0 = (t) * 32; const int _ao = (_k0 >> 7) * s.SA + (_k0 & 127); \
        _Pragma("unroll") for (int i = 0; i < 2; ++i) glds16_asm(s.arow[i] + _ao, dmaw + G3_A + (unsigned)(stage) * 16384u + i * 8192u); \
        _Pragma("unroll") for (int i = 0; i < 2; ++i) glds16_asm(s.brow[i] + (size_t)_k0 * s.ldb, dmaw + G3_B + (unsigned)(stage) * 16384u + i * 8192u); } while (0)
    const int nkt = s.nkt;
    const int grp = wave >> 2;
    __syncthreads();
    G3_DMA(0, 0); G3_DMA(1, 1);
    asm volatile("s_waitcnt vmcnt(4)" ::: "memory");
    __syncthreads();
    if (grp) { __builtin_amdgcn_s_barrier(); asm volatile("" ::: "memory"); }
    int st = 0, st2 = 2;
    for (int t = 0; t < nkt; ++t) {
        if (t + 2 < nkt) G3_DMA(t + 2, st2);
        bf16x8 bfr[4], af[8];
#pragma unroll
        for (int ni = 0; ni < 4; ++ni) {
            const s16x4 lo = __builtin_bit_cast(s16x4, __builtin_amdgcn_ds_read_tr16_b64_v4i16((LAS s16x4*)(lds + G3_B + st * 16384 + (bR0 ^ (ni << 5)))));
            const s16x4 hi = __builtin_bit_cast(s16x4, __builtin_amdgcn_ds_read_tr16_b64_v4i16((LAS s16x4*)(lds + G3_B + st * 16384 + (bR0 ^ (ni << 5)) + 2048)));
            bfr[ni] = __builtin_shufflevector(lo, hi, 0, 1, 2, 3, 4, 5, 6, 7); }
#pragma unroll
        for (int mi = 0; mi < 8; ++mi) af[mi] = *(const LAS bf16x8*)(lds + G3_A + st * 16384 + aR + mi * 1024);
        if (t + 2 < nkt) asm volatile("s_waitcnt vmcnt(4) lgkmcnt(0)" ::: "memory"); else asm volatile("s_waitcnt vmcnt(0) lgkmcnt(0)" ::: "memory");
        __builtin_amdgcn_s_barrier(); asm volatile("" ::: "memory");
        __builtin_amdgcn_s_setprio(1);
#pragma unroll
        for (int mi = 0; mi < 8; ++mi) {
#pragma unroll
            for (int ni = 0; ni < 4; ++ni) acc[mi][ni] = __builtin_amdgcn_mfma_f32_16x16x32_bf16(bfr[ni], af[mi], acc[mi][ni], 0, 0, 0); }
        __builtin_amdgcn_s_setprio(0);
        asm volatile("" ::: "memory"); __builtin_amdgcn_s_barrier(); asm volatile("" ::: "memory");
        st = (st == 2) ? 0 : st + 1; st2 = (st2 == 2) ? 0 : st2 + 1;
    }
    if (!grp) { __builtin_amdgcn_s_barrier(); asm volatile("" ::: "memory"); }
#undef G3_DMA
}
__device__ __forceinline__ void b_src_setup(TileSrc2b& s, const bf16_t* Bbase, int ldb, int n0, int ncols, int tid) {
    const int lane = tid & 63, wave = tid >> 6;
#pragma unroll
    for (int j = 0; j < 2; ++j) {
        const int k = 2 * (8 * j + wave) + (lane >> 5), slot = lane & 31;
        const int piece = (((slot >> 1) ^ ((k & 3) | (((k >> 3) & 1) << 2))) << 1) | (slot & 1);
        int col = n0 + piece * 8; if (col > ncols - 8) col = ncols - 8;
        s.brow[j] = Bbase + (size_t)k * ldb + col;
    }
}

__device__ __forceinline__ int vcu_of_block() { const int G = gridDim.x, bx = blockIdx.x; return (G % 8 == 0) ? (bx % 8) * (G / 8) + bx / 8 : bx; }


__device__ __forceinline__ void moe_offsets256(const Params& p, LAS int* li) {
    const unsigned* ctl = (const unsigned*)(p.ws + WS_CTL);
    __syncthreads();
    if (threadIdx.x < 32) li[threadIdx.x] = (int)__hip_atomic_load(ctl + CW_CNT + 64 * threadIdx.x, __ATOMIC_RELAXED, __HIP_MEMORY_SCOPE_AGENT);
    __syncthreads();
    if (threadIdx.x == 0) { int o = 0, tt = 0; for (int e = 0; e < 32; ++e) { li[32 + e] = o; li[72 + e] = tt; o += li[e]; tt += (li[e] + 255) / 256; } li[64] = o; li[104] = tt; }
    __syncthreads();
}


constexpr int NA_KV = 32768;
constexpr int NA_PBH = 65536;
constexpr int NA_SELM = NA_PBH + 32768;
constexpr float NA_C = 0.08838834764831845f * 1.4426950408889634f;

struct NaTile { const bf16_t* k; const bf16_t* v; };
#define NA_ISSUE(tile, rs) do { _Pragma("unroll") for (int i = 0; i < 2; ++i) { const size_t _o = (size_t)((tid >> 4) + 32 * i) * (rs) + (tid & 15) * 8; \
        rk[i] = *(const u32x4*)((tile).k + _o); rv[i] = *(const u32x4*)((tile).v + _o); } } while (0)
#define NA_WRITE(buf) do { _Pragma("unroll") for (int i = 0; i < 2; ++i) { const int _key = (tid >> 4) + 32 * i, _ch = tid & 15; \
        *(LAS u32x4*)(lds + (buf) * NA_KV + _key * 256 + ((_ch ^ (_key & 15)) << 4)) = rk[i]; \
        *(LAS u32x4*)(lds + (buf) * NA_KV + 16384 + _key * 256 + (((_ch >> 1) ^ (_key & 7)) << 5) + (_ch & 1) * 16) = rv[i]; } } while (0)

__device__ __forceinline__ void na_tile(ldsp_t img, const bf16x8 (&qf)[4], const unsigned (&kR)[4], unsigned vB, int sv, int g,
                                        float& m, float& l, f32x4 (&o)[8], bool need_mask, int key0, int lo, int hi, f32x4 (&p)[4], float& alpha_out) {
    f32x4 sc[4];
#pragma unroll
    for (int kt = 0; kt < 4; ++kt) { sc[kt] = (f32x4){0.f, 0.f, 0.f, 0.f};
#pragma unroll
        for (int ks = 0; ks < 4; ++ks) { const bf16x8 kf = *(const LAS bf16x8*)(img + kt * 4096 + kR[ks]); sc[kt] = __builtin_amdgcn_mfma_f32_16x16x32_bf16(kf, qf[ks], sc[kt], 0, 0, 0); } }
    float mx = -INFINITY;
#pragma unroll
    for (int kt = 0; kt < 4; ++kt)
#pragma unroll
        for (int i = 0; i < 4; ++i) { float v = sc[kt][i] * NA_C; if (need_mask) { const int key = key0 + 16 * kt + 4 * g + i; v = (key >= lo && key <= hi) ? v : -INFINITY; } sc[kt][i] = v; mx = fmaxf(mx, v); }
    mx = fmaxf(mx, __shfl_xor(mx, 16)); mx = fmaxf(mx, __shfl_xor(mx, 32));
    const float mn = fmaxf(m, mx), mu = (mn == -INFINITY) ? 0.f : mn;
    const float alpha = __builtin_amdgcn_exp2f(m - mu);
    float ls = 0.f;
#pragma unroll
    for (int kt = 0; kt < 4; ++kt)
#pragma unroll
        for (int i = 0; i < 4; ++i) { const float e = __builtin_amdgcn_exp2f(sc[kt][i] - mu); p[kt][i] = e; ls += e; }
    l = l * alpha + ls; m = mn; alpha_out = alpha;
    if (!__all(alpha == 1.f)) {
#pragma unroll
        for (int dt = 0; dt < 8; ++dt) o[dt] = o[dt] * alpha;
    }
    bf16x8 pf[2];
#pragma unroll
    for (int kk = 0; kk < 2; ++kk) { u32x4 w; w.x = cvt_pk_bf16(p[2 * kk][0], p[2 * kk][1]); w.y = cvt_pk_bf16(p[2 * kk][2], p[2 * kk][3]);
        w.z = cvt_pk_bf16(p[2 * kk + 1][0], p[2 * kk + 1][1]); w.w = cvt_pk_bf16(p[2 * kk + 1][2], p[2 * kk + 1][3]); pf[kk] = __builtin_bit_cast(bf16x8, w); }
#pragma unroll
    for (int dt = 0; dt < 8; ++dt) {
        const unsigned va = 16384u + vB + (unsigned)((dt ^ sv) << 5);
#pragma unroll
        for (int kk = 0; kk < 2; ++kk) {
            const s16x4 lo4 = __builtin_bit_cast(s16x4, __builtin_amdgcn_ds_read_tr16_b64_v4i16((LAS s16x4*)(img + va + kk * 8192)));
            const s16x4 hi4 = __builtin_bit_cast(s16x4, __builtin_amdgcn_ds_read_tr16_b64_v4i16((LAS s16x4*)(img + va + kk * 8192 + 4096)));
            const bf16x8 vf = __builtin_shufflevector(lo4, hi4, 0, 1, 2, 3, 4, 5, 6, 7);
            o[dt] = __builtin_amdgcn_mfma_f32_16x16x32_bf16(vf, pf[kk], o[dt], 0, 0, 0);
        }
    }
}

__device__ __forceinline__ void nsa_unit(const Params& p, ldsp_t lds, int u) {
    const bf16_t* PROJ = (const bf16_t*)(p.ws + WS_PROJ);
    const bf16_t* KC = (const bf16_t*)(p.ws + WS_KC);
    const bf16_t* VC = (const bf16_t*)(p.ws + WS_VC);
    bf16_t* MIXIN = (bf16_t*)(p.ws + WS_MIXIN);
    const int tid = threadIdx.x, lane = tid & 63, wave = __builtin_amdgcn_readfirstlane(tid >> 6);
    const int tb = 127 - (u >> 2), b = (u >> 1) & 1, grp = u & 1;
    const int t0 = 32 * tb, cur = t0 >> 6;
    const int hh = wave >> 1, th = wave & 1, qi = lane & 15, g = lane >> 4;
    const int tq = t0 + 16 * th + qi;
    const size_t rowq = (size_t)b * T + tq;
    const int head = grp * 4 + hh;
    bf16x8 qf[4];
#pragma unroll
    for (int ks = 0; ks < 4; ++ks) qf[ks] = *(const bf16x8*)(PROJ + rowq * DIN + C_NQ + head * 128 + 32 * ks + 8 * g);
    const float g0 = sigmoid_f(bf2f(PROJ[rowq * DIN + C_NGT + head * 3 + 0])), g1 = sigmoid_f(bf2f(PROJ[rowq * DIN + C_NGT + head * 3 + 1])), g2 = sigmoid_f(bf2f(PROJ[rowq * DIN + C_NGT + head * 3 + 2]));
    unsigned kR[4];
#pragma unroll
    for (int ks = 0; ks < 4; ++ks) kR[ks] = (unsigned)(qi * 256 + (((4 * ks + g) ^ qi) << 4));
    const int qq = qi >> 2, pp = qi & 3;
    const unsigned vB = (unsigned)((4 * g + qq) * 256 + 8 * pp);
    const int sv = ((4 * g + qq) & 7);
    u32x4 rk[2], rv[2];
    f32x4 o[8], outacc[8], pt[4];
    float m, l, alpha;
    const int nvis_q = tq >= 31 ? (tq - 31) / 16 + 1 : 0;
    const int nvis_max = t0 / 16 + 1;
    const int ntl = (min(nvis_max, NCMP) + 63) >> 6;
    float pb[17];
#pragma unroll
    for (int i = 0; i < 17; ++i) pb[i] = 0.f;
#pragma unroll
    for (int dt = 0; dt < 8; ++dt) o[dt] = (f32x4){0.f, 0.f, 0.f, 0.f};
    m = -INFINITY; l = 0.f;
    const bf16_t* kc0 = KC + ((size_t)b * 256 * 2 + grp) * 128; const bf16_t* vc0 = VC + ((size_t)b * 256 * 2 + grp) * 128;
    __syncthreads();
    { NaTile t0_{kc0, vc0}; NA_ISSUE(t0_, 256); NA_WRITE(0); if (ntl > 1) { NaTile t1_{kc0 + 64 * 256, vc0 + 64 * 256}; NA_ISSUE(t1_, 256); } }
#pragma unroll
    for (int tl = 0; tl < 4; ++tl) {
        if (tl < ntl) {
            __syncthreads();
            if (tl + 1 < ntl) NA_WRITE((tl + 1) & 1);
            if (tl + 2 < ntl) { NaTile t2_{kc0 + (size_t)(tl + 2) * 64 * 256, vc0 + (size_t)(tl + 2) * 64 * 256}; NA_ISSUE(t2_, 256); }
            na_tile(lds + (tl & 1) * NA_KV, qf, kR, vB, sv, g, m, l, o, true, 64 * tl, 0, nvis_q - 1, pt, alpha);
#pragma unroll
            for (int i = 0; i < 17; ++i) pb[i] *= alpha;
#pragma unroll
            for (int kt = 0; kt < 4; ++kt) {
                const float s4 = (pt[kt][0] + pt[kt][1]) + (pt[kt][2] + pt[kt][3]);
                const float recv = __shfl(pt[kt][3], (lane + 48) & 63);
                pb[tl * 4 + kt] += s4 + (g >= 1 ? recv : 0.f);
                pb[tl * 4 + kt + 1] += (g == 0 ? recv : 0.f);
            }
        }
    }
    {
        float lr = l; lr += __shfl_xor(lr, 16); lr += __shfl_xor(lr, 32);
        const float inv = lr > 0.f ? 1.f / lr : 0.f;
#pragma unroll
        for (int dt = 0; dt < 8; ++dt) outacc[dt] = o[dt] * (inv * g0);
        LAS float* pbh = (LAS float*)(lds + NA_PBH) + (hh * 32 + 16 * th + qi) * 64;
#pragma unroll
        for (int i = 0; i < 16; ++i) pbh[4 * i + g] = pb[i] * inv;
    }
    __syncthreads();
    {
        const LAS float* pball = (const LAS float*)(lds + NA_PBH);
        LAS unsigned long long* selm = (LAS unsigned long long*)(lds + NA_SELM);
#pragma unroll 1
        for (int tt = 0; tt < 4; ++tt) {
            const int tok = 4 * wave + tt;
            const float v = (pball[(0 * 32 + tok) * 64 + lane] + pball[(1 * 32 + tok) * 64 + lane]) + (pball[(2 * 32 + tok) * 64 + lane] + pball[(3 * 32 + tok) * 64 + lane]);
            const bool forced = (lane == 0) || (lane == cur) || (lane == cur - 1);
            const float score = forced ? INFINITY : (lane <= cur ? v : -INFINITY);
            int rank = 0;
            for (int i = 0; i < 64; ++i) { const float w = __shfl(score, i); rank += (w > score || (w == score && i < lane)) ? 1 : 0; }
            const unsigned long long mk = __ballot(rank < 16);
            if (lane == 0) selm[tok] = mk;
        }
    }
    __syncthreads();
    const unsigned long long mysel = ((const LAS unsigned long long*)(lds + NA_SELM))[16 * th + qi];
    {
#pragma unroll
        for (int dt = 0; dt < 8; ++dt) o[dt] = (f32x4){0.f, 0.f, 0.f, 0.f};
        m = -INFINITY; l = 0.f;
        const bf16_t* kb = PROJ + (size_t)b * T * DIN + C_KSL + grp * 128; const bf16_t* vb = PROJ + (size_t)b * T * DIN + C_VSL + grp * 128;
        const int n = cur + 1;
        { NaTile a{kb, vb}; NA_ISSUE(a, DIN); NA_WRITE(0); if (n > 1) { NaTile c{kb + (size_t)64 * DIN, vb + (size_t)64 * DIN}; NA_ISSUE(c, DIN); } }
        for (int j = 0; j < n; ++j) {
            __syncthreads();
            if (j + 1 < n) NA_WRITE((j + 1) & 1);
            if (j + 2 < n) { NaTile c{kb + (size_t)(j + 2) * 64 * DIN, vb + (size_t)(j + 2) * 64 * DIN}; NA_ISSUE(c, DIN); }
            const bool sel = (mysel >> j) & 1ull;
            na_tile(lds + (j & 1) * NA_KV, qf, kR, vB, sv, g, m, l, o, true, 64 * j, 0, sel ? tq : -1, pt, alpha);
        }
        float lr = l; lr += __shfl_xor(lr, 16); lr += __shfl_xor(lr, 32);
        const float inv = g1 / lr;
#pragma unroll
        for (int dt = 0; dt < 8; ++dt) outacc[dt] += o[dt] * inv;
    }
    {
#pragma unroll
        for (int dt = 0; dt < 8; ++dt) o[dt] = (f32x4){0.f, 0.f, 0.f, 0.f};
        m = -INFINITY; l = 0.f;
        const bf16_t* kb = PROJ + (size_t)b * T * DIN + C_KWN + grp * 128; const bf16_t* vb = PROJ + (size_t)b * T * DIN + C_VWN + grp * 128;
        const int kb_lo = max(0, t0 - 511) >> 6, n = cur - kb_lo + 1;
        __syncthreads();
        { NaTile a{kb + (size_t)kb_lo * 64 * DIN, vb + (size_t)kb_lo * 64 * DIN}; NA_ISSUE(a, DIN); NA_WRITE(0);
          if (n > 1) { NaTile c{kb + (size_t)(kb_lo + 1) * 64 * DIN, vb + (size_t)(kb_lo + 1) * 64 * DIN}; NA_ISSUE(c, DIN); } }
        for (int j = 0; j < n; ++j) {
            __syncthreads();
            if (j + 1 < n) NA_WRITE((j + 1) & 1);
            if (j + 2 < n) { NaTile c{kb + (size_t)(kb_lo + j + 2) * 64 * DIN, vb + (size_t)(kb_lo + j + 2) * 64 * DIN}; NA_ISSUE(c, DIN); }
            const int key0 = 64 * (kb_lo + j);
            const bool need = (key0 + 63 > t0) || (key0 < t0 + 31 - 511);
            na_tile(lds + (j & 1) * NA_KV, qf, kR, vB, sv, g, m, l, o, need, key0, tq - 511, tq, pt, alpha);
        }
        float lr = l; lr += __shfl_xor(lr, 16); lr += __shfl_xor(lr, 32);
        const float inv = g2 / lr;
#pragma unroll
        for (int dt = 0; dt < 8; ++dt) outacc[dt] += o[dt] * inv;
    }
#pragma unroll
    for (int dt = 0; dt < 8; ++dt) { u32x2 w; w.x = cvt_pk_bf16(outacc[dt][0], outacc[dt][1]); w.y = cvt_pk_bf16(outacc[dt][2], outacc[dt][3]);
        *(u32x2*)(MIXIN + rowq * D + 1024 + head * 128 + 16 * dt + 4 * g) = w; }
}


__device__ __forceinline__ int sfun(int row) { return (row & 3) | (((row >> 3) & 1) << 2); }
__device__ __forceinline__ bf16x8 tr_frag(ldsp_t a, int rs4) {
    const s16x4 lo = __builtin_bit_cast(s16x4, __builtin_amdgcn_ds_read_tr16_b64_v4i16((LAS s16x4*)a));
    const s16x4 hi = __builtin_bit_cast(s16x4, __builtin_amdgcn_ds_read_tr16_b64_v4i16((LAS s16x4*)(a + rs4)));
    return __builtin_shufflevector(lo, hi, 0, 1, 2, 3, 4, 5, 6, 7);
}
__device__ __forceinline__ void gla_stage_v(ldsp_t vimg, const bf16_t* PROJ, size_t row0, int col0) {
    const int tid = threadIdx.x;
#pragma unroll
    for (int i = 0; i < 4; ++i) { const int idx = tid + 512 * i, sr = idx >> 5, ch = idx & 31;
        const u32x4 w = *(const u32x4*)(PROJ + (row0 + sr) * DIN + col0 + ch * 8);
        *(LAS u32x4*)(vimg + sr * 512 + (((ch >> 1) ^ sfun(sr)) << 5) + (ch & 1) * 16) = w; }
}

__device__ __forceinline__ void gla_a_unit(const Params& p, ldsp_t lds, int u) {
    const bf16_t* PROJ = (const bf16_t*)(p.ws + WS_PROJ);
    float* BC = (float*)(p.ws + WS_BC); float* U = (float*)(p.ws + WS_U); float* DTOT = (float*)(p.ws + WS_DTOT);
    const int tid = threadIdx.x, lane = tid & 63, wave = __builtin_amdgcn_readfirstlane(tid >> 6);
    const int b = u >> 6, h = (u >> 4) & 3, sc = u & 15;
    const size_t row0 = (size_t)b * T + sc * 256;
    LAS float* glr = (LAS float*)lds;
    LAS float* tot = (LAS float*)(lds + 16384);
    ldsp_t kimg = lds + 20480;
    ldsp_t vimg = lds + 86016;
    __syncthreads();
#pragma unroll
    for (int i = 0; i < 8; ++i) { const int idx = tid + 512 * i; glr[idx] = bf2f(PROJ[(row0 + (idx >> 4)) * DIN + C_GLR + (idx & 15)]); }
    __syncthreads();
    const int d = tid & 127, c = tid >> 7, hd = h * 128 + d;
    float w[16];
#pragma unroll
    for (int r = 0; r < 16; ++r) w[r] = p.w_gk[r * 512 + hd];
    const float bias = p.b_gk[hd];
    float cum = 0.f;
    for (int sl = 0; sl < 64; ++sl) {
        const int sr = 64 * c + sl; float x = bias;
#pragma unroll
        for (int r4 = 0; r4 < 4; ++r4) { const f32x4 gv = *(const LAS f32x4*)(glr + sr * 16 + r4 * 4); x = fmaf(gv[0], w[4 * r4], x); x = fmaf(gv[1], w[4 * r4 + 1], x); x = fmaf(gv[2], w[4 * r4 + 2], x); x = fmaf(gv[3], w[4 * r4 + 3], x); }
        cum += logsigmoid_f(x) * (1.f / 16.f);
        BC[(row0 + sr) * 512 + hd] = cum;
    }
    tot[c * 128 + d] = cum;
    __syncthreads();
    float suffix = 0.f;
    for (int c2 = c + 1; c2 < 4; ++c2) suffix += tot[c2 * 128 + d];
    if (c == 0) DTOT[(size_t)u * 128 + d] = __expf(cum + suffix);
    for (int sl = 0; sl < 64; ++sl) {
        const int sr = 64 * c + sl;
        const float bcs = BC[(row0 + sr) * 512 + hd];
        const float kv = bf2f(PROJ[(row0 + sr) * DIN + C_GK + hd]) * __expf((cum - bcs) + suffix);
        *(LAS bf16_t*)(kimg + sr * 256 + (((d >> 4) ^ sfun(sr)) << 5) + (d & 15) * 2) = f2bf(kv);
    }
    const int e0 = (wave >> 1) * 64, d0 = (wave & 1) * 64;
    const int g = lane >> 4, qq = (lane & 15) >> 2, pp = lane & 3, sR = qq | ((g & 1) << 2);
    f32x4 acc[4][4];
#pragma unroll
    for (int a = 0; a < 4; ++a)
#pragma unroll
        for (int bb = 0; bb < 4; ++bb) acc[a][bb] = (f32x4){0.f, 0.f, 0.f, 0.f};
    for (int cc = 0; cc < 4; ++cc) {
        __syncthreads();
        gla_stage_v(vimg, PROJ, row0 + 64 * cc, C_GV + h * 256);
        __syncthreads();
#pragma unroll
        for (int ks = 0; ks < 2; ++ks) {
            bf16x8 vf[4], kf[4];
            const int rl = 32 * ks + 8 * g + qq;
#pragma unroll
            for (int et = 0; et < 4; ++et) vf[et] = tr_frag(vimg + rl * 512 + ((((e0 >> 4) + et) ^ sR) << 5) + 8 * pp, 2048);
#pragma unroll
            for (int dt = 0; dt < 4; ++dt) kf[dt] = tr_frag(kimg + (64 * cc + rl) * 256 + ((((d0 >> 4) + dt) ^ sR) << 5) + 8 * pp, 1024);
#pragma unroll
            for (int et = 0; et < 4; ++et)
#pragma unroll
                for (int dt = 0; dt < 4; ++dt) acc[et][dt] = __builtin_amdgcn_mfma_f32_16x16x32_bf16(vf[et], kf[dt], acc[et][dt], 0, 0, 0);
        }
    }
    float* Uu = U + (size_t)u * 128 * 256;
#pragma unroll
    for (int et = 0; et < 4; ++et)
#pragma unroll
        for (int dt = 0; dt < 4; ++dt) *(f32x4*)(Uu + (size_t)(d0 + 16 * dt + (lane & 15)) * 256 + e0 + 16 * et + 4 * g) = acc[et][dt];
}

__device__ __forceinline__ void gla_c_unit(const Params& p, ldsp_t lds, int u) {
    const bf16_t* PROJ = (const bf16_t*)(p.ws + WS_PROJ);
    const float* BC = (const float*)(p.ws + WS_BC); const float* U = (const float*)(p.ws + WS_U); const float* DTOT = (const float*)(p.ws + WS_DTOT);
    bf16_t* MIXIN = (bf16_t*)(p.ws + WS_MIXIN);
    const int tid = threadIdx.x, lane = tid & 63, wave = __builtin_amdgcn_readfirstlane(tid >> 6);
    const int b = u >> 6, h = (u >> 4) & 3, sc = u & 15;
    const size_t row0 = (size_t)b * T + sc * 256;
    ldsp_t simg = lds;
    ldsp_t vimg = lds + 65536;
    ldsp_t qimg = lds + 98304;
    ldsp_t kimg = lds + 114688;
    ldsp_t aimg = lds + 131072;
    LAS float* ssq = (LAS float*)(lds + 139264);
    LAS float* blast = (LAS float*)(lds + 141312);
    const int g = lane >> 4, li = lane & 15, qq = li >> 2, pp = li & 3, sR = qq | ((g & 1) << 2);
    const int e0 = (wave >> 1) * 64, d0 = (wave & 1) * 64;
    f32x4 S[4][4];
#pragma unroll
    for (int a = 0; a < 4; ++a)
#pragma unroll
        for (int bb = 0; bb < 4; ++bb) S[a][bb] = (f32x4){0.f, 0.f, 0.f, 0.f};
    for (int j = 0; j < sc; ++j) {
        const float* Uj = U + (size_t)(u - sc + j) * 128 * 256; const float* Dj = DTOT + (size_t)(u - sc + j) * 128;
#pragma unroll
        for (int dt = 0; dt < 4; ++dt) { const int dd = d0 + 16 * dt + li; const float dj = Dj[dd];
#pragma unroll
            for (int et = 0; et < 4; ++et) S[et][dt] = S[et][dt] * dj + *(const f32x4*)(Uj + (size_t)dd * 256 + e0 + 16 * et + 4 * g); }
    }
    const float scale = 0.08838834764831845f;
    for (int cc = 0; cc < 4; ++cc) {
        const size_t rowc = row0 + 64 * cc;
        __syncthreads();
#pragma unroll
        for (int et = 0; et < 4; ++et)
#pragma unroll
            for (int dt = 0; dt < 4; ++dt) { const int dd = d0 + 16 * dt + li, ee = e0 + 16 * et + 4 * g;
                u32x2 w; w.x = cvt_pk_bf16(S[et][dt][0], S[et][dt][1]); w.y = cvt_pk_bf16(S[et][dt][2], S[et][dt][3]);
                *(LAS u32x2*)(simg + dd * 512 + (((ee >> 4) ^ sfun(dd)) << 5) + (ee & 15) * 2) = w; }
        { const int d = tid & 127, tq4 = tid >> 7, hd = h * 128 + d;
#pragma unroll 4
          for (int i = 0; i < 16; ++i) { const int t = 16 * tq4 + i;
              const float bc = BC[(rowc + t) * 512 + hd];
              const float qv = bf2f(PROJ[(rowc + t) * DIN + C_GQ + hd]) * scale * __expf(bc);
              const float kv = bf2f(PROJ[(rowc + t) * DIN + C_GK + hd]) * __expf(-bc);
              *(LAS bf16_t*)(qimg + t * 256 + (((d >> 3) ^ (t & 15)) << 4) + (d & 7) * 2) = f2bf(qv);
              *(LAS bf16_t*)(kimg + t * 256 + (((d >> 4) ^ sfun(t)) << 5) + (d & 15) * 2) = f2bf(kv);
              if (t == 63) blast[d] = bc; } }
        gla_stage_v(vimg, PROJ, rowc, C_GV + h * 256);
        __syncthreads();
        { const int st = wave & 3, tt0 = (wave >> 2) * 2;
          f32x4 at[2] = {(f32x4){0.f, 0.f, 0.f, 0.f}, (f32x4){0.f, 0.f, 0.f, 0.f}};
#pragma unroll
          for (int ks = 0; ks < 4; ++ks) {
              const int rs_ = 16 * st + li, ch = 4 * ks + g;
              const bf16x8 kf = *(const LAS bf16x8*)(kimg + rs_ * 256 + (((ch >> 1) ^ sfun(rs_)) << 5) + (ch & 1) * 16);
#pragma unroll
              for (int k2 = 0; k2 < 2; ++k2) { const int rt = 16 * (tt0 + k2) + li;
                  const bf16x8 qf = *(const LAS bf16x8*)(qimg + rt * 256 + ((ch ^ (rt & 15)) << 4));
                  at[k2] = __builtin_amdgcn_mfma_f32_16x16x32_bf16(kf, qf, at[k2], 0, 0, 0); } }
#pragma unroll
          for (int k2 = 0; k2 < 2; ++k2) { const int t = 16 * (tt0 + k2) + li, s0 = 16 * st + 4 * g;
              float a[4];
#pragma unroll
              for (int i = 0; i < 4; ++i) a[i] = (s0 + i <= t) ? at[k2][i] : 0.f;
              u32x2 w; w.x = cvt_pk_bf16(a[0], a[1]); w.y = cvt_pk_bf16(a[2], a[3]);
              *(LAS u32x2*)(aimg + t * 128 + (((s0 >> 3) ^ (t & 7)) << 4) + (s0 & 7) * 2) = w; } }
        __syncthreads();
        f32x4 o[2][4];
#pragma unroll
        for (int a = 0; a < 2; ++a)
#pragma unroll
            for (int bb = 0; bb < 4; ++bb) o[a][bb] = (f32x4){0.f, 0.f, 0.f, 0.f};
#pragma unroll
        for (int ks = 0; ks < 4; ++ks) {
            const int rl = 32 * ks + 8 * g + qq, ch = 4 * ks + g;
            bf16x8 sf[2], qf[4];
#pragma unroll
            for (int et = 0; et < 2; ++et) sf[et] = tr_frag(simg + rl * 512 + (((2 * wave + et) ^ sR) << 5) + 8 * pp, 2048);
#pragma unroll
            for (int tt = 0; tt < 4; ++tt) { const int rt = 16 * tt + li; qf[tt] = *(const LAS bf16x8*)(qimg + rt * 256 + ((ch ^ (rt & 15)) << 4)); }
#pragma unroll
            for (int et = 0; et < 2; ++et)
#pragma unroll
                for (int tt = 0; tt < 4; ++tt) o[et][tt] = __builtin_amdgcn_mfma_f32_16x16x32_bf16(sf[et], qf[tt], o[et][tt], 0, 0, 0);
        }
#pragma unroll
        for (int ks = 0; ks < 2; ++ks) {
            const int rl = 32 * ks + 8 * g + qq, ch = 4 * ks + g;
            bf16x8 vf[2], af[4];
#pragma unroll
            for (int et = 0; et < 2; ++et) vf[et] = tr_frag(vimg + rl * 512 + (((2 * wave + et) ^ sR) << 5) + 8 * pp, 2048);
#pragma unroll
            for (int tt = 0; tt < 4; ++tt) { const int rt = 16 * tt + li; af[tt] = *(const LAS bf16x8*)(aimg + rt * 128 + ((ch ^ (rt & 7)) << 4)); }
#pragma unroll
            for (int et = 0; et < 2; ++et)
#pragma unroll
                for (int tt = 0; tt < 4; ++tt) o[et][tt] = __builtin_amdgcn_mfma_f32_16x16x32_bf16(vf[et], af[tt], o[et][tt], 0, 0, 0);
        }
#pragma unroll
        for (int tt = 0; tt < 4; ++tt) { float q2 = 0.f;
#pragma unroll
            for (int et = 0; et < 2; ++et) q2 += (o[et][tt][0] * o[et][tt][0] + o[et][tt][1] * o[et][tt][1]) + (o[et][tt][2] * o[et][tt][2] + o[et][tt][3] * o[et][tt][3]);
            q2 += __shfl_xor(q2, 16); q2 += __shfl_xor(q2, 32);
            if (g == 0) ssq[wave * 64 + 16 * tt + li] = q2; }
        __syncthreads();
#pragma unroll
        for (int tt = 0; tt < 4; ++tt) { const int t = 16 * tt + li; float q2 = 0.f;
#pragma unroll
            for (int w8 = 0; w8 < 8; ++w8) q2 += ssq[w8 * 64 + t];
            const float rs_ = 1.f / sqrtf(q2 * (1.f / 256.f) + LN_EPS);
#pragma unroll
            for (int et = 0; et < 2; ++et) { const int ee = 32 * wave + 16 * et + 4 * g;
                const f32x4 gg = *(const f32x4*)(p.gla_g + ee);
                const u32x2 rw = *(const u32x2*)(PROJ + (rowc + t) * DIN + C_GR + h * 256 + ee);
                const float r0 = __uint_as_float(rw.x << 16), r1 = __uint_as_float(rw.x & 0xffff0000u), r2 = __uint_as_float(rw.y << 16), r3 = __uint_as_float(rw.y & 0xffff0000u);
                u32x2 w; w.x = cvt_pk_bf16(o[et][tt][0] * rs_ * gg[0] * silu_f(r0), o[et][tt][1] * rs_ * gg[1] * silu_f(r1));
                w.y = cvt_pk_bf16(o[et][tt][2] * rs_ * gg[2] * silu_f(r2), o[et][tt][3] * rs_ * gg[3] * silu_f(r3));
                *(u32x2*)(MIXIN + (rowc + t) * D + h * 256 + ee) = w; } }
        if (cc < 3) {
#pragma unroll
            for (int ks = 0; ks < 2; ++ks) {
                const int rl = 32 * ks + 8 * g + qq;
                bf16x8 vf[4], kf[4];
#pragma unroll
                for (int et = 0; et < 4; ++et) vf[et] = tr_frag(vimg + rl * 512 + ((((e0 >> 4) + et) ^ sR) << 5) + 8 * pp, 2048);
#pragma unroll
                for (int dt = 0; dt < 4; ++dt) kf[dt] = tr_frag(kimg + rl * 256 + ((((d0 >> 4) + dt) ^ sR) << 5) + 8 * pp, 1024);
#pragma unroll
                for (int et = 0; et < 4; ++et)
#pragma unroll
                    for (int dt = 0; dt < 4; ++dt) S[et][dt] = __builtin_amdgcn_mfma_f32_16x16x32_bf16(vf[et], kf[dt], S[et][dt], 0, 0, 0);
            }
#pragma unroll
            for (int dt = 0; dt < 4; ++dt) { const float dl = __expf(blast[d0 + 16 * dt + li]);
#pragma unroll
                for (int et = 0; et < 4; ++et) S[et][dt] = S[et][dt] * dl; }
        }
    }
}

__device__ __forceinline__ void ph3_mfma(const Params& p, ldsp_t lds, bool rep = false) {
    bf16_t* PROJ = (bf16_t*)(p.ws + WS_PROJ);
    const float* rope = (const float*)(p.ws + WS_ROPE);
    float* HIDP = (float*)(p.ws + WS_HIDP);
    const int tid = threadIdx.x, lane = tid & 63, wave = tid >> 6, wm0 = (wave >> 1) * 64, wn0 = (wave & 1) * 64;
    if (false) for (int i = blockIdx.x * NTHR + tid; i < NTOK * 12 * 16; i += gridDim.x * NTHR) {
        const int f = i & 15, slot = (i >> 4) % 12, row = i / (16 * 12);
        const int cb = slot < 8 ? C_NQ + slot * 128 : (slot < 10 ? C_KSL + (slot - 8) * 128 : C_KWN + (slot - 10) * 128);
        const int pos = row % T;
        const float cs = rope[pos * 16 + f], sn = rope[65536 + pos * 16 + f];
        bf16_t* q = PROJ + (size_t)row * DIN + cb;
        const float x1 = bf2f(q[f]), x2 = bf2f(q[16 + f]);
        q[f] = f2bf(x1 * cs - x2 * sn); q[16 + f] = f2bf(x2 * cs + x1 * sn);
    }
    for (int u = blockIdx.x; u < 256; u += gridDim.x) {
        if (u < 128) { gla_a_unit(p, lds, u); continue; }
        const int v = u - 128, kv = v >> 6, mt = (v >> 4) & 3, nt = (v >> 3) & 1, ks = v & 7;
        const int m0 = mt * 256, n0 = nt * 128, cbase = kv ? C_VCM : C_KCM;
        TileSrc s;
#pragma unroll
        for (int i = 0; i < 4; ++i) { int rr = m0 + (tid >> 3) + 64 * i; if (rr > 1019) rr = 1019; const int g = rr & 1, bi = rr >> 1, b = bi / 255, ii = bi % 255;
            s.arow[i] = PROJ + (size_t)(b * T + 16 * ii + 4 * ks) * DIN + cbase + g * 128 + (tid & 7) * 8; }
        s.bcol = (kv ? p.w_cv1 : p.w_ck1) + (size_t)(ks * 512) * 256 + n0 + (tid & 31) * 4; s.bvalid = true; s.SA = DIN; s.ldb = 256; s.nkt = 8;
        f32x4 acc[4][4];
        gemm_tile(lds, s, acc);
#pragma unroll
        for (int mi = 0; mi < 4; ++mi)
#pragma unroll
            for (int ni = 0; ni < 4; ++ni) *(f32x4*)(HIDP + ((size_t)(kv * 8 + ks) * 1024 + m0 + wm0 + 16 * mi + (lane & 15)) * 256 + n0 + wn0 + 16 * ni + 4 * (lane >> 4)) = acc[mi][ni];
    }
}

__device__ __forceinline__ void ph3b_mfma(const Params& p, float* lds) {
    const float* HIDP = (const float*)(p.ws + WS_HIDP);
    const float* pebp = (const float*)(p.ws + WS_PEBP);
    const float* rope = (const float*)(p.ws + WS_ROPE);
    const int tid = threadIdx.x;
    for (int u = blockIdx.x; u < 2 * 255; u += gridDim.x) {
        const int kv = u / 255, rg = u % 255;
        const float* w2 = kv ? p.w_cv2 : p.w_ck2; const float* b2 = kv ? p.b_cv2 : p.b_ck2; const float* b1 = kv ? p.b_cv1 : p.b_ck1;
        bf16_t* OUT = (bf16_t*)(p.ws + (kv ? WS_VC : WS_KC));
        __syncthreads();
        for (int i = tid; i < 4 * 256; i += NTHR) { const int n = i & 255; float v = b1[n];
#pragma unroll
            for (int rs = 0; rs < 16; ++rs) v += pebp[(kv * 16 + rs) * 256 + n];
#pragma unroll
            for (int ks = 0; ks < 8; ++ks) v += HIDP[((size_t)(kv * 8 + ks) * 1024 + rg * 4) * 256 + i];
            lds[i] = silu_f(v); }
        __syncthreads();
        const int rl = tid >> 7, d = tid & 127, rr = rg * 4 + rl;
        float sacc = b2[d];
        for (int j = 0; j < 256; ++j) sacc = fmaf(lds[rl * 256 + j], w2[j * 128 + d], sacc);
        lds[1024 + tid] = sacc;
        __syncthreads();
        const int g = rr & 1, bi = rr >> 1, b = bi / 255, n = bi % 255;
        float o = sacc;
        if (kv == 0 && d < 32) {
            const int pos = 16 * n + 31, f = d & 15;
            const float cs = rope[pos * 16 + f], sn = rope[65536 + pos * 16 + f];
            const float x1 = lds[1024 + rl * 128 + f], x2 = lds[1024 + rl * 128 + 16 + f];
            o = d < 16 ? x1 * cs - x2 * sn : x2 * cs + x1 * sn;
        }
        OUT[(((size_t)b * 256 + n) * 2 + g) * 128 + d] = f2bf(o);
    }
}

__device__ __forceinline__ void ph4_mfma(const Params& p, ldsp_t lds, int nrep_gla = 1, int nrep_nsa = 1) {
    unsigned* qh = (unsigned*)(p.ws + WS_CTL) + CW_Q;
    LAS int* nxt = (LAS int*)(lds + LDS_BYTES - 128);
    for (int r = 0; r < nrep_gla; ++r)
    for (;;) {
        __syncthreads();
        if (threadIdx.x == 0) *nxt = (int)__hip_atomic_fetch_add(qh + 128 * r, 1u, __ATOMIC_RELAXED, __HIP_MEMORY_SCOPE_AGENT);
        __syncthreads();
        const int u = *nxt;
        if (u >= 128) break;
        gla_c_unit(p, lds, u);
    }
    for (int r = 0; r < nrep_nsa; ++r)
    for (;;) {
        __syncthreads();
        if (threadIdx.x == 0) *nxt = (int)__hip_atomic_fetch_add(qh + 64 + 128 * r, 1u, __ATOMIC_RELAXED, __HIP_MEMORY_SCOPE_AGENT);
        __syncthreads();
        const int u = *nxt;
        if (u >= 512) break;
        nsa_unit(p, lds, u);
    }
}


__device__ __forceinline__ u32x4 pair16(u32x2 t0, u32x2 t1, int g) {
    const bool odd = g & 1;
    const unsigned s0 = odd ? t0.x : t1.x, s1 = odd ? t0.y : t1.y;
    const unsigned r0 = (unsigned)__shfl_xor((int)s0, 16), r1 = (unsigned)__shfl_xor((int)s1, 16);
    u32x4 o;
    o.x = odd ? r0 : t0.x; o.y = odd ? r1 : t0.y; o.z = odd ? t1.x : r0; o.w = odd ? t1.y : r1;
    return o;
}
__device__ __forceinline__ int lane_id_opaque() { int l; asm volatile("v_mbcnt_lo_u32_b32 %0, -1, 0\n\tv_mbcnt_hi_u32_b32 %0, -1, %0" : "=v"(l)); return l; }
__device__ __forceinline__ int a_src_chunk(int tid) { return ((tid & 3) ^ f4((tid >> 4) & 3)) * 8; }

__device__ __forceinline__ void ph2_v2(const Params& p, ldsp_t lds) {
    const bf16_t* H = (const bf16_t*)(p.ws + WS_H);
    bf16_t* PROJ = (bf16_t*)(p.ws + WS_PROJ);
    const int tid0 = threadIdx.x, wave = __builtin_amdgcn_readfirstlane(tid0 >> 6), wm0 = (wave >> 2) * 128, wn0 = (wave & 3) * 64;
    const int vcu = vcu_of_block();
    constexpr int NT = (DIN + 255) / 256;
    for (int u = vcu; u < 4 * 6 * 32; u += gridDim.x) {
        const int sb = u >> 5, j = u & 31, mt = (sb & 3) * 8 + (j & 7), nt = (sb >> 2) * 4 + (j >> 3);
        if (nt >= NT) continue;
        const int m0 = mt * 256, n0 = nt * 256;
        int tid = threadIdx.x; asm volatile("" : "+v"(tid));
        TileSrc2b s;
#pragma unroll
        for (int i = 0; i < 2; ++i) s.arow[i] = H + (size_t)(m0 + (tid >> 2) + 128 * i) * D + a_src_chunk(tid);
        b_src_setup(s, (const bf16_t*)(p.ws + WS_WINB), DIN, n0, DIN, tid);
        s.SA = 128; s.ldb = DIN; s.nkt = D / 32;
        f32x4 acc[8][4];
        gemm_tile2b(lds, s, acc);
        const int lane = lane_id_opaque();
        const int g = lane >> 4;
        {
          const int c0 = n0 + wn0 + 16;
          const bool is_rope = (c0 >= C_NQ && c0 < C_NQ + 1024 && ((c0 - C_NQ) & 127) == 0) || c0 == C_KSL || c0 == C_KSL + 128 || c0 == C_KWN || c0 == C_KWN + 128;
          if (is_rope) {
              const float* rope = (const float*)(p.ws + WS_ROPE);
#pragma unroll
              for (int mi = 0; mi < 8; ++mi) { const int pos = (m0 + wm0 + 16 * mi + (lane & 15)) % T;
                  const f32x4 cs = *(const f32x4*)(rope + pos * 16 + 4 * g), sn = *(const f32x4*)(rope + 65536 + pos * 16 + 4 * g);
                  const f32x4 x1 = acc[mi][1], x2 = acc[mi][2];
                  acc[mi][1] = x1 * cs - x2 * sn; acc[mi][2] = x2 * cs + x1 * sn; } } }
#pragma unroll
        for (int mi = 0; mi < 8; ++mi)
#pragma unroll
            for (int np = 0; np < 2; ++np) {
                u32x2 t0, t1; t0.x = cvt_pk_bf16(acc[mi][2 * np][0], acc[mi][2 * np][1]); t0.y = cvt_pk_bf16(acc[mi][2 * np][2], acc[mi][2 * np][3]);
                t1.x = cvt_pk_bf16(acc[mi][2 * np + 1][0], acc[mi][2 * np + 1][1]); t1.y = cvt_pk_bf16(acc[mi][2 * np + 1][2], acc[mi][2 * np + 1][3]);
                const u32x4 o = pair16(t0, t1, g);
                const int m = m0 + wm0 + 16 * mi + (lane & 15), n = n0 + wn0 + 32 * np + ((g & 1) ? 16 + 4 * (g - 1) : 4 * g);
                if (n < DIN) *(u32x4*)(PROJ + (size_t)m * DIN + n) = o;
            }
    }
}

__device__ __forceinline__ void ph5_v2(const Params& p, ldsp_t lds) {
    const bf16_t* MIXIN = (const bf16_t*)(p.ws + WS_MIXIN);
    const float* mod = (const float*)(p.ws + WS_MOD);
    float* Z = (float*)(p.ws + WS_Z);
    const int tid0 = threadIdx.x, wave = __builtin_amdgcn_readfirstlane(tid0 >> 6), wm0 = (wave >> 2) * 128, wn0 = (wave & 3) * 64;
    const int vcu = vcu_of_block();
    for (int u = vcu; u < 32 * 8; u += gridDim.x) {
        const int sb = u >> 5, j = u & 31, mt = (sb & 3) * 8 + (j & 7), nt = (sb >> 2) * 4 + (j >> 3);
        const int m0 = mt * 256, n0 = nt * 256;
        int tid = threadIdx.x; asm volatile("" : "+v"(tid));
        TileSrc2b s;
#pragma unroll
        for (int i = 0; i < 2; ++i) s.arow[i] = MIXIN + (size_t)(m0 + (tid >> 2) + 128 * i) * D + a_src_chunk(tid);
        b_src_setup(s, (const bf16_t*)(p.ws + WS_WOB), D, n0, D, tid);
        s.SA = 128; s.ldb = D; s.nkt = D / 32;
        f32x4 acc[8][4];
        gemm_tile2b(lds, s, acc);
        const int lane = lane_id_opaque();
        const int b = m0 / T;
#pragma unroll
        for (int ni = 0; ni < 4; ++ni) {
            const int n = n0 + wn0 + 16 * ni + 4 * (lane >> 4);
            const f32x4 g1 = 1.f + *(const f32x4*)(mod + b * 12288 + 2 * 2048 + n);
#pragma unroll
            for (int mi = 0; mi < 8; ++mi) { const size_t o = (size_t)(m0 + wm0 + 16 * mi + (lane & 15)) * D + n;
                *(f32x4*)(Z + o) = DN_ALPHA * *(const f32x4*)(p.x + o) + g1 * acc[mi][ni]; }
        }
    }
}

__device__ __forceinline__ void ph7_v2(const Params& p, ldsp_t lds) {
    const bf16_t* H2 = (const bf16_t*)(p.ws + WS_H);
    const int* LIST = (const int*)(p.ws + WS_LIST);
    bf16_t* ACT = (bf16_t*)(p.ws + WS_ACT);
    LAS int* li = (LAS int*)(lds + G2_LDS);
    moe_offsets256(p, li);
    const int tid0 = threadIdx.x, wave = __builtin_amdgcn_readfirstlane(tid0 >> 6), wm0 = (wave >> 2) * 128, wn = wave & 3;
    unsigned* qh = (unsigned*)(p.ws + WS_CTL) + CW_Q + 256;
    LAS int* nxt = (LAS int*)(lds + LDS_BYTES - 128);
    const int myx = (int)(xb_xcc_id() & 7u);
    for (int qi = 0; qi < 8; ++qi) {
    const int xq = (myx + qi) & 7;
    for (;;) {
        __syncthreads();
        if (threadIdx.x == 0) *nxt = (int)__hip_atomic_fetch_add(qh + 64 * xq, 1u, __ATOMIC_RELAXED, __HIP_MEMORY_SCOPE_AGENT);
        __syncthreads();
        const int u = *nxt;
        int e = xq, base = 0;
        for (; e < 32; e += 8) { const int ne = (li[72 + e + 1] - li[72 + e]) * 16; if (u < base + ne) break; base += ne; }
        if (e >= 32) break;
        const int mte = li[72 + e + 1] - li[72 + e];
        const int ul = u - base, nt = ul / mte, mt = ul % mte;
        const int cnt = li[e], off = li[32 + e], n0 = nt * 128;
        int tid = threadIdx.x; asm volatile("" : "+v"(tid));
        TileSrc2 s;
#pragma unroll
        for (int i = 0; i < 2; ++i) { int rr = mt * 256 + (tid >> 2) + 128 * i; if (rr >= cnt) rr = cnt - 1; const int slot = LIST[e * 8192 + rr]; s.arow[i] = H2 + (size_t)(slot >> 2) * D + a_src_chunk(tid); }
        { const int c = (tid & 31) * 8, w = c >> 6, jj = c & 63;
          s.bcol = (jj < 32 ? p.w_gate : p.w_up) + (size_t)e * D * DFF + n0 + 32 * w + (jj & 31); }
        s.bvalid = true; s.SA = 128; s.ldb = DFF; s.nkt = D / 32;
        f32x4 acc[8][4];
        const int nmi_ = min(8, max(0, (cnt - mt * 256 - (wave >> 2) * 128 + 15) >> 4));
        gemm_tile2(lds, s, acc, nmi_);
        const int lane = lane_id_opaque();
        { const int g = lane >> 4;
          f32x4 bg[2], bu[2];
#pragma unroll
          for (int ni = 0; ni < 2; ++ni) { const int n = n0 + 32 * wn + 16 * ni + 4 * g; bg[ni] = *(const f32x4*)(p.b_gate + e * DFF + n); bu[ni] = *(const f32x4*)(p.b_up + e * DFF + n); }
#pragma unroll
          for (int mi = 0; mi < 8; ++mi) { const int rr = mt * 256 + wm0 + 16 * mi + (lane & 15);
              u32x2 t[2];
#pragma unroll
              for (int ni = 0; ni < 2; ++ni) { float a[4];
#pragma unroll
                  for (int i = 0; i < 4; ++i) { const float gt = fminf(acc[mi][ni][i] + bg[ni][i], 7.f), up = fminf(fmaxf(acc[mi][ni + 2][i] + bu[ni][i], -7.f), 7.f); a[i] = gt * sigmoid_f(1.702f * gt) * (up + 1.f); }
                  t[ni].x = cvt_pk_bf16(a[0], a[1]); t[ni].y = cvt_pk_bf16(a[2], a[3]); }
              const u32x4 o = pair16(t[0], t[1], g);
              const int n = n0 + 32 * wn + ((g & 1) ? 16 + 4 * (g - 1) : 4 * g);
              if (rr < cnt) *(u32x4*)(ACT + (size_t)(off + rr) * DFF + n) = o; } }
    }
    }
}

__device__ __forceinline__ void ph8_v2(const Params& p, ldsp_t lds) {
    const bf16_t* ACT = (const bf16_t*)(p.ws + WS_ACT);
    const int* LIST = (const int*)(p.ws + WS_LIST);
    const float* TOPW = (const float*)(p.ws + WS_TOPW);
    bf16_t* YP = (bf16_t*)(p.ws + WS_YP);
    LAS int* li = (LAS int*)(lds + G2_LDS);
    moe_offsets256(p, li);
    const int tid0 = threadIdx.x, wave = __builtin_amdgcn_readfirstlane(tid0 >> 6), wm0 = (wave >> 2) * 128, wn0 = (wave & 3) * 64;
    unsigned* qh = (unsigned*)(p.ws + WS_CTL) + CW_Q + 256 + 512;
    LAS int* nxt = (LAS int*)(lds + LDS_BYTES - 128);
    const int myx = (int)(xb_xcc_id() & 7u);
    for (int qi = 0; qi < 8; ++qi) {
    const int xq = (myx + qi) & 7;
    for (;;) {
        __syncthreads();
        if (threadIdx.x == 0) *nxt = (int)__hip_atomic_fetch_add(qh + 64 * xq, 1u, __ATOMIC_RELAXED, __HIP_MEMORY_SCOPE_AGENT);
        __syncthreads();
        const int u = *nxt;
        int e = xq, base = 0;
        for (; e < 32; e += 8) { const int ne = (li[72 + e + 1] - li[72 + e]) * 8; if (u < base + ne) break; base += ne; }
        if (e >= 32) break;
        const int mte = li[72 + e + 1] - li[72 + e];
        const int ul = u - base, nt = ul / mte, mt = ul % mte;
        const int cnt = li[e], off = li[32 + e], n0 = nt * 256;
        int tid = threadIdx.x; asm volatile("" : "+v"(tid));
        TileSrc2 s;
#pragma unroll
        for (int i = 0; i < 2; ++i) { int rr = mt * 256 + (tid >> 2) + 128 * i; if (rr >= cnt) rr = cnt - 1; s.arow[i] = ACT + (size_t)(off + rr) * DFF + a_src_chunk(tid); }
        s.bcol = p.w_down + (size_t)e * DFF * D + n0 + (tid & 31) * 8; s.bvalid = true; s.SA = 128; s.ldb = D; s.nkt = DFF / 32;
        f32x4 acc[8][4];
        const int nmi_ = min(8, max(0, (cnt - mt * 256 - (wave >> 2) * 128 + 15) >> 4));
        gemm_tile2(lds, s, acc, nmi_);
        const int lane = lane_id_opaque();
        { const int g = lane >> 4;
          f32x4 bd[4];
#pragma unroll
          for (int ni = 0; ni < 4; ++ni) bd[ni] = *(const f32x4*)(p.b_down + e * D + n0 + wn0 + 16 * ni + 4 * g);
#pragma unroll
          for (int mi = 0; mi < 8; ++mi) { int rr = mt * 256 + wm0 + 16 * mi + (lane & 15); const bool ok = rr < cnt; if (!ok) rr = cnt - 1;
              const int slot = LIST[e * 8192 + rr]; const float w = TOPW[slot];
#pragma unroll
              for (int np = 0; np < 2; ++np) { u32x2 t[2];
#pragma unroll
                  for (int k2 = 0; k2 < 2; ++k2) { const f32x4 y = w * (acc[mi][2 * np + k2] + bd[2 * np + k2]); t[k2].x = cvt_pk_bf16(y[0], y[1]); t[k2].y = cvt_pk_bf16(y[2], y[3]); }
                  const u32x4 o = pair16(t[0], t[1], g);
                  const int n = n0 + wn0 + 32 * np + ((g & 1) ? 16 + 4 * (g - 1) : 4 * g);
                  if (ok) *(u32x4*)(YP + (size_t)slot * D + n) = o; } } }
    }
    }
}


constexpr int CW_DONE = 32768;
__device__ __forceinline__ void ph78(const Params& p, ldsp_t lds) {
    const bf16_t* H2 = (const bf16_t*)(p.ws + WS_H);
    const int* LIST = (const int*)(p.ws + WS_LIST);
    const float* TOPW = (const float*)(p.ws + WS_TOPW);
    bf16_t* ACT = (bf16_t*)(p.ws + WS_ACT);
    bf16_t* YP = (bf16_t*)(p.ws + WS_YP);
    LAS int* li = (LAS int*)(lds + G2_LDS);
    moe_offsets256(p, li);
    const int tid0 = threadIdx.x, wave = __builtin_amdgcn_readfirstlane(tid0 >> 6), wm0 = (wave >> 2) * 128, wn = wave & 3;
    unsigned* qh = (unsigned*)(p.ws + WS_CTL) + CW_Q + 256;
    unsigned* done = (unsigned*)(p.ws + WS_CTL) + CW_DONE;
    LAS int* nxt = (LAS int*)(lds + LDS_BYTES - 128);
    const int myx = (int)(xb_xcc_id() & 7u);
    const auto actr = __builtin_amdgcn_make_buffer_rsrc((void*)ACT, 0, 0x7fffffff, 0x00020000);
    int pend = -1;
    for (int qi = 0; qi < 8; ++qi) {
    const int xq = (myx + qi) & 7;
    for (;;) {
        asm volatile("s_waitcnt vmcnt(0)" ::: "memory");
        __syncthreads();
        if (threadIdx.x == 0) {
            if (pend >= 0) __hip_atomic_fetch_add(done + 16 * pend, 1u, __ATOMIC_RELAXED, __HIP_MEMORY_SCOPE_AGENT);
            *nxt = (int)__hip_atomic_fetch_add(qh + 64 * xq, 1u, __ATOMIC_RELAXED, __HIP_MEMORY_SCOPE_AGENT);
        }
        pend = -1;
        __syncthreads();
        const int u = *nxt;
        int base = 0, sg = 0, kind = 0, e = 0, mte = 0;
        for (; sg < 8; ++sg) { kind = (0xD4 >> sg) & 1; e = xq + 8 * ((0xED84 >> (2 * sg)) & 3); mte = li[72 + e + 1] - li[72 + e];
            const int ne = mte * (kind ? 8 : 16); if (u < base + ne) break; base += ne; }
        if (sg >= 8) break;
        const int ul = u - base, nt = ul / mte, mt = ul % mte;
        const int cnt = li[e], off = li[32 + e], n0 = kind ? nt * 256 : nt * 128;
        int tid = threadIdx.x; asm volatile("" : "+v"(tid));
        TileSrc2 s;
        if (kind == 0) {
#pragma unroll
            for (int i = 0; i < 2; ++i) { int rr = mt * 256 + (tid >> 2) + 128 * i; if (rr >= cnt) rr = cnt - 1; const int slot = LIST[e * 8192 + rr]; s.arow[i] = H2 + (size_t)(slot >> 2) * D + a_src_chunk(tid); }
            const int c = (tid & 31) * 8, w = c >> 6, jj = c & 63;
            s.bcol = (jj < 32 ? p.w_gate : p.w_up) + (size_t)e * D * DFF + n0 + 32 * w + (jj & 31);
        } else {
#pragma unroll
            for (int i = 0; i < 2; ++i) { int rr = mt * 256 + (tid >> 2) + 128 * i; if (rr >= cnt) rr = cnt - 1; s.arow[i] = ACT + (size_t)(off + rr) * DFF + a_src_chunk(tid); }
            s.bcol = p.w_down + (size_t)e * DFF * D + n0 + (tid & 31) * 8;
            if (threadIdx.x == 0) {
                unsigned sp = 0;
                while (__hip_atomic_load(done + 16 * (e * 32 + mt), __ATOMIC_RELAXED, __HIP_MEMORY_SCOPE_AGENT) < 16u) { __builtin_amdgcn_s_sleep(2); if (++sp > (1u << 22)) break; }
                __builtin_amdgcn_fence(__ATOMIC_ACQUIRE, "agent");
                asm volatile("s_waitcnt vmcnt(0)" ::: "memory");
            }
        }
        s.bvalid = true; s.SA = 128; s.ldb = DFF; s.nkt = D / 32;
        f32x4 acc[8][4];
        const int nmi_ = min(8, max(0, (cnt - mt * 256 - (wave >> 2) * 128 + 15) >> 4));
        gemm_tile2(lds, s, acc, nmi_);
        const int lane = lane_id_opaque();
        const int g = lane >> 4;
        if (kind == 0) {
          f32x4 bg[2], bu[2];
#pragma unroll
          for (int ni = 0; ni < 2; ++ni) { const int n = n0 + 32 * wn + 16 * ni + 4 * g; bg[ni] = *(const f32x4*)(p.b_gate + e * DFF + n); bu[ni] = *(const f32x4*)(p.b_up + e * DFF + n); }
#pragma unroll
          for (int mi = 0; mi < 8; ++mi) { const int rr = mt * 256 + wm0 + 16 * mi + (lane & 15);
              u32x2 t[2];
#pragma unroll
              for (int ni = 0; ni < 2; ++ni) { float a[4];
#pragma unroll
                  for (int i = 0; i < 4; ++i) { const float gt = fminf(acc[mi][ni][i] + bg[ni][i], 7.f), up = fminf(fmaxf(acc[mi][ni + 2][i] + bu[ni][i], -7.f), 7.f); a[i] = gt * sigmoid_f(1.702f * gt) * (up + 1.f); }
                  t[ni].x = cvt_pk_bf16(a[0], a[1]); t[ni].y = cvt_pk_bf16(a[2], a[3]); }
              const u32x4 o = pair16(t[0], t[1], g);
              const int n = n0 + 32 * wn + ((g & 1) ? 16 + 4 * (g - 1) : 4 * g);
              if (rr < cnt) __builtin_amdgcn_raw_buffer_store_b128(o, actr, ((off + rr) * DFF + n) * 2, 0, 16); }
          pend = e * 32 + mt;
        } else {
          const int wn0 = wn * 64;
          f32x4 bd[4];
#pragma unroll
          for (int ni = 0; ni < 4; ++ni) bd[ni] = *(const f32x4*)(p.b_down + e * D + n0 + wn0 + 16 * ni + 4 * g);
#pragma unroll
          for (int mi = 0; mi < 8; ++mi) { int rr = mt * 256 + wm0 + 16 * mi + (lane & 15); const bool ok = rr < cnt; if (!ok) rr = cnt - 1;
              const int slot = LIST[e * 8192 + rr]; const float w = TOPW[slot];
#pragma unroll
              for (int np = 0; np < 2; ++np) { u32x2 t[2];
#pragma unroll
                  for (int k2 = 0; k2 < 2; ++k2) { const f32x4 y = w * (acc[mi][2 * np + k2] + bd[2 * np + k2]); t[k2].x = cvt_pk_bf16(y[0], y[1]); t[k2].y = cvt_pk_bf16(y[2], y[3]); }
                  const u32x4 o = pair16(t[0], t[1], g);
                  const int n = n0 + wn0 + 32 * np + ((g & 1) ? 16 + 4 * (g - 1) : 4 * g);
                  if (ok) *(u32x4*)(YP + (size_t)slot * D + n) = o; } }
        }
    }
    }
}

__device__ __forceinline__ void ph6_v2(const Params& p, ldsp_t lds, const int rep = 0) {
    const float* Z = (const float*)(p.ws + WS_Z);
    const float* mod = (const float*)(p.ws + WS_MOD);
    float* X1 = (float*)(p.ws + WS_X1);
    bf16_t* H2 = (bf16_t*)(p.ws + WS_H);
    const bf16_t* WRT = (const bf16_t*)(p.ws + WS_WRT);
    float* TOPW = (float*)(p.ws + WS_TOPW + (rep ? 512 * 1024 : 0));
    int* LIST = (int*)(p.ws + WS_LIST + (rep ? MiB : 0));
    unsigned* ctl = (unsigned*)(p.ws + WS_CTL) + (rep ? 32 * 64 : 0);
    const int tid = threadIdx.x, lane = tid & 63, wave = __builtin_amdgcn_readfirstlane(tid >> 6);
    ldsp_t img_hi = lds, img_lo = lds + 65536;
    LAS float* part = (LAS float*)(lds + 131072);
    LAS float* lgt = (LAS float*)(lds + 131072 + 16384);
    for (int blk = blockIdx.x; blk < NTOK / 32; blk += gridDim.x) {
        for (int half = 0; half < 2; ++half) {
            __syncthreads();
#pragma unroll 1
            for (int rr = 0; rr < 2; ++rr) {
                const int rl = 2 * wave + rr, row = blk * 32 + half * 16 + rl, b = row / T;
                const f32x4* zr = (const f32x4*)(Z + (size_t)row * D) + lane;
                f32x4 v[8]; float s1 = 0.f;
#pragma unroll
                for (int j = 0; j < 8; ++j) { v[j] = zr[64 * j]; s1 += (v[j][0] + v[j][1]) + (v[j][2] + v[j][3]); }
                float mean = wave_sum(s1) * (1.f / D), s2 = 0.f;
#pragma unroll
                for (int j = 0; j < 8; ++j) { v[j] = v[j] - mean; s2 += (v[j][0] * v[j][0] + v[j][1] * v[j][1]) + (v[j][2] * v[j][2] + v[j][3] * v[j][3]); }
                float rstd = 1.f / sqrtf(wave_sum(s2) * (1.f / D) + LN_EPS);
                s1 = 0.f;
#pragma unroll
                for (int j = 0; j < 8; ++j) { const int c0 = 256 * j + lane * 4;
                    v[j] = v[j] * rstd * *(const f32x4*)(p.ln1_g + c0) + *(const f32x4*)(p.ln1_b + c0);
                    *(f32x4*)(X1 + (size_t)row * D + c0) = v[j];
                    s1 += (v[j][0] + v[j][1]) + (v[j][2] + v[j][3]); }
                mean = wave_sum(s1) * (1.f / D); s2 = 0.f;
#pragma unroll
                for (int j = 0; j < 8; ++j) { v[j] = v[j] - mean; s2 += (v[j][0] * v[j][0] + v[j][1] * v[j][1]) + (v[j][2] * v[j][2] + v[j][3] * v[j][3]); }
                rstd = 1.f / sqrtf(wave_sum(s2) * (1.f / D) + LN_EPS);
                u32x2* o8 = (u32x2*)(H2 + (size_t)row * D) + lane;
#pragma unroll
                for (int j = 0; j < 8; ++j) { const int c0 = 256 * j + lane * 4;
                    const f32x4 sh = *(const f32x4*)(mod + b * 12288 + 3 * 2048 + c0), sc = *(const f32x4*)(mod + b * 12288 + 4 * 2048 + c0);
                    const f32x4 h = v[j] * rstd * (1.f + sc) + sh;
                    u32x2 hi; hi.x = cvt_pk_bf16(h[0], h[1]); hi.y = cvt_pk_bf16(h[2], h[3]);
                    o8[64 * j] = hi;
                    const float r0 = h[0] - __uint_as_float(hi.x << 16), r1 = h[1] - __uint_as_float(hi.x & 0xffff0000u), r2 = h[2] - __uint_as_float(hi.y << 16), r3 = h[3] - __uint_as_float(hi.y & 0xffff0000u);
                    u32x2 lo; lo.x = cvt_pk_bf16(r0, r1); lo.y = cvt_pk_bf16(r2, r3);
                    const unsigned off = (unsigned)(rl * 4096 + ((((32 * j + (lane >> 1))) ^ (rl & 15)) << 4) + (lane & 1) * 8);
                    *(LAS u32x2*)(img_hi + off) = hi; *(LAS u32x2*)(img_lo + off) = lo; }
            }
            __syncthreads();
            { const int r = lane & 15, g = lane >> 4;
              f32x4 acc[2] = {(f32x4){0.f, 0.f, 0.f, 0.f}, (f32x4){0.f, 0.f, 0.f, 0.f}};
#pragma unroll 2
              for (int ks = 0; ks < 8; ++ks) {
                  const int k0 = 256 * wave + 32 * ks, ch = (k0 >> 3) + g;
                  const unsigned aoff = (unsigned)(r * 4096 + ((ch ^ r) << 4));
                  const bf16x8 ahi = *(const LAS bf16x8*)(img_hi + aoff), alo = *(const LAS bf16x8*)(img_lo + aoff);
#pragma unroll
                  for (int et = 0; et < 2; ++et) {
                      const bf16x8 whi = *(const bf16x8*)(WRT + (size_t)(16 * et + r) * 2048 + k0 + 8 * g);
                      const bf16x8 wlo = *(const bf16x8*)(WRT + 65536 + (size_t)(16 * et + r) * 2048 + k0 + 8 * g);
                      acc[et] = __builtin_amdgcn_mfma_f32_16x16x32_bf16(whi, ahi, acc[et], 0, 0, 0);
                      acc[et] = __builtin_amdgcn_mfma_f32_16x16x32_bf16(whi, alo, acc[et], 0, 0, 0);
                      acc[et] = __builtin_amdgcn_mfma_f32_16x16x32_bf16(wlo, ahi, acc[et], 0, 0, 0);
                  }
              }
#pragma unroll
              for (int et = 0; et < 2; ++et)
#pragma unroll
                  for (int i = 0; i < 4; ++i) part[(wave * 16 + r) * 32 + 16 * et + 4 * g + i] = acc[et][i];
            }
            __syncthreads();
            { const int rl = tid >> 5, e = tid & 31; float sum = p.b_router[e];
#pragma unroll
              for (int w8 = 0; w8 < 8; ++w8) sum += part[(w8 * 16 + rl) * 32 + e];
              lgt[rl * 32 + e] = sum; }
            __syncthreads();
            if (tid < 16) {
                const int row = blk * 32 + half * 16 + tid;
                float tv[4]; int ti[4];
#pragma unroll
                for (int k = 0; k < 4; ++k) { tv[k] = -INFINITY; ti[k] = 0; }
                for (int e = 0; e < 32; ++e) {
                    const float v = lgt[tid * 32 + e];
                    if (v > tv[3]) {
                        if (v > tv[0]) { tv[3] = tv[2]; ti[3] = ti[2]; tv[2] = tv[1]; ti[2] = ti[1]; tv[1] = tv[0]; ti[1] = ti[0]; tv[0] = v; ti[0] = e; }
                        else if (v > tv[1]) { tv[3] = tv[2]; ti[3] = ti[2]; tv[2] = tv[1]; ti[2] = ti[1]; tv[1] = v; ti[1] = e; }
                        else if (v > tv[2]) { tv[3] = tv[2]; ti[3] = ti[2]; tv[2] = v; ti[2] = e; }
                        else { tv[3] = v; ti[3] = e; }
                    }
                }
                const float e1 = __expf(tv[1] - tv[0]), e2 = __expf(tv[2] - tv[0]), e3 = __expf(tv[3] - tv[0]);
                const float isum = 1.f / (1.f + e1 + e2 + e3);
                const float ww[4] = {isum, e1 * isum, e2 * isum, e3 * isum};
#pragma unroll
                for (int k = 0; k < 4; ++k) {
                    const unsigned pos = atomicAdd(ctl + CW_CNT + 64 * ti[k], 1u);
                    LIST[ti[k] * 8192 + pos] = row * 4 + k;
                    TOPW[row * 4 + k] = ww[k];
                }
            }
        }
    }
}


constexpr int NPHASE = 11;
__global__ void __launch_bounds__(NTHR, 2) fwd_kernel(Params p) {
    extern __shared__ __attribute__((aligned(16))) unsigned char lds_raw[];
    float* lds = (float*)lds_raw;
    volatile LAS unsigned* misc = (volatile LAS unsigned*)((LAS unsigned char*)lds_raw + LDS_BYTES - 64);
    if (threadIdx.x < 16) misc[threadIdx.x] = 0u;
    __syncthreads();
    unsigned* ctl = (unsigned*)(p.ws + WS_CTL);
    const bool multi = (p.ph_hi - p.ph_lo) > 1;
    XcdBarrier bar; bar.bar = ctl + CW_BAR; bar.x = 0; bar.st = misc;
    if (multi) bar = xcd_barrier_post(ctl + CW_BAR, misc);
#define IN(k) (p.ph_lo <= (k) && (k) < p.ph_hi)
#ifndef REPEAT_PHASE
#define REPEAT_PHASE -1
#endif
#define SEAM(k) do { if (IN(k) && IN((k) + 1)) xcd_barrier(bar); } while (0)
    if (IN(0)) { ph0(p, lds); if (REPEAT_PHASE == 0) ph0(p, lds); }
    SEAM(0);
    if (IN(1)) { ph1(p, lds); if (REPEAT_PHASE == 1) ph1(p, lds); }
    SEAM(1);
    if (IN(2)) { ph2_v2(p, (ldsp_t)lds_raw); if (REPEAT_PHASE == 2) ph2_v2(p, (ldsp_t)lds_raw); }
    SEAM(2);
    if (IN(3)) { ph3_mfma(p, (ldsp_t)lds_raw); if (REPEAT_PHASE == 3) ph3_mfma(p, (ldsp_t)lds_raw, true); }
    SEAM(3);
    if (IN(4)) { ph3b_mfma(p, lds); if (REPEAT_PHASE == 4) ph3b_mfma(p, lds); }
    SEAM(4);
    if (IN(5)) ph4_mfma(p, (ldsp_t)lds_raw, REPEAT_PHASE == 50 ? 2 : 1, REPEAT_PHASE == 51 ? 2 : 1);
    SEAM(5);
    if (IN(6)) { ph5_v2(p, (ldsp_t)lds_raw); if (REPEAT_PHASE == 6) ph5_v2(p, (ldsp_t)lds_raw); }
    SEAM(6);
    if (IN(7)) { for (int r7 = 0; r7 < (REPEAT_PHASE == 7 ? 2 : 1); ++r7) ph6_v2(p, (ldsp_t)lds_raw, r7); }
    SEAM(7);
    if (IN(8)) ph78(p, (ldsp_t)lds_raw);
    SEAM(9);
    if (IN(10)) { ph9(p, lds); if (REPEAT_PHASE == 10) ph9(p, lds); }
}

extern "C" void kernel_launch(void* const* d_in, const int* in_sizes, int n_in, void* d_out, int out_size, void* d_ws, size_t ws_size, hipStream_t stream) {
    static int grid = 0;
    if (grid == 0) {
        int dev = 0, cus = 0;
        if (hipGetDevice(&dev) != hipSuccess || hipDeviceGetAttribute(&cus, hipDeviceAttributeMultiprocessorCount, dev) != hipSuccess) { fprintf(stderr, "kernel_launch: device query failed\n"); grid = -1; return; }
        if (hipFuncSetAttribute((const void*)fwd_kernel, hipFuncAttributeMaxDynamicSharedMemorySize, LDS_BYTES) != hipSuccess) { fprintf(stderr, "kernel_launch: hipFuncSetAttribute failed\n"); grid = -1; return; }
        if (n_in != 31 || ws_size < WS_END) { fprintf(stderr, "kernel_launch: unexpected n_in %d / ws %zu\n", n_in, ws_size); grid = -1; return; }
        (void)hipGetLastError();
        grid = cus;
    }
    if (grid < 0) return;
    (void)hipMemsetAsync((char*)d_ws + WS_CTL, 0, CTL_BYTES, stream);
    Params p{};
    const float** f = (const float**)&p;
    for (int i = 0; i < 31; ++i) f[i] = (const float*)d_in[i];
    p.out = (float*)d_out; p.ws = (unsigned char*)d_ws;
#if N_LAUNCH_MODE == 1
    p.ph_lo = 0; p.ph_hi = NPHASE;
    hipLaunchKernelGGL(fwd_kernel, dim3(grid), dim3(NTHR), LDS_BYTES, stream, p);
#else
    for (int k = 0; k < NPHASE; ++k) { p.ph_lo = k; p.ph_hi = k + 1; hipLaunchKernelGGL(fwd_kernel, dim3(grid), dim3(NTHR), LDS_BYTES, stream, p); }
#endif
}
```

```cpp
#include <hip/hip_runtime.h>
#include <stdint.h>
#include <cstdio>

#ifndef N_LAUNCH_MODE
#define N_LAUNCH_MODE 1
#endif

typedef unsigned short bf16_t;
typedef float f32x4 __attribute__((ext_vector_type(4)));
#define LAS __attribute__((address_space(3)))

constexpr int NB = 2, T = 4096, D = 2048, NTOK = NB * T;
constexpr int DIN = 5672;
constexpr int C_GQ = 0, C_GK = 512, C_GV = 1024, C_GR = 2048, C_GLR = 3072, C_NQ = 3088, C_KCM = 4112, C_VCM = 4368,
              C_KSL = 4624, C_VSL = 4880, C_KWN = 5136, C_VWN = 5392, C_NGT = 5648;
constexpr int NE = 32, TOPK = 4, DFF = 2048;
constexpr int NCMP = 255;
constexpr float LN_EPS = 1e-5f;
constexpr float DN_ALPHA = 1.189207115002721f;
constexpr int NTHR = 512;

constexpr size_t MiB = 1u << 20;
constexpr size_t WS_CTL = 0, CTL_BYTES = 1 * MiB;
constexpr size_t WS_MODP = 1 * MiB;
constexpr size_t WS_MOD = 2 * MiB;
constexpr size_t WS_ROPE = 3 * MiB;
constexpr size_t WS_PEBP = 4 * MiB;
constexpr size_t WS_KC = 5 * MiB;
constexpr size_t WS_VC = 6 * MiB;
constexpr size_t WS_H = 16 * MiB;
constexpr size_t WS_PROJ = 48 * MiB;
constexpr size_t WS_MIXIN = 144 * MiB;
constexpr size_t WS_Z = 176 * MiB;
constexpr size_t WS_X1 = 240 * MiB;
constexpr size_t WS_TOPW = 304 * MiB;
constexpr size_t WS_LIST = 305 * MiB;
constexpr size_t WS_ACT = 340 * MiB;
constexpr size_t WS_YP = 470 * MiB;
constexpr size_t WS_HIDP = 600 * MiB;
constexpr size_t WS_BC = 616 * MiB;
constexpr size_t WS_U = 632 * MiB;
constexpr size_t WS_DTOT = 648 * MiB;
constexpr size_t WS_WRT = 650 * MiB;
constexpr size_t WS_WINB = 652 * MiB;
constexpr size_t WS_WOB = 676 * MiB;
constexpr size_t WS_END = 686 * MiB;
constexpr int CW_BAR = 4096;
constexpr int CW_CNT = 8192;
constexpr int CW_Q = 12288;

constexpr int LDS_BYTES = 160 * 1024;

__device__ __forceinline__ float bf2f(bf16_t b) { return __uint_as_float(((unsigned)b) << 16); }
__device__ __forceinline__ bf16_t f2bf(float f) { unsigned u = __float_as_uint(f); u += 0x7fffu + ((u >> 16) & 1u); return (bf16_t)(u >> 16); }
__device__ __forceinline__ unsigned pk2(float lo, float hi) { return (unsigned)f2bf(lo) | ((unsigned)f2bf(hi) << 16); }
__device__ __forceinline__ float silu_f(float x) { return x / (1.f + __expf(-x)); }
__device__ __forceinline__ float sigmoid_f(float x) { return 1.f / (1.f + __expf(-x)); }
__device__ __forceinline__ float logsigmoid_f(float x) { return fminf(x, 0.f) - log1pf(__expf(-fabsf(x))); }
__device__ __forceinline__ float wave_sum(float v) {
#pragma unroll
    for (int o = 1; o < 64; o <<= 1) v += __shfl_xor(v, o);
    return v;
}
__device__ __forceinline__ float wave_max(float v) {
#pragma unroll
    for (int o = 1; o < 64; o <<= 1) v = fmaxf(v, __shfl_xor(v, o));
    return v;
}

#define XB_TMO      128
#define XB_XCNT(j)  (256  + 64 * (j))
#define XB_XSUB(j)  (1280 + 64 * (j))
#define XB_XGEN(j)  (2304 + 64 * (j))
#define XB_TOP      3328
#define XB_TOPGEN   3392
#define XCD_BAR_WORDS 3456
#define XB_SPIN_CAP (1u << 18)
__device__ __forceinline__ unsigned xb_ld(unsigned* p)              { return __hip_atomic_load(p, __ATOMIC_RELAXED, __HIP_MEMORY_SCOPE_AGENT); }
__device__ __forceinline__ unsigned xb_add(unsigned* p, unsigned v) { return __hip_atomic_fetch_add(p, v, __ATOMIC_RELAXED, __HIP_MEMORY_SCOPE_AGENT); }
__device__ __forceinline__ unsigned xb_xcc_id() { return (unsigned)__builtin_amdgcn_s_getreg((3 << 11) | 20) & 0xFu; }
#define XB_SPIN(cond, bar) do { unsigned _sp = 0; while (cond) { __builtin_amdgcn_s_sleep(1); \
    if ((++_sp & 255u) == 0u) { if (xb_ld(&(bar)[XB_TMO])) break; if (_sp > XB_SPIN_CAP) { atomicAdd(&(bar)[XB_TMO], 1u); break; } } } } while (0)
struct XcdBarrier { unsigned* bar; unsigned x; volatile LAS unsigned* st; };
__device__ __forceinline__ XcdBarrier xcd_barrier_post(unsigned* bar, volatile LAS unsigned* st) {
    XcdBarrier b; b.bar = bar; b.x = xb_xcc_id(); b.st = st;
    if (threadIdx.x == 0) (void)xb_add(&bar[XB_XCNT(b.x)], 1u);
    return b;
}
__device__ __forceinline__ void xcd_barrier_complete(unsigned* bar, unsigned x, unsigned& nloc, unsigned& nx) {
    const unsigned G = gridDim.x * gridDim.y * gridDim.z;
    unsigned sum, cnt, mine, sp = 0u;
    for (;;) {
        sum = 0u; cnt = 0u; mine = 0u;
#pragma unroll
        for (unsigned j = 0; j < 16; ++j) { const unsigned c = xb_ld(&bar[XB_XCNT(j)]); sum += c; cnt += (c > 0u) ? 1u : 0u; mine = (j == x) ? c : mine; }
        if (sum == G) break;
        __builtin_amdgcn_s_sleep(1);
        if ((++sp & 255u) == 0u) { if (xb_ld(&bar[XB_TMO])) break; if (sp > XB_SPIN_CAP) { atomicAdd(&bar[XB_TMO], 1u); break; } }
    }
    nloc = mine > 0u ? mine : 1u; nx = cnt > 0u ? cnt : 1u;
}
__device__ __forceinline__ void xcd_barrier(const XcdBarrier& b) {
    asm volatile("s_waitcnt vmcnt(0)" ::: "memory");
    __syncthreads();
    if (threadIdx.x == 0) {
        unsigned* bar = b.bar;
        __builtin_amdgcn_s_waitcnt(0);
        unsigned nloc = b.st[0], nx = b.st[1];
        if (nloc == 0u) { xcd_barrier_complete(bar, b.x, nloc, nx); b.st[0] = nloc; b.st[1] = nx; }
        const unsigned old = xb_add(&bar[XB_XSUB(b.x)], 1u);
        const unsigned gen = old / nloc;
        if (old + 1u == (gen + 1u) * nloc) {
            __builtin_amdgcn_fence(__ATOMIC_RELEASE, "agent");
            asm volatile("s_waitcnt vmcnt(0)" ::: "memory");
            const unsigned og = xb_add(&bar[XB_TOP], 1u);
            const unsigned tg = og / nx;
            if (og + 1u == (tg + 1u) * nx) xb_add(&bar[XB_TOPGEN], 1u);
            else XB_SPIN(xb_ld(&bar[XB_TOPGEN]) == tg, bar);
            __builtin_amdgcn_fence(__ATOMIC_ACQUIRE, "agent");
            xb_add(&bar[XB_XGEN(b.x)], 1u);
            asm volatile("s_waitcnt vmcnt(0)" ::: "memory");
        } else {
            XB_SPIN(xb_ld(&bar[XB_XGEN(b.x)]) == gen, bar);
            __builtin_amdgcn_fence(__ATOMIC_ACQUIRE, "agent");
            asm volatile("s_waitcnt vmcnt(0)" ::: "memory");
        }
    }
    __syncthreads();
}

struct Params {
    const float *x, *c, *w_ada, *b_ada, *w_in, *w_gk, *b_gk, *gla_g, *pe_k, *pe_v;
    const float *w_ck1, *b_ck1, *w_ck2, *b_ck2, *w_cv1, *b_cv1, *w_cv2, *b_cv2, *w_o, *ln1_g, *ln1_b;
    const float *w_router, *b_router, *w_gate, *b_gate, *w_up, *b_up, *w_down, *b_down, *ln2_g, *ln2_b;
    float* out; unsigned char* ws;
    int ph_lo, ph_hi;
};


__device__ __forceinline__ void ph0(const Params& p, float* lds) {
    const int tid = threadIdx.x, lane = tid & 63, wave = tid >> 6;
    float* modp = (float*)(p.ws + WS_MODP);
    float* rope = (float*)(p.ws + WS_ROPE);
    float* pebp = (float*)(p.ws + WS_PEBP);
    for (int u = blockIdx.x; u < 384; u += gridDim.x) {
        const int cb = u % 48, kc = u / 48;
        const int col = cb * 256 + lane * 4, kb = kc * 256 + wave * 32;
        f32x4 a0 = {0.f, 0.f, 0.f, 0.f}, a1 = {0.f, 0.f, 0.f, 0.f};
#pragma unroll 8
        for (int k = kb; k < kb + 32; ++k) {
            const f32x4 w = *(const f32x4*)(p.w_ada + (size_t)k * 12288 + col);
            const float s0 = silu_f(p.c[k]), s1 = silu_f(p.c[D + k]);
            a0 += s0 * w; a1 += s1 * w;
        }
        __syncthreads();
        *(f32x4*)(lds + (wave * 2 + 0) * 256 + lane * 4) = a0;
        *(f32x4*)(lds + (wave * 2 + 1) * 256 + lane * 4) = a1;
        __syncthreads();
        { const int b = tid >> 8, cc = tid & 255; float s = 0.f;
#pragma unroll
          for (int w = 0; w < 8; ++w) s += lds[(w * 2 + b) * 256 + cc];
          modp[((size_t)kc * 2 + b) * 12288 + cb * 256 + cc] = s; }
    }
    for (int i = blockIdx.x * NTHR + tid; i < 4096 * 16; i += gridDim.x * NTHR) {
        const int pos = i >> 4, f = i & 15;
        const double inv = pow(500000.0, -(double)f / 16.0);
        const double ang = (double)pos * inv;
        rope[i] = (float)cos(ang); rope[65536 + i] = (float)sin(ang);
    }
    { bf16_t* winb = (bf16_t*)(p.ws + WS_WINB); bf16_t* wob = (bf16_t*)(p.ws + WS_WOB);
      const size_t n1 = (size_t)D * DIN / 8, n2 = (size_t)D * D / 8;
      for (size_t i = (size_t)blockIdx.x * NTHR + tid; i < n1 + n2; i += (size_t)gridDim.x * NTHR) {
          const float* src = i < n1 ? p.w_in + i * 8 : p.w_o + (i - n1) * 8; bf16_t* dst = i < n1 ? winb + i * 8 : wob + (i - n1) * 8;
          const f32x4 a = *(const f32x4*)src, b = *(const f32x4*)(src + 4);
          uint4 o; o.x = pk2(a[0], a[1]); o.y = pk2(a[2], a[3]); o.z = pk2(b[0], b[1]); o.w = pk2(b[2], b[3]);
          *(uint4*)dst = o; } }
    { bf16_t* wrt = (bf16_t*)(p.ws + WS_WRT);
      for (int i = blockIdx.x * NTHR + tid; i < 2048 * 32; i += gridDim.x * NTHR) {
          const int k = i >> 5, e = i & 31; const float w = p.w_router[i];
          const bf16_t hi = f2bf(w); const bf16_t lo = f2bf(w - bf2f(hi));
          wrt[e * 2048 + k] = hi; wrt[65536 + e * 2048 + k] = lo; } }
    for (int u = blockIdx.x; u < 32; u += gridDim.x) {
        const int kv = u >> 4, rs = u & 15;
        const float* w1 = kv ? p.w_cv1 : p.w_ck1; const float* pe = kv ? p.pe_v : p.pe_k;
        const int j = tid & 255, half = tid >> 8;
        float s = 0.f;
        for (int r = rs * 256 + half * 128; r < rs * 256 + half * 128 + 128; ++r) s = fmaf(pe[r], w1[(size_t)r * 256 + j], s);
        __syncthreads();
        lds[tid] = s;
        __syncthreads();
        if (tid < 256) pebp[(kv * 16 + rs) * 256 + tid] = lds[tid] + lds[tid + 256];
    }
}

__device__ __forceinline__ void ph1(const Params& p, float* lds) {
    const int tid = threadIdx.x, lane = tid & 63, wave = tid >> 6;
    const float* modp = (const float*)(p.ws + WS_MODP);
    float* mod = (float*)(p.ws + WS_MOD);
    bf16_t* H = (bf16_t*)(p.ws + WS_H);
    for (int i = blockIdx.x * NTHR + tid; i < 2 * 12288; i += gridDim.x * NTHR) {
        const int b = i / 12288, col = i % 12288;
        float v = p.b_ada[col];
#pragma unroll
        for (int kc = 0; kc < 8; ++kc) v += modp[((size_t)kc * 2 + b) * 12288 + col];
        mod[i] = v;
    }
    const int rpb = (((NTOK + (int)gridDim.x - 1) / (int)gridDim.x) + 7) & ~7;
    int cached_b = -1;
    for (int r0 = blockIdx.x * rpb; r0 < min(NTOK, (int)(blockIdx.x + 1) * rpb); r0 += 8) {
        const int row = r0 + wave;
        const int bb = r0 / T;
        if (bb != cached_b) {
            __syncthreads();
            for (int i = tid; i < 4096; i += NTHR) { const int seg = i >> 11, jx = i & 2047, col = seg * 2048 + jx;
                float v = p.b_ada[col];
#pragma unroll
                for (int kc = 0; kc < 8; ++kc) v += modp[((size_t)kc * 2 + bb) * 12288 + col];
                lds[i] = v; }
            __syncthreads();
            cached_b = bb;
        }
        if (row >= NTOK) continue;
        const f32x4* xr = (const f32x4*)(p.x + (size_t)row * D) + lane;
        f32x4 v[8]; float s = 0.f;
#pragma unroll
        for (int j2 = 0; j2 < 8; ++j2) { v[j2] = xr[64 * j2]; s += (v[j2][0] + v[j2][1]) + (v[j2][2] + v[j2][3]); }
        const float mean = wave_sum(s) * (1.f / D); float s2 = 0.f;
#pragma unroll
        for (int j2 = 0; j2 < 8; ++j2) { v[j2] = v[j2] - mean; s2 += (v[j2][0] * v[j2][0] + v[j2][1] * v[j2][1]) + (v[j2][2] * v[j2][2] + v[j2][3] * v[j2][3]); }
        const float rstd = 1.f / sqrtf(wave_sum(s2) * (1.f / D) + LN_EPS);
        unsigned long long* o8 = (unsigned long long*)(H + (size_t)row * D) + lane;
#pragma unroll
        for (int j2 = 0; j2 < 8; ++j2) {
            const int c0 = 256 * j2 + lane * 4;
            const f32x4 sh = *(const f32x4*)(lds + c0), sc = *(const f32x4*)(lds + 2048 + c0);
            const f32x4 y = v[j2] * rstd * (1.f + sc) + sh;
            o8[64 * j2] = (unsigned long long)pk2(y[0], y[1]) | ((unsigned long long)pk2(y[2], y[3]) << 32);
        }
    }
}


__device__ __forceinline__ void ph9(const Params& p, float* lds) {
    const float* X1 = (const float*)(p.ws + WS_X1);
    const float* mod = (const float*)(p.ws + WS_MOD);
    const bf16_t* YP = (const bf16_t*)(p.ws + WS_YP);
    const int tid = threadIdx.x, lane = tid & 63, wave = tid >> 6;
    for (int row = blockIdx.x * 8 + wave; row < NTOK; row += gridDim.x * 8) {
        const int b = row / T;
        f32x4 v[8]; float s = 0.f;
#pragma unroll
        for (int j = 0; j < 8; ++j) { const int c0 = 256 * j + lane * 4;
            f32x4 y = {0.f, 0.f, 0.f, 0.f};
#pragma unroll
            for (int k = 0; k < 4; ++k) { const unsigned long long w = *(const unsigned long long*)(YP + ((size_t)row * 4 + k) * D + c0);
                y[0] += bf2f((bf16_t)(w & 0xffff)); y[1] += bf2f((bf16_t)((w >> 16) & 0xffff)); y[2] += bf2f((bf16_t)((w >> 32) & 0xffff)); y[3] += bf2f((bf16_t)(w >> 48)); }
            const f32x4 g2 = *(const f32x4*)(mod + b * 12288 + 5 * 2048 + c0);
            v[j] = DN_ALPHA * *(const f32x4*)(X1 + (size_t)row * D + c0) + (1.f + g2) * y;
            s += (v[j][0] + v[j][1]) + (v[j][2] + v[j][3]); }
        const float mean = wave_sum(s) * (1.f / D); float s2 = 0.f;
#pragma unroll
        for (int j = 0; j < 8; ++j) { v[j] = v[j] - mean; s2 += (v[j][0] * v[j][0] + v[j][1] * v[j][1]) + (v[j][2] * v[j][2] + v[j][3] * v[j][3]); }
        const float rstd = 1.f / sqrtf(wave_sum(s2) * (1.f / D) + LN_EPS);
        const float pscale = 1.f;
#pragma unroll
        for (int j = 0; j < 8; ++j) { const int c0 = 256 * j + lane * 4;
            *(f32x4*)(p.out + (size_t)row * D + c0) = pscale * (v[j] * rstd * *(const f32x4*)(p.ln2_g + c0) + *(const f32x4*)(p.ln2_b + c0)); }
    }
}


typedef short bf16x8 __attribute__((ext_vector_type(8)));
typedef short s16x4 __attribute__((ext_vector_type(4)));
typedef unsigned u32x4 __attribute__((ext_vector_type(4)));
typedef unsigned u32x2 __attribute__((ext_vector_type(2)));
typedef LAS unsigned char* ldsp_t;
__device__ __forceinline__ unsigned cvt_pk_bf16(float lo, float hi) { unsigned r; asm volatile("v_cvt_pk_bf16_f32 %0, %1, %2" : "=v"(r) : "v"(lo), "v"(hi)); return r; }
constexpr int GT_A_BYTES = 256 * 128, GT_B_BYTES = 64 * 256;
constexpr int GT_A0 = 0, GT_A1 = GT_A_BYTES, GT_B0 = 2 * GT_A_BYTES, GT_B1 = 2 * GT_A_BYTES + GT_B_BYTES, GT_LDS = 2 * GT_A_BYTES + 2 * GT_B_BYTES;

struct TileSrc {
    const bf16_t* arow[4];
    const float* bcol;
    int SA;
    int ldb;
    int nkt;
    bool bvalid;
};

__device__ __forceinline__ void gemm_tile(ldsp_t lds, const TileSrc& s, f32x4 (&acc)[4][4]) {
    const int tid = threadIdx.x, lane = tid & 63, wave = __builtin_amdgcn_readfirstlane(tid >> 6);
    const int wm0 = (wave >> 1) * 64, wn = wave & 1;
    const int rA = tid >> 3, chA = tid & 7;
    const unsigned wA = (unsigned)(rA * 128 + ((chA ^ (rA & 7)) << 4));
    const int kB = tid >> 5, cB = (tid & 31) * 4;
    const int sB = (kB & 3) | (((kB >> 3) & 1) << 2);
    const unsigned wB = (unsigned)(kB * 256 + (((cB >> 4) ^ sB) << 5) + (cB & 15) * 2);
    const int r = lane & 15, g = lane >> 4;
    const unsigned aR0 = (unsigned)((wm0 + r) * 128 + (((g) ^ (r & 7)) << 4));
    const unsigned aR1 = (unsigned)((wm0 + r) * 128 + (((4 + g) ^ (r & 7)) << 4));
    const int q = r >> 2, pp = r & 3, sR = q | ((g & 1) << 2);
    unsigned bR[4];
#pragma unroll
    for (int ni = 0; ni < 4; ++ni) bR[ni] = (unsigned)((8 * g + q) * 256 + (((wn * 4 + ni) ^ sR) << 5) + 8 * pp);
#pragma unroll
    for (int mi = 0; mi < 4; ++mi)
#pragma unroll
        for (int ni = 0; ni < 4; ++ni) acc[mi][ni] = (f32x4){0.f, 0.f, 0.f, 0.f};
    u32x4 ra[4]; f32x4 rb[4];
    const f32x4 zero4 = {0.f, 0.f, 0.f, 0.f};
#define GT_ISSUE(t) do { const int _k0 = (t) * 64; const int _ao = (_k0 >> 7) * s.SA + (_k0 & 127); \
        _Pragma("unroll") for (int i = 0; i < 4; ++i) ra[i] = *(const u32x4*)(s.arow[i] + _ao); \
        _Pragma("unroll") for (int i = 0; i < 4; ++i) rb[i] = s.bvalid ? *(const f32x4*)(s.bcol + (size_t)(_k0 + kB + 16 * i) * s.ldb) : zero4; } while (0)
#define GT_WRITE(aoff, boff) do { \
        _Pragma("unroll") for (int i = 0; i < 4; ++i) *(LAS u32x4*)(lds + (aoff) + wA + i * 8192) = ra[i]; \
        _Pragma("unroll") for (int i = 0; i < 4; ++i) { u32x2 w; w.x = cvt_pk_bf16(rb[i][0], rb[i][1]); w.y = cvt_pk_bf16(rb[i][2], rb[i][3]); *(LAS u32x2*)(lds + (boff) + wB + i * 4096) = w; } } while (0)
#define GT_COMPUTE(aoff, boff) do { \
        _Pragma("unroll") for (int ks = 0; ks < 2; ++ks) { \
            bf16x8 af[4], bfr[4]; \
            _Pragma("unroll") for (int mi = 0; mi < 4; ++mi) af[mi] = *(const LAS bf16x8*)(lds + (aoff) + (ks ? aR1 : aR0) + mi * 2048); \
            _Pragma("unroll") for (int ni = 0; ni < 4; ++ni) { \
                const s16x4 lo = __builtin_bit_cast(s16x4, __builtin_amdgcn_ds_read_tr16_b64_v4i16((LAS s16x4*)(lds + (boff) + bR[ni] + ks * 8192))); \
                const s16x4 hi = __builtin_bit_cast(s16x4, __builtin_amdgcn_ds_read_tr16_b64_v4i16((LAS s16x4*)(lds + (boff) + bR[ni] + ks * 8192 + 1024))); \
                bfr[ni] = __builtin_shufflevector(lo, hi, 0, 1, 2, 3, 4, 5, 6, 7); } \
            _Pragma("unroll") for (int mi = 0; mi < 4; ++mi) \
                _Pragma("unroll") for (int ni = 0; ni < 4; ++ni) acc[mi][ni] = __builtin_amdgcn_mfma_f32_16x16x32_bf16(bfr[ni], af[mi], acc[mi][ni], 0, 0, 0); } } while (0)
    __syncthreads();
    GT_ISSUE(0); GT_WRITE(GT_A0, GT_B0);
    if (s.nkt > 1) GT_ISSUE(1);
    for (int t = 0; t < s.nkt; t += 2) {
        __syncthreads();
        if (t + 1 < s.nkt) GT_WRITE(GT_A1, GT_B1);
        if (t + 2 < s.nkt) GT_ISSUE(t + 2);
        GT_COMPUTE(GT_A0, GT_B0);
        if (t + 1 < s.nkt) {
            __syncthreads();
            if (t + 2 < s.nkt) GT_WRITE(GT_A0, GT_B0);
            if (t + 3 < s.nkt) GT_ISSUE(t + 3);
            GT_COMPUTE(GT_A1, GT_B1);
        }
    }
#undef GT_ISSUE
#undef GT_WRITE
#undef GT_COMPUTE
}

constexpr int G2_A = 0  , G2_B0 = 49152, G2_B1 = 65536, G2_LDS = 81920;
__device__ __forceinline__ int f4(int x) { return (0x1320 >> (4 * x)) & 3; }
struct TileSrc2 {
    const bf16_t* arow[2];
    const float* bcol;
    int SA, ldb, nkt; bool bvalid;
};
__device__ __forceinline__ void glds16_asm(const void* gsrc, unsigned lds_dst) {
    unsigned keep;
    asm volatile("s_mov_b32 %0, m0\n\ts_mov_b32 m0, %2\n\ts_nop 0\n\tglobal_load_lds_dwordx4 %1, off\n\ts_mov_b32 m0, %0" : "=&s"(keep) : "v"(gsrc), "s"(lds_dst) : "memory");
}
__device__ __forceinline__ void gemm_tile2(ldsp_t lds, const TileSrc2& s, f32x4 (&acc)[8][4], const int nmi) {
    int tid = threadIdx.x; asm volatile("" : "+v"(tid));
    const int lane = tid & 63, wave = __builtin_amdgcn_readfirstlane(tid >> 6);
    const int wm0 = (wave >> 2) * 128, wn = wave & 3;
    const int kB = 2 * (tid >> 6) + ((tid >> 5) & 1), cB = (tid & 31) * 8;
    const int r = lane & 15, g = lane >> 4;
    const unsigned aR = (unsigned)((wm0 + r) * 64 + ((g ^ f4((r >> 2) & 3)) << 4));
    const int q = r >> 2, pp = r & 3, sR = q | ((g & 1) << 2);
    const unsigned bR0 = (unsigned)((8 * g + q) * 512 + (((wn * 4) ^ sR) << 5) + 8 * pp);
    const unsigned wB0 = (unsigned)(kB * 512 + (((cB >> 4) ^ ((kB & 3) | (((kB >> 3) & 1) << 2))) << 5) + (cB & 15) * 2);
#pragma unroll
    for (int mi = 0; mi < 8; ++mi)
#pragma unroll
        for (int ni = 0; ni < 4; ++ni) acc[mi][ni] = (f32x4){0.f, 0.f, 0.f, 0.f};
    f32x4 rb[4]; u32x4 wv[2];
    const f32x4 zero4 = {0.f, 0.f, 0.f, 0.f};
    const unsigned ldsbase = (unsigned)(unsigned long long)lds;
    const unsigned dmaw = ldsbase + G2_A + (unsigned)wave * 1024u;
#define G2_DMA_A(t, stage) do { const int _k0 = (t) * 32; const int _ao = (_k0 >> 7) * s.SA + (_k0 & 127); \
        _Pragma("unroll") for (int i = 0; i < 2; ++i) glds16_asm(s.arow[i] + _ao, dmaw + (unsigned)(stage) * 16384u + i * 8192u); } while (0)
#define G2_ISSUE_B(t) do { const int _k0 = (t) * 32; \
        _Pragma("unroll") for (int i = 0; i < 2; ++i) { const float* _p = s.bcol + (size_t)(_k0 + kB + 16 * i) * s.ldb; \
            asm volatile("global_load_dwordx4 %0, %1, off" : "=v"(rb[2 * i]) : "v"(_p) : "memory"); \
            asm volatile("global_load_dwordx4 %0, %1, off offset:16" : "=v"(rb[2 * i + 1]) : "v"(_p) : "memory"); } } while (0)
#define G2_WAIT_B(N) asm volatile("s_waitcnt vmcnt(" #N ")" : "+v"(rb[0]), "+v"(rb[1]), "+v"(rb[2]), "+v"(rb[3]) :: "memory")
#define G2_WRITE_B(boff, tt) do { \
        _Pragma("unroll") for (int i = 0; i < 2; ++i) { wv[i].x = cvt_pk_bf16(rb[2 * i][0], rb[2 * i][1]); wv[i].y = cvt_pk_bf16(rb[2 * i][2], rb[2 * i][3]); \
            wv[i].z = cvt_pk_bf16(rb[2 * i + 1][0], rb[2 * i + 1][1]); wv[i].w = cvt_pk_bf16(rb[2 * i + 1][2], rb[2 * i + 1][3]); \
            *(LAS u32x4*)(lds + (boff) + wB0 + i * 8192) = wv[i]; } } while (0)
    const int nkt = s.nkt;
    const int grp = wave >> 2;
    __syncthreads();
    G2_ISSUE_B(0); G2_DMA_A(0, 0); G2_DMA_A(1, 1);
    G2_WAIT_B(4);
    G2_WRITE_B(G2_B0, 0); G2_ISSUE_B(1);
    asm volatile("s_waitcnt vmcnt(6) lgkmcnt(0)" ::: "memory");
    __syncthreads();
    if (grp) { __builtin_amdgcn_s_barrier(); asm volatile("" ::: "memory"); }
    int st = 0, st2 = 2;
    for (int t = 0; t < nkt; ++t) {
        const int bcur = (t & 1) ? G2_B1 : G2_B0, bnxt = (t & 1) ? G2_B0 : G2_B1;
        bf16x8 bfr[4], af[8];
#pragma unroll
        for (int ni = 0; ni < 4; ++ni) {
            const s16x4 lo = __builtin_bit_cast(s16x4, __builtin_amdgcn_ds_read_tr16_b64_v4i16((LAS s16x4*)(lds + bcur + (bR0 ^ (ni << 5)))));
            const s16x4 hi = __builtin_bit_cast(s16x4, __builtin_amdgcn_ds_read_tr16_b64_v4i16((LAS s16x4*)(lds + bcur + (bR0 ^ (ni << 5)) + 2048)));
            bfr[ni] = __builtin_shufflevector(lo, hi, 0, 1, 2, 3, 4, 5, 6, 7); }
#pragma unroll
        for (int mi = 0; mi < 8; ++mi) af[mi] = *(const LAS bf16x8*)(lds + G2_A + st * 16384 + aR + mi * 1024);
        __builtin_amdgcn_sched_barrier(0);
        if (t + 2 < nkt) { G2_DMA_A(t + 2, st2); G2_WAIT_B(2); } else { G2_WAIT_B(0); }
        if (t + 1 < nkt) G2_WRITE_B(bnxt, t + 1);
        if (t + 2 < nkt) G2_ISSUE_B(t + 2);
        asm volatile("s_waitcnt lgkmcnt(0)" ::: "memory");
        __builtin_amdgcn_s_barrier(); asm volatile("" ::: "memory");
        __builtin_amdgcn_s_setprio(1);
#pragma unroll
        for (int mi = 0; mi < 8; ++mi) {
#pragma unroll
            for (int ni = 0; ni < 4; ++ni) acc[mi][ni] = __builtin_amdgcn_mfma_f32_16x16x32_bf16(bfr[ni], af[mi], acc[mi][ni], 0, 0, 0); }
        __builtin_amdgcn_s_setprio(0);
        asm volatile("" ::: "memory"); __builtin_amdgcn_s_barrier(); asm volatile("" ::: "memory");
        st = (st == 2) ? 0 : st + 1; st2 = (st2 == 2) ? 0 : st2 + 1;
    }
    if (!grp) { __builtin_amdgcn_s_barrier(); asm volatile("" ::: "memory"); }
#undef G2_DMA_A
#undef G2_ISSUE_B
#undef G2_WRITE_B
#undef G2_WAIT_B
#undef G2_COMPUTE
}

struct TileSrc2b { const bf16_t* arow[2]; const bf16_t* brow[2]; int SA, ldb, nkt; };
constexpr int G3_A = 0  , G3_B = 49152  ;
__device__ __forceinline__ void gemm_tile2b(ldsp_t lds, const TileSrc2b& s, f32x4 (&acc)[8][4], const int nmi = 8) {
    int tid = threadIdx.x; asm volatile("" : "+v"(tid));
    const int lane = tid & 63, wave = __builtin_amdgcn_readfirstlane(tid >> 6);
    const int wm0 = (wave >> 2) * 128, wn = wave & 3;
    const int r = lane & 15, g = lane >> 4;
    const unsigned aR = (unsigned)((wm0 + r) * 64 + ((g ^ f4((r >> 2) & 3)) << 4));
    const int q = r >> 2, pp = r & 3, sR = q | ((g & 1) << 2);
    const unsigned bR0 = (unsigned)((8 * g + q) * 512 + (((wn * 4) ^ sR) << 5) + 8 * pp);
#pragma unroll
    for (int mi = 0; mi < 8; ++mi)
#pragma unroll
        for (int ni = 0; ni < 4; ++ni) acc[mi][ni] = (f32x4){0.f, 0.f, 0.f, 0.f};
    const unsigned ldsbase = (unsigned)(unsigned long long)lds;
    const unsigned dmaw = ldsbase + (unsigned)wave * 1024u;
#define G3_DMA(t, stage) do { const int _k0 = (t) * 32; const int _ao = (_k0 >> 7) * s.SA + (_k0 & 127); \
        _Pragma("unroll") for (int i = 0; i < 2; ++i) glds16_asm(s.arow[i] + _ao, dmaw + G3_A + (unsigned)(stage) * 16384u + i * 8192u); \
        _Pragma("unroll") for (int i = 0; i < 2; ++i) glds16_asm(s.brow[i] + (size_t)_k0 * s.ldb, dmaw + G3_B + (unsigned)(stage) * 16384u + i * 8192u); } while (0)
    const int nkt = s.nkt;
    const int grp = wave >> 2;
    __syncthreads();
    G3_DMA(0, 0); G3_DMA(1, 1);
    asm volatile("s_waitcnt vmcnt(4)" ::: "memory");
    __syncthreads();
    if (grp) { __builtin_amdgcn_s_barrier(); asm volatile("" ::: "memory"); }
    int st = 0, st2 = 2;
    for (int t = 0; t < nkt; ++t) {
        if (t + 2 < nkt) G3_DMA(t + 2, st2);
        bf16x8 bfr[4], af[8];
#pragma unroll
        for (int ni = 0; ni < 4; ++ni) {
            const s16x4 lo = __builtin_bit_cast(s16x4, __builtin_amdgcn_ds_read_tr16_b64_v4i16((LAS s16x4*)(lds + G3_B + st * 16384 + (bR0 ^ (ni << 5)))));
            const s16x4 hi = __builtin_bit_cast(s16x4, __builtin_amdgcn_ds_read_tr16_b64_v4i16((LAS s16x4*)(lds + G3_B + st * 16384 + (bR0 ^ (ni << 5)) + 2048)));
            bfr[ni] = __builtin_shufflevector(lo, hi, 0, 1, 2, 3, 4, 5, 6, 7); }
#pragma unroll
        for (int mi = 0; mi < 8; ++mi) af[mi] = *(const LAS bf16x8*)(lds + G3_A + st * 16384 + aR + mi * 1024);
        if (t + 2 < nkt) asm volatile("s_waitcnt vmcnt(4) lgkmcnt(0)" ::: "memory"); else asm volatile("s_waitcnt vmcnt(0) lgkmcnt(0)" ::: "memory");
        __builtin_amdgcn_s_barrier(); asm volatile("" ::: "memory");
        __builtin_amdgcn_s_setprio(1);
#pragma unroll
        for (int mi = 0; mi < 8; ++mi) {
#pragma unroll
            for (int ni = 0; ni < 4; ++ni) acc[mi][ni] = __builtin_amdgcn_mfma_f32_16x16x32_bf16(bfr[ni], af[mi], acc[mi][ni], 0, 0, 0); }
        __builtin_amdgcn_s_setprio(0);
        asm volatile("" ::: "memory"); __builtin_amdgcn_s_barrier(); asm volatile("" ::: "memory");
        st = (st == 2) ? 0 : st + 1; st2 = (st2 == 2) ? 0 : st2 + 1;
    }
    if (!grp) { __builtin_amdgcn_s_barrier(); asm volatile("" ::: "memory"); }
#undef G3_DMA
}
__device__ __forceinline__ void b_src_setup(TileSrc2b& s, const bf16_t* Bbase, int ldb, int n0, int ncols, int tid) {
    const int lane = tid & 63, wave = tid >> 6;
#pragma unroll
    for (int j = 0; j < 2; ++j) {
        const int k = 2 * (8 * j + wave) + (lane >> 5), slot = lane & 31;
        const int piece = (((slot >> 1) ^ ((k & 3) | (((k >> 3) & 1) << 2))) << 1) | (slot & 1);
        int col = n0 + piece * 8; if (col > ncols - 8) col = ncols - 8;
        s.brow[j] = Bbase + (size_t)k * ldb + col;
    }
}

__device__ __forceinline__ int vcu_of_block() { const int G = gridDim.x, bx = blockIdx.x; return (G % 8 == 0) ? (bx % 8) * (G / 8) + bx / 8 : bx; }


__device__ __forceinline__ void moe_offsets256(const Params& p, LAS int* li) {
    const unsigned* ctl = (const unsigned*)(p.ws + WS_CTL);
    __syncthreads();
    if (threadIdx.x < 32) li[threadIdx.x] = (int)__hip_atomic_load(ctl + CW_CNT + 64 * threadIdx.x, __ATOMIC_RELAXED, __HIP_MEMORY_SCOPE_AGENT);
    __syncthreads();
    if (threadIdx.x == 0) { int o = 0, tt = 0; for (int e = 0; e < 32; ++e) { li[32 + e] = o; li[72 + e] = tt; o += li[e]; tt += (li[e] + 255) / 256; } li[64] = o; li[104] = tt; }
    __syncthreads();
}


constexpr int NA_KV = 32768;
constexpr int NA_PBH = 65536;
constexpr int NA_SELM = NA_PBH + 32768;
constexpr float NA_C = 0.08838834764831845f * 1.4426950408889634f;

struct NaTile { const bf16_t* k; const bf16_t* v; };
#define NA_ISSUE(tile, rs) do { _Pragma("unroll") for (int i = 0; i < 2; ++i) { const size_t _o = (size_t)((tid >> 4) + 32 * i) * (rs) + (tid & 15) * 8; \
        rk[i] = *(const u32x4*)((tile).k + _o); rv[i] = *(const u32x4*)((tile).v + _o); } } while (0)
#define NA_WRITE(buf) do { _Pragma("unroll") for (int i = 0; i < 2; ++i) { const int _key = (tid >> 4) + 32 * i, _ch = tid & 15; \
        *(LAS u32x4*)(lds + (buf) * NA_KV + _key * 256 + ((_ch ^ (_key & 15)) << 4)) = rk[i]; \
        *(LAS u32x4*)(lds + (buf) * NA_KV + 16384 + _key * 256 + (((_ch >> 1) ^ (_key & 7)) << 5) + (_ch & 1) * 16) = rv[i]; } } while (0)

__device__ __forceinline__ void na_tile(ldsp_t img, const bf16x8 (&qf)[4], const unsigned (&kR)[4], unsigned vB, int sv, int g,
                                        float& m, float& l, f32x4 (&o)[8], bool need_mask, int key0, int lo, int hi, f32x4 (&p)[4], float& alpha_out) {
    f32x4 sc[4];
#pragma unroll
    for (int kt = 0; kt < 4; ++kt) { sc[kt] = (f32x4){0.f, 0.f, 0.f, 0.f};
#pragma unroll
        for (int ks = 0; ks < 4; ++ks) { const bf16x8 kf = *(const LAS bf16x8*)(img + kt * 4096 + kR[ks]); sc[kt] = __builtin_amdgcn_mfma_f32_16x16x32_bf16(kf, qf[ks], sc[kt], 0, 0, 0); } }
    float mx = -INFINITY;
#pragma unroll
    for (int kt = 0; kt < 4; ++kt)
#pragma unroll
        for (int i = 0; i < 4; ++i) { float v = sc[kt][i] * NA_C; if (need_mask) { const int key = key0 + 16 * kt + 4 * g + i; v = (key >= lo && key <= hi) ? v : -INFINITY; } sc[kt][i] = v; mx = fmaxf(mx, v); }
    mx = fmaxf(mx, __shfl_xor(mx, 16)); mx = fmaxf(mx, __shfl_xor(mx, 32));
    const float mn = fmaxf(m, mx), mu = (mn == -INFINITY) ? 0.f : mn;
    const float alpha = __builtin_amdgcn_exp2f(m - mu);
    float ls = 0.f;
#pragma unroll
    for (int kt = 0; kt < 4; ++kt)
#pragma unroll
        for (int i = 0; i < 4; ++i) { const float e = __builtin_amdgcn_exp2f(sc[kt][i] - mu); p[kt][i] = e; ls += e; }
    l = l * alpha + ls; m = mn; alpha_out = alpha;
    if (!__all(alpha == 1.f)) {
#pragma unroll
        for (int dt = 0; dt < 8; ++dt) o[dt] = o[dt] * alpha;
    }
    bf16x8 pf[2];
#pragma unroll
    for (int kk = 0; kk < 2; ++kk) { u32x4 w; w.x = cvt_pk_bf16(p[2 * kk][0], p[2 * kk][1]); w.y = cvt_pk_bf16(p[2 * kk][2], p[2 * kk][3]);
        w.z = cvt_pk_bf16(p[2 * kk + 1][0], p[2 * kk + 1][1]); w.w = cvt_pk_bf16(p[2 * kk + 1][2], p[2 * kk + 1][3]); pf[kk] = __builtin_bit_cast(bf16x8, w); }
#pragma unroll
    for (int dt = 0; dt < 8; ++dt) {
        const unsigned va = 16384u + vB + (unsigned)((dt ^ sv) << 5);
#pragma unroll
        for (int kk = 0; kk < 2; ++kk) {
            const s16x4 lo4 = __builtin_bit_cast(s16x4, __builtin_amdgcn_ds_read_tr16_b64_v4i16((LAS s16x4*)(img + va + kk * 8192)));
            const s16x4 hi4 = __builtin_bit_cast(s16x4, __builtin_amdgcn_ds_read_tr16_b64_v4i16((LAS s16x4*)(img + va + kk * 8192 + 4096)));
            const bf16x8 vf = __builtin_shufflevector(lo4, hi4, 0, 1, 2, 3, 4, 5, 6, 7);
            o[dt] = __builtin_amdgcn_mfma_f32_16x16x32_bf16(vf, pf[kk], o[dt], 0, 0, 0);
        }
    }
}

__device__ __forceinline__ void nsa_unit(const Params& p, ldsp_t lds, int u) {
    const bf16_t* PROJ = (const bf16_t*)(p.ws + WS_PROJ);
    const bf16_t* KC = (const bf16_t*)(p.ws + WS_KC);
    const bf16_t* VC = (const bf16_t*)(p.ws + WS_VC);
    bf16_t* MIXIN = (bf16_t*)(p.ws + WS_MIXIN);
    const int tid = threadIdx.x, lane = tid & 63, wave = __builtin_amdgcn_readfirstlane(tid >> 6);
    const int tb = 127 - (u >> 2), b = (u >> 1) & 1, grp = u & 1;
    const int t0 = 32 * tb, cur = t0 >> 6;
    const int hh = wave >> 1, th = wave & 1, qi = lane & 15, g = lane >> 4;
    const int tq = t0 + 16 * th + qi;
    const size_t rowq = (size_t)b * T + tq;
    const int head = grp * 4 + hh;
    bf16x8 qf[4];
#pragma unroll
    for (int ks = 0; ks < 4; ++ks) qf[ks] = *(const bf16x8*)(PROJ + rowq * DIN + C_NQ + head * 128 + 32 * ks + 8 * g);
    const float g0 = sigmoid_f(bf2f(PROJ[rowq * DIN + C_NGT + head * 3 + 0])), g1 = sigmoid_f(bf2f(PROJ[rowq * DIN + C_NGT + head * 3 + 1])), g2 = sigmoid_f(bf2f(PROJ[rowq * DIN + C_NGT + head * 3 + 2]));
    unsigned kR[4];
#pragma unroll
    for (int ks = 0; ks < 4; ++ks) kR[ks] = (unsigned)(qi * 256 + (((4 * ks + g) ^ qi) << 4));
    const int qq = qi >> 2, pp = qi & 3;
    const unsigned vB = (unsigned)((4 * g + qq) * 256 + 8 * pp);
    const int sv = ((4 * g + qq) & 7);
    u32x4 rk[2], rv[2];
    f32x4 o[8], outacc[8], pt[4];
    float m, l, alpha;
    const int nvis_q = tq >= 31 ? (tq - 31) / 16 + 1 : 0;
    const int nvis_max = t0 / 16 + 1;
    const int ntl = (min(nvis_max, NCMP) + 63) >> 6;
    float pb[17];
#pragma unroll
    for (int i = 0; i < 17; ++i) pb[i] = 0.f;
#pragma unroll
    for (int dt = 0; dt < 8; ++dt) o[dt] = (f32x4){0.f, 0.f, 0.f, 0.f};
    m = -INFINITY; l = 0.f;
    const bf16_t* kc0 = KC + ((size_t)b * 256 * 2 + grp) * 128; const bf16_t* vc0 = VC + ((size_t)b * 256 * 2 + grp) * 128;
    __syncthreads();
    { NaTile t0_{kc0, vc0}; NA_ISSUE(t0_, 256); NA_WRITE(0); if (ntl > 1) { NaTile t1_{kc0 + 64 * 256, vc0 + 64 * 256}; NA_ISSUE(t1_, 256); } }
#pragma unroll
    for (int tl = 0; tl < 4; ++tl) {
        if (tl < ntl) {
            __syncthreads();
            if (tl + 1 < ntl) NA_WRITE((tl + 1) & 1);
            if (tl + 2 < ntl) { NaTile t2_{kc0 + (size_t)(tl + 2) * 64 * 256, vc0 + (size_t)(tl + 2) * 64 * 256}; NA_ISSUE(t2_, 256); }
            na_tile(lds + (tl & 1) * NA_KV, qf, kR, vB, sv, g, m, l, o, true, 64 * tl, 0, nvis_q - 1, pt, alpha);
#pragma unroll
            for (int i = 0; i < 17; ++i) pb[i] *= alpha;
#pragma unroll
            for (int kt = 0; kt < 4; ++kt) {
                const float s4 = (pt[kt][0] + pt[kt][1]) + (pt[kt][2] + pt[kt][3]);
                const float recv = __shfl(pt[kt][3], (lane + 48) & 63);
                pb[tl * 4 + kt] += s4 + (g >= 1 ? recv : 0.f);
                pb[tl * 4 + kt + 1] += (g == 0 ? recv : 0.f);
            }
        }
    }
    {
        float lr = l; lr += __shfl_xor(lr, 16); lr += __shfl_xor(lr, 32);
        const float inv = lr > 0.f ? 1.f / lr : 0.f;
#pragma unroll
        for (int dt = 0; dt < 8; ++dt) outacc[dt] = o[dt] * (inv * g0);
        LAS float* pbh = (LAS float*)(lds + NA_PBH) + (hh * 32 + 16 * th + qi) * 64;
#pragma unroll
        for (int i = 0; i < 16; ++i) pbh[4 * i + g] = pb[i] * inv;
    }
    __syncthreads();
    {
        const LAS float* pball = (const LAS float*)(lds + NA_PBH);
        LAS unsigned long long* selm = (LAS unsigned long long*)(lds + NA_SELM);
#pragma unroll 1
        for (int tt = 0; tt < 4; ++tt) {
            const int tok = 4 * wave + tt;
            const float v = (pball[(0 * 32 + tok) * 64 + lane] + pball[(1 * 32 + tok) * 64 + lane]) + (pball[(2 * 32 + tok) * 64 + lane] + pball[(3 * 32 + tok) * 64 + lane]);
            const bool forced = (lane == 0) || (lane == cur) || (lane == cur - 1);
            const float score = forced ? INFINITY : (lane <= cur ? v : -INFINITY);
            int rank = 0;
            for (int i = 0; i < 64; ++i) { const float w = __shfl(score, i); rank += (w > score || (w == score && i < lane)) ? 1 : 0; }
            const unsigned long long mk = __ballot(rank < 16);
            if (lane == 0) selm[tok] = mk;
        }
    }
    __syncthreads();
    const unsigned long long mysel = ((const LAS unsigned long long*)(lds + NA_SELM))[16 * th + qi];
    {
#pragma unroll
        for (int dt = 0; dt < 8; ++dt) o[dt] = (f32x4){0.f, 0.f, 0.f, 0.f};
        m = -INFINITY; l = 0.f;
        const bf16_t* kb = PROJ + (size_t)b * T * DIN + C_KSL + grp * 128; const bf16_t* vb = PROJ + (size_t)b * T * DIN + C_VSL + grp * 128;
        const int n = cur + 1;
        { NaTile a{kb, vb}; NA_ISSUE(a, DIN); NA_WRITE(0); if (n > 1) { NaTile c{kb + (size_t)64 * DIN, vb + (size_t)64 * DIN}; NA_ISSUE(c, DIN); } }
        for (int j = 0; j < n; ++j) {
            __syncthreads();
            if (j + 1 < n) NA_WRITE((j + 1) & 1);
            if (j + 2 < n) { NaTile c{kb + (size_t)(j + 2) * 64 * DIN, vb + (size_t)(j + 2) * 64 * DIN}; NA_ISSUE(c, DIN); }
            const bool sel = (mysel >> j) & 1ull;
            na_tile(lds + (j & 1) * NA_KV, qf, kR, vB, sv, g, m, l, o, true, 64 * j, 0, sel ? tq : -1, pt, alpha);
        }
        float lr = l; lr += __shfl_xor(lr, 16); lr += __shfl_xor(lr, 32);
        const float inv = g1 / lr;
#pragma unroll
        for (int dt = 0; dt < 8; ++dt) outacc[dt] += o[dt] * inv;
    }
    {
#pragma unroll
        for (int dt = 0; dt < 8; ++dt) o[dt] = (f32x4){0.f, 0.f, 0.f, 0.f};
        m = -INFINITY; l = 0.f;
        const bf16_t* kb = PROJ + (size_t)b * T * DIN + C_KWN + grp * 128; const bf16_t* vb = PROJ + (size_t)b * T * DIN + C_VWN + grp * 128;
        const int kb_lo = max(0, t0 - 511) >> 6, n = cur - kb_lo + 1;
        __syncthreads();
        { NaTile a{kb + (size_t)kb_lo * 64 * DIN, vb + (size_t)kb_lo * 64 * DIN}; NA_ISSUE(a, DIN); NA_WRITE(0);
          if (n > 1) { NaTile c{kb + (size_t)(kb_lo + 1) * 64 * DIN, vb + (size_t)(kb_lo + 1) * 64 * DIN}; NA_ISSUE(c, DIN); } }
        for (int j = 0; j < n; ++j) {
            __syncthreads();
            if (j + 1 < n) NA_WRITE((j + 1) & 1);
            if (j + 2 < n) { NaTile c{kb + (size_t)(kb_lo + j + 2) * 64 * DIN, vb + (size_t)(kb_lo + j + 2) * 64 * DIN}; NA_ISSUE(c, DIN); }
            const int key0 = 64 * (kb_lo + j);
            const bool need = (key0 + 63 > t0) || (key0 < t0 + 31 - 511);
            na_tile(lds + (j & 1) * NA_KV, qf, kR, vB, sv, g, m, l, o, need, key0, tq - 511, tq, pt, alpha);
        }
        float lr = l; lr += __shfl_xor(lr, 16); lr += __shfl_xor(lr, 32);
        const float inv = g2 / lr;
#pragma unroll
        for (int dt = 0; dt < 8; ++dt) outacc[dt] += o[dt] * inv;
    }
#pragma unroll
    for (int dt = 0; dt < 8; ++dt) { u32x2 w; w.x = cvt_pk_bf16(outacc[dt][0], outacc[dt][1]); w.y = cvt_pk_bf16(outacc[dt][2], outacc[dt][3]);
        *(u32x2*)(MIXIN + rowq * D + 1024 + head * 128 + 16 * dt + 4 * g) = w; }
}


__device__ __forceinline__ int sfun(int row) { return (row & 3) | (((row >> 3) & 1) << 2); }
__device__ __forceinline__ bf16x8 tr_frag(ldsp_t a, int rs4) {
    const s16x4 lo = __builtin_bit_cast(s16x4, __builtin_amdgcn_ds_read_tr16_b64_v4i16((LAS s16x4*)a));
    const s16x4 hi = __builtin_bit_cast(s16x4, __builtin_amdgcn_ds_read_tr16_b64_v4i16((LAS s16x4*)(a + rs4)));
    return __builtin_shufflevector(lo, hi, 0, 1, 2, 3, 4, 5, 6, 7);
}
__device__ __forceinline__ void gla_stage_v(ldsp_t vimg, const bf16_t* PROJ, size_t row0, int col0) {
    const int tid = threadIdx.x;
#pragma unroll
    for (int i = 0; i < 4; ++i) { const int idx = tid + 512 * i, sr = idx >> 5, ch = idx & 31;
        const u32x4 w = *(const u32x4*)(PROJ + (row0 + sr) * DIN + col0 + ch * 8);
        *(LAS u32x4*)(vimg + sr * 512 + (((ch >> 1) ^ sfun(sr)) << 5) + (ch & 1) * 16) = w; }
}

__device__ __forceinline__ void gla_a_unit(const Params& p, ldsp_t lds, int u) {
    const bf16_t* PROJ = (const bf16_t*)(p.ws + WS_PROJ);
    float* BC = (float*)(p.ws + WS_BC); float* U = (float*)(p.ws + WS_U); float* DTOT = (float*)(p.ws + WS_DTOT);
    const int tid = threadIdx.x, lane = tid & 63, wave = __builtin_amdgcn_readfirstlane(tid >> 6);
    const int b = u >> 6, h = (u >> 4) & 3, sc = u & 15;
    const size_t row0 = (size_t)b * T + sc * 256;
    LAS float* glr = (LAS float*)lds;
    LAS float* tot = (LAS float*)(lds + 16384);
    ldsp_t kimg = lds + 20480;
    ldsp_t vimg = lds + 86016;
    __syncthreads();
#pragma unroll
    for (int i = 0; i < 8; ++i) { const int idx = tid + 512 * i; glr[idx] = bf2f(PROJ[(row0 + (idx >> 4)) * DIN + C_GLR + (idx & 15)]); }
    __syncthreads();
    const int d = tid & 127, c = tid >> 7, hd = h * 128 + d;
    float w[16];
#pragma unroll
    for (int r = 0; r < 16; ++r) w[r] = p.w_gk[r * 512 + hd];
    const float bias = p.b_gk[hd];
    float cum = 0.f;
    for (int sl = 0; sl < 64; ++sl) {
        const int sr = 64 * c + sl; float x = bias;
#pragma unroll
        for (int r4 = 0; r4 < 4; ++r4) { const f32x4 gv = *(const LAS f32x4*)(glr + sr * 16 + r4 * 4); x = fmaf(gv[0], w[4 * r4], x); x = fmaf(gv[1], w[4 * r4 + 1], x); x = fmaf(gv[2], w[4 * r4 + 2], x); x = fmaf(gv[3], w[4 * r4 + 3], x); }
        cum += logsigmoid_f(x) * (1.f / 16.f);
        BC[(row0 + sr) * 512 + hd] = cum;
    }
    tot[c * 128 + d] = cum;
    __syncthreads();
    float suffix = 0.f;
    for (int c2 = c + 1; c2 < 4; ++c2) suffix += tot[c2 * 128 + d];
    if (c == 0) DTOT[(size_t)u * 128 + d] = __expf(cum + suffix);
    for (int sl = 0; sl < 64; ++sl) {
        const int sr = 64 * c + sl;
        const float bcs = BC[(row0 + sr) * 512 + hd];
        const float kv = bf2f(PROJ[(row0 + sr) * DIN + C_GK + hd]) * __expf((cum - bcs) + suffix);
        *(LAS bf16_t*)(kimg + sr * 256 + (((d >> 4) ^ sfun(sr)) << 5) + (d & 15) * 2) = f2bf(kv);
    }
    const int e0 = (wave >> 1) * 64, d0 = (wave & 1) * 64;
    const int g = lane >> 4, qq = (lane & 15) >> 2, pp = lane & 3, sR = qq | ((g & 1) << 2);
    f32x4 acc[4][4];
#pragma unroll
    for (int a = 0; a < 4; ++a)
#pragma unroll
        for (int bb = 0; bb < 4; ++bb) acc[a][bb] = (f32x4){0.f, 0.f, 0.f, 0.f};
    for (int cc = 0; cc < 4; ++cc) {
        __syncthreads();
        gla_stage_v(vimg, PROJ, row0 + 64 * cc, C_GV + h * 256);
        __syncthreads();
#pragma unroll
        for (int ks = 0; ks < 2; ++ks) {
            bf16x8 vf[4], kf[4];
            const int rl = 32 * ks + 8 * g + qq;
#pragma unroll
            for (int et = 0; et < 4; ++et) vf[et] = tr_frag(vimg + rl * 512 + ((((e0 >> 4) + et) ^ sR) << 5) + 8 * pp, 2048);
#pragma unroll
            for (int dt = 0; dt < 4; ++dt) kf[dt] = tr_frag(kimg + (64 * cc + rl) * 256 + ((((d0 >> 4) + dt) ^ sR) << 5) + 8 * pp, 1024);
#pragma unroll
            for (int et = 0; et < 4; ++et)
#pragma unroll
                for (int dt = 0; dt < 4; ++dt) acc[et][dt] = __builtin_amdgcn_mfma_f32_16x16x32_bf16(vf[et], kf[dt], acc[et][dt], 0, 0, 0);
        }
    }
    float* Uu = U + (size_t)u * 128 * 256;
#pragma unroll
    for (int et = 0; et < 4; ++et)
#pragma unroll
        for (int dt = 0; dt < 4; ++dt) *(f32x4*)(Uu + (size_t)(d0 + 16 * dt + (lane & 15)) * 256 + e0 + 16 * et + 4 * g) = acc[et][dt];
}

__device__ __forceinline__ void gla_c_unit(const Params& p, ldsp_t lds, int u) {
    const bf16_t* PROJ = (const bf16_t*)(p.ws + WS_PROJ);
    const float* BC = (const float*)(p.ws + WS_BC); const float* U = (const float*)(p.ws + WS_U); const float* DTOT = (const float*)(p.ws + WS_DTOT);
    bf16_t* MIXIN = (bf16_t*)(p.ws + WS_MIXIN);
    const int tid = threadIdx.x, lane = tid & 63, wave = __builtin_amdgcn_readfirstlane(tid >> 6);
    const int b = u >> 6, h = (u >> 4) & 3, sc = u & 15;
    const size_t row0 = (size_t)b * T + sc * 256;
    ldsp_t simg = lds;
    ldsp_t vimg = lds + 65536;
    ldsp_t qimg = lds + 98304;
    ldsp_t kimg = lds + 114688;
    ldsp_t aimg = lds + 131072;
    LAS float* ssq = (LAS float*)(lds + 139264);
    LAS float* blast = (LAS float*)(lds + 141312);
    const int g = lane >> 4, li = lane & 15, qq = li >> 2, pp = li & 3, sR = qq | ((g & 1) << 2);
    const int e0 = (wave >> 1) * 64, d0 = (wave & 1) * 64;
    f32x4 S[4][4];
#pragma unroll
    for (int a = 0; a < 4; ++a)
#pragma unroll
        for (int bb = 0; bb < 4; ++bb) S[a][bb] = (f32x4){0.f, 0.f, 0.f, 0.f};
    for (int j = 0; j < sc; ++j) {
        const float* Uj = U + (size_t)(u - sc + j) * 128 * 256; const float* Dj = DTOT + (size_t)(u - sc + j) * 128;
#pragma unroll
        for (int dt = 0; dt < 4; ++dt) { const int dd = d0 + 16 * dt + li; const float dj = Dj[dd];
#pragma unroll
            for (int et = 0; et < 4; ++et) S[et][dt] = S[et][dt] * dj + *(const f32x4*)(Uj + (size_t)dd * 256 + e0 + 16 * et + 4 * g); }
    }
    const float scale = 0.08838834764831845f;
    for (int cc = 0; cc < 4; ++cc) {
        const size_t rowc = row0 + 64 * cc;
        __syncthreads();
#pragma unroll
        for (int et = 0; et < 4; ++et)
#pragma unroll
            for (int dt = 0; dt < 4; ++dt) { const int dd = d0 + 16 * dt + li, ee = e0 + 16 * et + 4 * g;
                u32x2 w; w.x = cvt_pk_bf16(S[et][dt][0], S[et][dt][1]); w.y = cvt_pk_bf16(S[et][dt][2], S[et][dt][3]);
                *(LAS u32x2*)(simg + dd * 512 + (((ee >> 4) ^ sfun(dd)) << 5) + (ee & 15) * 2) = w; }
        { const int d = tid & 127, tq4 = tid >> 7, hd = h * 128 + d;
#pragma unroll 4
          for (int i = 0; i < 16; ++i) { const int t = 16 * tq4 + i;
              const float bc = BC[(rowc + t) * 512 + hd];
              const float qv = bf2f(PROJ[(rowc + t) * DIN + C_GQ + hd]) * scale * __expf(bc);
              const float kv = bf2f(PROJ[(rowc + t) * DIN + C_GK + hd]) * __expf(-bc);
              *(LAS bf16_t*)(qimg + t * 256 + (((d >> 3) ^ (t & 15)) << 4) + (d & 7) * 2) = f2bf(qv);
              *(LAS bf16_t*)(kimg + t * 256 + (((d >> 4) ^ sfun(t)) << 5) + (d & 15) * 2) = f2bf(kv);
              if (t == 63) blast[d] = bc; } }
        gla_stage_v(vimg, PROJ, rowc, C_GV + h * 256);
        __syncthreads();
        { const int st = wave & 3, tt0 = (wave >> 2) * 2;
          f32x4 at[2] = {(f32x4){0.f, 0.f, 0.f, 0.f}, (f32x4){0.f, 0.f, 0.f, 0.f}};
#pragma unroll
          for (int ks = 0; ks < 4; ++ks) {
              const int rs_ = 16 * st + li, ch = 4 * ks + g;
              const bf16x8 kf = *(const LAS bf16x8*)(kimg + rs_ * 256 + (((ch >> 1) ^ sfun(rs_)) << 5) + (ch & 1) * 16);
#pragma unroll
              for (int k2 = 0; k2 < 2; ++k2) { const int rt = 16 * (tt0 + k2) + li;
                  const bf16x8 qf = *(const LAS bf16x8*)(qimg + rt * 256 + ((ch ^ (rt & 15)) << 4));
                  at[k2] = __builtin_amdgcn_mfma_f32_16x16x32_bf16(kf, qf, at[k2], 0, 0, 0); } }
#pragma unroll
          for (int k2 = 0; k2 < 2; ++k2) { const int t = 16 * (tt0 + k2) + li, s0 = 16 * st + 4 * g;
              float a[4];
#pragma unroll
              for (int i = 0; i < 4; ++i) a[i] = (s0 + i <= t) ? at[k2][i] : 0.f;
              u32x2 w; w.x = cvt_pk_bf16(a[0], a[1]); w.y = cvt_pk_bf16(a[2], a[3]);
              *(LAS u32x2*)(aimg + t * 128 + (((s0 >> 3) ^ (t & 7)) << 4) + (s0 & 7) * 2) = w; } }
        __syncthreads();
        f32x4 o[2][4];
#pragma unroll
        for (int a = 0; a < 2; ++a)
#pragma unroll
            for (int bb = 0; bb < 4; ++bb) o[a][bb] = (f32x4){0.f, 0.f, 0.f, 0.f};
#pragma unroll
        for (int ks = 0; ks < 4; ++ks) {
            const int rl = 32 * ks + 8 * g + qq, ch = 4 * ks + g;
            bf16x8 sf[2], qf[4];
#pragma unroll
            for (int et = 0; et < 2; ++et) sf[et] = tr_frag(simg + rl * 512 + (((2 * wave + et) ^ sR) << 5) + 8 * pp, 2048);
#pragma unroll
            for (int tt = 0; tt < 4; ++tt) { const int rt = 16 * tt + li; qf[tt] = *(const LAS bf16x8*)(qimg + rt * 256 + ((ch ^ (rt & 15)) << 4)); }
#pragma unroll
            for (int et = 0; et < 2; ++et)
#pragma unroll
                for (int tt = 0; tt < 4; ++tt) o[et][tt] = __builtin_amdgcn_mfma_f32_16x16x32_bf16(sf[et], qf[tt], o[et][tt], 0, 0, 0);
        }
#pragma unroll
        for (int ks = 0; ks < 2; ++ks) {
            const int rl = 32 * ks + 8 * g + qq, ch = 4 * ks + g;
            bf16x8 vf[2], af[4];
#pragma unroll
            for (int et = 0; et < 2; ++et) vf[et] = tr_frag(vimg + rl * 512 + (((2 * wave + et) ^ sR) << 5) + 8 * pp, 2048);
#pragma unroll
            for (int tt = 0; tt < 4; ++tt) { const int rt = 16 * tt + li; af[tt] = *(const LAS bf16x8*)(aimg + rt * 128 + ((ch ^ (rt & 7)) << 4)); }
#pragma unroll
            for (int et = 0; et < 2; ++et)
#pragma unroll
                for (int tt = 0; tt < 4; ++tt) o[et][tt] = __builtin_amdgcn_mfma_f32_16x16x32_bf16(vf[et], af[tt], o[et][tt], 0, 0, 0);
        }
#pragma unroll
        for (int tt = 0; tt < 4; ++tt) { float q2 = 0.f;
#pragma unroll
            for (int et = 0; et < 2; ++et) q2 += (o[et][tt][0] * o[et][tt][0] + o[et][tt][1] * o[et][tt][1]) + (o[et][tt][2] * o[et][tt][2] + o[et][tt][3] * o[et][tt][3]);
            q2 += __shfl_xor(q2, 16); q2 += __shfl_xor(q2, 32);
            if (g == 0) ssq[wave * 64 + 16 * tt + li] = q2; }
        __syncthreads();
#pragma unroll
        for (int tt = 0; tt < 4; ++tt) { const int t = 16 * tt + li; float q2 = 0.f;
#pragma unroll
            for (int w8 = 0; w8 < 8; ++w8) q2 += ssq[w8 * 64 + t];
            const float rs_ = 1.f / sqrtf(q2 * (1.f / 256.f) + LN_EPS);
#pragma unroll
            for (int et = 0; et < 2; ++et) { const int ee = 32 * wave + 16 * et + 4 * g;
                const f32x4 gg = *(const f32x4*)(p.gla_g + ee);
                const u32x2 rw = *(const u32x2*)(PROJ + (rowc + t) * DIN + C_GR + h * 256 + ee);
                const float r0 = __uint_as_float(rw.x << 16), r1 = __uint_as_float(rw.x & 0xffff0000u), r2 = __uint_as_float(rw.y << 16), r3 = __uint_as_float(rw.y & 0xffff0000u);
                u32x2 w; w.x = cvt_pk_bf16(o[et][tt][0] * rs_ * gg[0] * silu_f(r0), o[et][tt][1] * rs_ * gg[1] * silu_f(r1));
                w.y = cvt_pk_bf16(o[et][tt][2] * rs_ * gg[2] * silu_f(r2), o[et][tt][3] * rs_ * gg[3] * silu_f(r3));
                *(u32x2*)(MIXIN + (rowc + t) * D + h * 256 + ee) = w; } }
        if (cc < 3) {
#pragma unroll
            for (int ks = 0; ks < 2; ++ks) {
                const int rl = 32 * ks + 8 * g + qq;
                bf16x8 vf[4], kf[4];
#pragma unroll
                for (int et = 0; et < 4; ++et) vf[et] = tr_frag(vimg + rl * 512 + ((((e0 >> 4) + et) ^ sR) << 5) + 8 * pp, 2048);
#pragma unroll
                for (int dt = 0; dt < 4; ++dt) kf[dt] = tr_frag(kimg + rl * 256 + ((((d0 >> 4) + dt) ^ sR) << 5) + 8 * pp, 1024);
#pragma unroll
                for (int et = 0; et < 4; ++et)
#pragma unroll
                    for (int dt = 0; dt < 4; ++dt) S[et][dt] = __builtin_amdgcn_mfma_f32_16x16x32_bf16(vf[et], kf[dt], S[et][dt], 0, 0, 0);
            }
#pragma unroll
            for (int dt = 0; dt < 4; ++dt) { const float dl = __expf(blast[d0 + 16 * dt + li]);
#pragma unroll
                for (int et = 0; et < 4; ++et) S[et][dt] = S[et][dt] * dl; }
        }
    }
}

__device__ __forceinline__ void ph3_mfma(const Params& p, ldsp_t lds, bool rep = false) {
    bf16_t* PROJ = (bf16_t*)(p.ws + WS_PROJ);
    const float* rope = (const float*)(p.ws + WS_ROPE);
    float* HIDP = (float*)(p.ws + WS_HIDP);
    const int tid = threadIdx.x, lane = tid & 63, wave = tid >> 6, wm0 = (wave >> 1) * 64, wn0 = (wave & 1) * 64;
    if (false) for (int i = blockIdx.x * NTHR + tid; i < NTOK * 12 * 16; i += gridDim.x * NTHR) {
        const int f = i & 15, slot = (i >> 4) % 12, row = i / (16 * 12);
        const int cb = slot < 8 ? C_NQ + slot * 128 : (slot < 10 ? C_KSL + (slot - 8) * 128 : C_KWN + (slot - 10) * 128);
        const int pos = row % T;
        const float cs = rope[pos * 16 + f], sn = rope[65536 + pos * 16 + f];
        bf16_t* q = PROJ + (size_t)row * DIN + cb;
        const float x1 = bf2f(q[f]), x2 = bf2f(q[16 + f]);
        q[f] = f2bf(x1 * cs - x2 * sn); q[16 + f] = f2bf(x2 * cs + x1 * sn);
    }
    for (int u = blockIdx.x; u < 256; u += gridDim.x) {
        if (u < 128) { gla_a_unit(p, lds, u); continue; }
        const int v = u - 128, kv = v >> 6, mt = (v >> 4) & 3, nt = (v >> 3) & 1, ks = v & 7;
        const int m0 = mt * 256, n0 = nt * 128, cbase = kv ? C_VCM : C_KCM;
        TileSrc s;
#pragma unroll
        for (int i = 0; i < 4; ++i) { int rr = m0 + (tid >> 3) + 64 * i; if (rr > 1019) rr = 1019; const int g = rr & 1, bi = rr >> 1, b = bi / 255, ii = bi % 255;
            s.arow[i] = PROJ + (size_t)(b * T + 16 * ii + 4 * ks) * DIN + cbase + g * 128 + (tid & 7) * 8; }
        s.bcol = (kv ? p.w_cv1 : p.w_ck1) + (size_t)(ks * 512) * 256 + n0 + (tid & 31) * 4; s.bvalid = true; s.SA = DIN; s.ldb = 256; s.nkt = 8;
        f32x4 acc[4][4];
        gemm_tile(lds, s, acc);
#pragma unroll
        for (int mi = 0; mi < 4; ++mi)
#pragma unroll
            for (int ni = 0; ni < 4; ++ni) *(f32x4*)(HIDP + ((size_t)(kv * 8 + ks) * 1024 + m0 + wm0 + 16 * mi + (lane & 15)) * 256 + n0 + wn0 + 16 * ni + 4 * (lane >> 4)) = acc[mi][ni];
    }
}

__device__ __forceinline__ void ph3b_mfma(const Params& p, float* lds) {
    const float* HIDP = (const float*)(p.ws + WS_HIDP);
    const float* pebp = (const float*)(p.ws + WS_PEBP);
    const float* rope = (const float*)(p.ws + WS_ROPE);
    const int tid = threadIdx.x;
    for (int u = blockIdx.x; u < 2 * 255; u += gridDim.x) {
        const int kv = u / 255, rg = u % 255;
        const float* w2 = kv ? p.w_cv2 : p.w_ck2; const float* b2 = kv ? p.b_cv2 : p.b_ck2; const float* b1 = kv ? p.b_cv1 : p.b_ck1;
        bf16_t* OUT = (bf16_t*)(p.ws + (kv ? WS_VC : WS_KC));
        __syncthreads();
        for (int i = tid; i < 4 * 256; i += NTHR) { const int n = i & 255; float v = b1[n];
#pragma unroll
            for (int rs = 0; rs < 16; ++rs) v += pebp[(kv * 16 + rs) * 256 + n];
#pragma unroll
            for (int ks = 0; ks < 8; ++ks) v += HIDP[((size_t)(kv * 8 + ks) * 1024 + rg * 4) * 256 + i];
            lds[i] = silu_f(v); }
        __syncthreads();
        const int rl = tid >> 7, d = tid & 127, rr = rg * 4 + rl;
        float sacc = b2[d];
        for (int j = 0; j < 256; ++j) sacc = fmaf(lds[rl * 256 + j], w2[j * 128 + d], sacc);
        lds[1024 + tid] = sacc;
        __syncthreads();
        const int g = rr & 1, bi = rr >> 1, b = bi / 255, n = bi % 255;
        float o = sacc;
        if (kv == 0 && d < 32) {
            const int pos = 16 * n + 31, f = d & 15;
            const float cs = rope[pos * 16 + f], sn = rope[65536 + pos * 16 + f];
            const float x1 = lds[1024 + rl * 128 + f], x2 = lds[1024 + rl * 128 + 16 + f];
            o = d < 16 ? x1 * cs - x2 * sn : x2 * cs + x1 * sn;
        }
        OUT[(((size_t)b * 256 + n) * 2 + g) * 128 + d] = f2bf(o);
    }
}

__device__ __forceinline__ void ph4_mfma(const Params& p, ldsp_t lds, int nrep_gla = 1, int nrep_nsa = 1) {
    unsigned* qh = (unsigned*)(p.ws + WS_CTL) + CW_Q;
    LAS int* nxt = (LAS int*)(lds + LDS_BYTES - 128);
    for (int r = 0; r < nrep_gla; ++r)
    for (;;) {
        __syncthreads();
        if (threadIdx.x == 0) *nxt = (int)__hip_atomic_fetch_add(qh + 128 * r, 1u, __ATOMIC_RELAXED, __HIP_MEMORY_SCOPE_AGENT);
        __syncthreads();
        const int u = *nxt;
        if (u >= 128) break;
        gla_c_unit(p, lds, u);
    }
    for (int r = 0; r < nrep_nsa; ++r)
    for (;;) {
        __syncthreads();
        if (threadIdx.x == 0) *nxt = (int)__hip_atomic_fetch_add(qh + 64 + 128 * r, 1u, __ATOMIC_RELAXED, __HIP_MEMORY_SCOPE_AGENT);
        __syncthreads();
        const int u = *nxt;
        if (u >= 512) break;
        nsa_unit(p, lds, u);
    }
}


__device__ __forceinline__ u32x4 pair16(u32x2 t0, u32x2 t1, int g) {
    const bool odd = g & 1;
    const unsigned s0 = odd ? t0.x : t1.x, s1 = odd ? t0.y : t1.y;
    const unsigned r0 = (unsigned)__shfl_xor((int)s0, 16), r1 = (unsigned)__shfl_xor((int)s1, 16);
    u32x4 o;
    o.x = odd ? r0 : t0.x; o.y = odd ? r1 : t0.y; o.z = odd ? t1.x : r0; o.w = odd ? t1.y : r1;
    return o;
}
__device__ __forceinline__ int lane_id_opaque() { int l; asm volatile("v_mbcnt_lo_u32_b32 %0, -1, 0\n\tv_mbcnt_hi_u32_b32 %0, -1, %0" : "=v"(l)); return l; }
__device__ __forceinline__ int a_src_chunk(int tid) { return ((tid & 3) ^ f4((tid >> 4) & 3)) * 8; }

__device__ __forceinline__ void ph2_v2(const Params& p, ldsp_t lds) {
    const bf16_t* H = (const bf16_t*)(p.ws + WS_H);
    bf16_t* PROJ = (bf16_t*)(p.ws + WS_PROJ);
    const int tid0 = threadIdx.x, wave = __builtin_amdgcn_readfirstlane(tid0 >> 6), wm0 = (wave >> 2) * 128, wn0 = (wave & 3) * 64;
    const int vcu = vcu_of_block();
    constexpr int NT = (DIN + 255) / 256;
    for (int u = vcu; u < 4 * 6 * 32; u += gridDim.x) {
        const int sb = u >> 5, j = u & 31, mt = (sb & 3) * 8 + (j & 7), nt = (sb >> 2) * 4 + (j >> 3);
        if (nt >= NT) continue;
        const int m0 = mt * 256, n0 = nt * 256;
        int tid = threadIdx.x; asm volatile("" : "+v"(tid));
        TileSrc2b s;
#pragma unroll
        for (int i = 0; i < 2; ++i) s.arow[i] = H + (size_t)(m0 + (tid >> 2) + 128 * i) * D + a_src_chunk(tid);
        b_src_setup(s, (const bf16_t*)(p.ws + WS_WINB), DIN, n0, DIN, tid);
        s.SA = 128; s.ldb = DIN; s.nkt = D / 32;
        f32x4 acc[8][4];
        gemm_tile2b(lds, s, acc);
        const int lane = lane_id_opaque();
        const int g = lane >> 4;
        {
          const int c0 = n0 + wn0 + 16;
          const bool is_rope = (c0 >= C_NQ && c0 < C_NQ + 1024 && ((c0 - C_NQ) & 127) == 0) || c0 == C_KSL || c0 == C_KSL + 128 || c0 == C_KWN || c0 == C_KWN + 128;
          if (is_rope) {
              const float* rope = (const float*)(p.ws + WS_ROPE);
#pragma unroll
              for (int mi = 0; mi < 8; ++mi) { const int pos = (m0 + wm0 + 16 * mi + (lane & 15)) % T;
                  const f32x4 cs = *(const f32x4*)(rope + pos * 16 + 4 * g), sn = *(const f32x4*)(rope + 65536 + pos * 16 + 4 * g);
                  const f32x4 x1 = acc[mi][1], x2 = acc[mi][2];
                  acc[mi][1] = x1 * cs - x2 * sn; acc[mi][2] = x2 * cs + x1 * sn; } } }
#pragma unroll
        for (int mi = 0; mi < 8; ++mi)
#pragma unroll
            for (int np = 0; np < 2; ++np) {
                u32x2 t0, t1; t0.x = cvt_pk_bf16(acc[mi][2 * np][0], acc[mi][2 * np][1]); t0.y = cvt_pk_bf16(acc[mi][2 * np][2], acc[mi][2 * np][3]);
                t1.x = cvt_pk_bf16(acc[mi][2 * np + 1][0], acc[mi][2 * np + 1][1]); t1.y = cvt_pk_bf16(acc[mi][2 * np + 1][2], acc[mi][2 * np + 1][3]);
                const u32x4 o = pair16(t0, t1, g);
                const int m = m0 + wm0 + 16 * mi + (lane & 15), n = n0 + wn0 + 32 * np + ((g & 1) ? 16 + 4 * (g - 1) : 4 * g);
                if (n < DIN) *(u32x4*)(PROJ + (size_t)m * DIN + n) = o;
            }
    }
}

__device__ __forceinline__ void ph5_v2(const Params& p, ldsp_t lds) {
    const bf16_t* MIXIN = (const bf16_t*)(p.ws + WS_MIXIN);
    const float* mod = (const float*)(p.ws + WS_MOD);
    float* Z = (float*)(p.ws + WS_Z);
    const int tid0 = threadIdx.x, wave = __builtin_amdgcn_readfirstlane(tid0 >> 6), wm0 = (wave >> 2) * 128, wn0 = (wave & 3) * 64;
    const int vcu = vcu_of_block();
    for (int u = vcu; u < 32 * 8; u += gridDim.x) {
        const int sb = u >> 5, j = u & 31, mt = (sb & 3) * 8 + (j & 7), nt = (sb >> 2) * 4 + (j >> 3);
        const int m0 = mt * 256, n0 = nt * 256;
        int tid = threadIdx.x; asm volatile("" : "+v"(tid));
        TileSrc2b s;
#pragma unroll
        for (int i = 0; i < 2; ++i) s.arow[i] = MIXIN + (size_t)(m0 + (tid >> 2) + 128 * i) * D + a_src_chunk(tid);
        b_src_setup(s, (const bf16_t*)(p.ws + WS_WOB), D, n0, D, tid);
        s.SA = 128; s.ldb = D; s.nkt = D / 32;
        f32x4 acc[8][4];
        gemm_tile2b(lds, s, acc);
        const int lane = lane_id_opaque();
        const int b = m0 / T;
#pragma unroll
        for (int ni = 0; ni < 4; ++ni) {
            const int n = n0 + wn0 + 16 * ni + 4 * (lane >> 4);
            const f32x4 g1 = 1.f + *(const f32x4*)(mod + b * 12288 + 2 * 2048 + n);
#pragma unroll
            for (int mi = 0; mi < 8; ++mi) { const size_t o = (size_t)(m0 + wm0 + 16 * mi + (lane & 15)) * D + n;
                *(f32x4*)(Z + o) = DN_ALPHA * *(const f32x4*)(p.x + o) + g1 * acc[mi][ni]; }
        }
    }
}

__device__ __forceinline__ void ph7_v2(const Params& p, ldsp_t lds) {
    const bf16_t* H2 = (const bf16_t*)(p.ws + WS_H);
    const int* LIST = (const int*)(p.ws + WS_LIST);
    bf16_t* ACT = (bf16_t*)(p.ws + WS_ACT);
    LAS int* li = (LAS int*)(lds + G2_LDS);
    moe_offsets256(p, li);
    const int tid0 = threadIdx.x, wave = __builtin_amdgcn_readfirstlane(tid0 >> 6), wm0 = (wave >> 2) * 128, wn = wave & 3;
    unsigned* qh = (unsigned*)(p.ws + WS_CTL) + CW_Q + 256;
    LAS int* nxt = (LAS int*)(lds + LDS_BYTES - 128);
    const int myx = (int)(xb_xcc_id() & 7u);
    for (int qi = 0; qi < 8; ++qi) {
    const int xq = (myx + qi) & 7;
    for (;;) {
        __syncthreads();
        if (threadIdx.x == 0) *nxt = (int)__hip_atomic_fetch_add(qh + 64 * xq, 1u, __ATOMIC_RELAXED, __HIP_MEMORY_SCOPE_AGENT);
        __syncthreads();
        const int u = *nxt;
        int e = xq, base = 0;
        for (; e < 32; e += 8) { const int ne = (li[72 + e + 1] - li[72 + e]) * 16; if (u < base + ne) break; base += ne; }
        if (e >= 32) break;
        const int mte = li[72 + e + 1] - li[72 + e];
        const int ul = u - base, nt = ul / mte, mt = ul % mte;
        const int cnt = li[e], off = li[32 + e], n0 = nt * 128;
        int tid = threadIdx.x; asm volatile("" : "+v"(tid));
        TileSrc2 s;
#pragma unroll
        for (int i = 0; i < 2; ++i) { int rr = mt * 256 + (tid >> 2) + 128 * i; if (rr >= cnt) rr = cnt - 1; const int slot = LIST[e * 8192 + rr]; s.arow[i] = H2 + (size_t)(slot >> 2) * D + a_src_chunk(tid); }
        { const int c = (tid & 31) * 8, w = c >> 6, jj = c & 63;
          s.bcol = (jj < 32 ? p.w_gate : p.w_up) + (size_t)e * D * DFF + n0 + 32 * w + (jj & 31); }
        s.bvalid = true; s.SA = 128; s.ldb = DFF; s.nkt = D / 32;
        f32x4 acc[8][4];
        const int nmi_ = min(8, max(0, (cnt - mt * 256 - (wave >> 2) * 128 + 15) >> 4));
        gemm_tile2(lds, s, acc, nmi_);
        const int lane = lane_id_opaque();
        { const int g = lane >> 4;
          f32x4 bg[2], bu[2];
#pragma unroll
          for (int ni = 0; ni < 2; ++ni) { const int n = n0 + 32 * wn + 16 * ni + 4 * g; bg[ni] = *(const f32x4*)(p.b_gate + e * DFF + n); bu[ni] = *(const f32x4*)(p.b_up + e * DFF + n); }
#pragma unroll
          for (int mi = 0; mi < 8; ++mi) { const int rr = mt * 256 + wm0 + 16 * mi + (lane & 15);
              u32x2 t[2];
#pragma unroll
              for (int ni = 0; ni < 2; ++ni) { float a[4];
#pragma unroll
                  for (int i = 0; i < 4; ++i) { const float gt = fminf(acc[mi][ni][i] + bg[ni][i], 7.f), up = fminf(fmaxf(acc[mi][ni + 2][i] + bu[ni][i], -7.f), 7.f); a[i] = gt * sigmoid_f(1.702f * gt) * (up + 1.f); }
                  t[ni].x = cvt_pk_bf16(a[0], a[1]); t[ni].y = cvt_pk_bf16(a[2], a[3]); }
              const u32x4 o = pair16(t[0], t[1], g);
              const int n = n0 + 32 * wn + ((g & 1) ? 16 + 4 * (g - 1) : 4 * g);
              if (rr < cnt) *(u32x4*)(ACT + (size_t)(off + rr) * DFF + n) = o; } }
    }
    }
}

__device__ __forceinline__ void ph8_v2(const Params& p, ldsp_t lds) {
    const bf16_t* ACT = (const bf16_t*)(p.ws + WS_ACT);
    const int* LIST = (const int*)(p.ws + WS_LIST);
    const float* TOPW = (const float*)(p.ws + WS_TOPW);
    bf16_t* YP = (bf16_t*)(p.ws + WS_YP);
    LAS int* li = (LAS int*)(lds + G2_LDS);
    moe_offsets256(p, li);
    const int tid0 = threadIdx.x, wave = __builtin_amdgcn_readfirstlane(tid0 >> 6), wm0 = (wave >> 2) * 128, wn0 = (wave & 3) * 64;
    unsigned* qh = (unsigned*)(p.ws + WS_CTL) + CW_Q + 256 + 512;
    LAS int* nxt = (LAS int*)(lds + LDS_BYTES - 128);
    const int myx = (int)(xb_xcc_id() & 7u);
    for (int qi = 0; qi < 8; ++qi) {
    const int xq = (myx + qi) & 7;
    for (;;) {
        __syncthreads();
        if (threadIdx.x == 0) *nxt = (int)__hip_atomic_fetch_add(qh + 64 * xq, 1u, __ATOMIC_RELAXED, __HIP_MEMORY_SCOPE_AGENT);
        __syncthreads();
        const int u = *nxt;
        int e = xq, base = 0;
        for (; e < 32; e += 8) { const int ne = (li[72 + e + 1] - li[72 + e]) * 8; if (u < base + ne) break; base += ne; }
        if (e >= 32) break;
        const int mte = li[72 + e + 1] - li[72 + e];
        const int ul = u - base, nt = ul / mte, mt = ul % mte;
        const int cnt = li[e], off = li[32 + e], n0 = nt * 256;
        int tid = threadIdx.x; asm volatile("" : "+v"(tid));
        TileSrc2 s;
#pragma unroll
        for (int i = 0; i < 2; ++i) { int rr = mt * 256 + (tid >> 2) + 128 * i; if (rr >= cnt) rr = cnt - 1; s.arow[i] = ACT + (size_t)(off + rr) * DFF + a_src_chunk(tid); }
        s.bcol = p.w_down + (size_t)e * DFF * D + n0 + (tid & 31) * 8; s.bvalid = true; s.SA = 128; s.ldb = D; s.nkt = DFF / 32;
        f32x4 acc[8][4];
        const int nmi_ = min(8, max(0, (cnt - mt * 256 - (wave >> 2) * 128 + 15) >> 4));
        gemm_tile2(lds, s, acc, nmi_);
        const int lane = lane_id_opaque();
        { const int g = lane >> 4;
          f32x4 bd[4];
#pragma unroll
          for (int ni = 0; ni < 4; ++ni) bd[ni] = *(const f32x4*)(p.b_down + e * D + n0 + wn0 + 16 * ni + 4 * g);
#pragma unroll
          for (int mi = 0; mi < 8; ++mi) { int rr = mt * 256 + wm0 + 16 * mi + (lane & 15); const bool ok = rr < cnt; if (!ok) rr = cnt - 1;
              const int slot = LIST[e * 8192 + rr]; const float w = TOPW[slot];
#pragma unroll
              for (int np = 0; np < 2; ++np) { u32x2 t[2];
#pragma unroll
                  for (int k2 = 0; k2 < 2; ++k2) { const f32x4 y = w * (acc[mi][2 * np + k2] + bd[2 * np + k2]); t[k2].x = cvt_pk_bf16(y[0], y[1]); t[k2].y = cvt_pk_bf16(y[2], y[3]); }
                  const u32x4 o = pair16(t[0], t[1], g);
                  const int n = n0 + wn0 + 32 * np + ((g & 1) ? 16 + 4 * (g - 1) : 4 * g);
                  if (ok) *(u32x4*)(YP + (size_t)slot * D + n) = o; } } }
    }
    }
}


constexpr int CW_DONE = 32768;
__device__ __forceinline__ void ph78(const Params& p, ldsp_t lds) {
    const bf16_t* H2 = (const bf16_t*)(p.ws + WS_H);
    const int* LIST = (const int*)(p.ws + WS_LIST);
    const float* TOPW = (const float*)(p.ws + WS_TOPW);
    bf16_t* ACT = (bf16_t*)(p.ws + WS_ACT);
    bf16_t* YP = (bf16_t*)(p.ws + WS_YP);
    LAS int* li = (LAS int*)(lds + G2_LDS);
    moe_offsets256(p, li);
    const int tid0 = threadIdx.x, wave = __builtin_amdgcn_readfirstlane(tid0 >> 6), wm0 = (wave >> 2) * 128, wn = wave & 3;
    unsigned* qh = (unsigned*)(p.ws + WS_CTL) + CW_Q + 256;
    unsigned* done = (unsigned*)(p.ws + WS_CTL) + CW_DONE;
    LAS int* nxt = (LAS int*)(lds + LDS_BYTES - 128);
    const int myx = (int)(xb_xcc_id() & 7u);
    const auto actr = __builtin_amdgcn_make_buffer_rsrc((void*)ACT, 0, 0x7fffffff, 0x00020000);
    int pend = -1;
    for (int qi = 0; qi < 8; ++qi) {
    const int xq = (myx + qi) & 7;
    for (;;) {
        asm volatile("s_waitcnt vmcnt(0)" ::: "memory");
        __syncthreads();
        if (threadIdx.x == 0) {
            if (pend >= 0) __hip_atomic_fetch_add(done + 16 * pend, 1u, __ATOMIC_RELAXED, __HIP_MEMORY_SCOPE_AGENT);
            *nxt = (int)__hip_atomic_fetch_add(qh + 64 * xq, 1u, __ATOMIC_RELAXED, __HIP_MEMORY_SCOPE_AGENT);
        }
        pend = -1;
        __syncthreads();
        const int u = *nxt;
        int base = 0, sg = 0, kind = 0, e = 0, mte = 0;
        for (; sg < 8; ++sg) { kind = (0xD4 >> sg) & 1; e = xq + 8 * ((0xED84 >> (2 * sg)) & 3); mte = li[72 + e + 1] - li[72 + e];
            const int ne = mte * (kind ? 8 : 16); if (u < base + ne) break; base += ne; }
        if (sg >= 8) break;
        const int ul = u - base, nt = ul / mte, mt = ul % mte;
        const int cnt = li[e], off = li[32 + e], n0 = kind ? nt * 256 : nt * 128;
        int tid = threadIdx.x; asm volatile("" : "+v"(tid));
        TileSrc2 s;
        if (kind == 0) {
#pragma unroll
            for (int i = 0; i < 2; ++i) { int rr = mt * 256 + (tid >> 2) + 128 * i; if (rr >= cnt) rr = cnt - 1; const int slot = LIST[e * 8192 + rr]; s.arow[i] = H2 + (size_t)(slot >> 2) * D + a_src_chunk(tid); }
            const int c = (tid & 31) * 8, w = c >> 6, jj = c & 63;
            s.bcol = (jj < 32 ? p.w_gate : p.w_up) + (size_t)e * D * DFF + n0 + 32 * w + (jj & 31);
        } else {
#pragma unroll
            for (int i = 0; i < 2; ++i) { int rr = mt * 256 + (tid >> 2) + 128 * i; if (rr >= cnt) rr = cnt - 1; s.arow[i] = ACT + (size_t)(off + rr) * DFF + a_src_chunk(tid); }
            s.bcol = p.w_down + (size_t)e * DFF * D + n0 + (tid & 31) * 8;
            if (threadIdx.x == 0) {
                unsigned sp = 0;
                while (__hip_atomic_load(done + 16 * (e * 32 + mt), __ATOMIC_RELAXED, __HIP_MEMORY_SCOPE_AGENT) < 16u) { __builtin_amdgcn_s_sleep(2); if (++sp > (1u << 22)) break; }
                __builtin_amdgcn_fence(__ATOMIC_ACQUIRE, "agent");
                asm volatile("s_waitcnt vmcnt(0)" ::: "memory");
            }
        }
        s.bvalid = true; s.SA = 128; s.ldb = DFF; s.nkt = D / 32;
        f32x4 acc[8][4];
        const int nmi_ = min(8, max(0, (cnt - mt * 256 - (wave >> 2) * 128 + 15) >> 4));
        gemm_tile2(lds, s, acc, nmi_);
        const int lane = lane_id_opaque();
        const int g = lane >> 4;
        if (kind == 0) {
          f32x4 bg[2], bu[2];
#pragma unroll
          for (int ni = 0; ni < 2; ++ni) { const int n = n0 + 32 * wn + 16 * ni + 4 * g; bg[ni] = *(const f32x4*)(p.b_gate + e * DFF + n); bu[ni] = *(const f32x4*)(p.b_up + e * DFF + n); }
#pragma unroll
          for (int mi = 0; mi < 8; ++mi) { const int rr = mt * 256 + wm0 + 16 * mi + (lane & 15);
              u32x2 t[2];
#pragma unroll
              for (int ni = 0; ni < 2; ++ni) { float a[4];
#pragma unroll
                  for (int i = 0; i < 4; ++i) { const float gt = fminf(acc[mi][ni][i] + bg[ni][i], 7.f), up = fminf(fmaxf(acc[mi][ni + 2][i] + bu[ni][i], -7.f), 7.f); a[i] = gt * sigmoid_f(1.702f * gt) * (up + 1.f); }
                  t[ni].x = cvt_pk_bf16(a[0], a[1]); t[ni].y = cvt_pk_bf16(a[2], a[3]); }
              const u32x4 o = pair16(t[0], t[1], g);
              const int n = n0 + 32 * wn + ((g & 1) ? 16 + 4 * (g - 1) : 4 * g);
              if (rr < cnt) __builtin_amdgcn_raw_buffer_store_b128(o, actr, ((off + rr) * DFF + n) * 2, 0, 16); }
          pend = e * 32 + mt;
        } else {
          const int wn0 = wn * 64;
          f32x4 bd[4];
#pragma unroll
          for (int ni = 0; ni < 4; ++ni) bd[ni] = *(const f32x4*)(p.b_down + e * D + n0 + wn0 + 16 * ni + 4 * g);
#pragma unroll
          for (int mi = 0; mi < 8; ++mi) { int rr = mt * 256 + wm0 + 16 * mi + (lane & 15); const bool ok = rr < cnt; if (!ok) rr = cnt - 1;
              const int slot = LIST[e * 8192 + rr]; const float w = TOPW[slot];
#pragma unroll
              for (int np = 0; np < 2; ++np) { u32x2 t[2];
#pragma unroll
                  for (int k2 = 0; k2 < 2; ++k2) { const f32x4 y = w * (acc[mi][2 * np + k2] + bd[2 * np + k2]); t[k2].x = cvt_pk_bf16(y[0], y[1]); t[k2].y = cvt_pk_bf16(y[2], y[3]); }
                  const u32x4 o = pair16(t[0], t[1], g);
                  const int n = n0 + wn0 + 32 * np + ((g & 1) ? 16 + 4 * (g - 1) : 4 * g);
                  if (ok) *(u32x4*)(YP + (size_t)slot * D + n) = o; } }
        }
    }
    }
}

__device__ __forceinline__ void ph6_v2(const Params& p, ldsp_t lds, const int rep = 0) {
    const float* Z = (const float*)(p.ws + WS_Z);
    const float* mod = (const float*)(p.ws + WS_MOD);
    float* X1 = (float*)(p.ws + WS_X1);
    bf16_t* H2 = (bf16_t*)(p.ws + WS_H);
    const bf16_t* WRT = (const bf16_t*)(p.ws + WS_WRT);
    float* TOPW = (float*)(p.ws + WS_TOPW + (rep ? 512 * 1024 : 0));
    int* LIST = (int*)(p.ws + WS_LIST + (rep ? MiB : 0));
    unsigned* ctl = (unsigned*)(p.ws + WS_CTL) + (rep ? 32 * 64 : 0);
    const int tid = threadIdx.x, lane = tid & 63, wave = __builtin_amdgcn_readfirstlane(tid >> 6);
    ldsp_t img_hi = lds, img_lo = lds + 65536;
    LAS float* part = (LAS float*)(lds + 131072);
    LAS float* lgt = (LAS float*)(lds + 131072 + 16384);
    for (int blk = blockIdx.x; blk < NTOK / 32; blk += gridDim.x) {
        for (int half = 0; half < 2; ++half) {
            __syncthreads();
#pragma unroll 1
            for (int rr = 0; rr < 2; ++rr) {
                const int rl = 2 * wave + rr, row = blk * 32 + half * 16 + rl, b = row / T;
                const f32x4* zr = (const f32x4*)(Z + (size_t)row * D) + lane;
                f32x4 v[8]; float s1 = 0.f;
#pragma unroll
                for (int j = 0; j < 8; ++j) { v[j] = zr[64 * j]; s1 += (v[j][0] + v[j][1]) + (v[j][2] + v[j][3]); }
                float mean = wave_sum(s1) * (1.f / D), s2 = 0.f;
#pragma unroll
                for (int j = 0; j < 8; ++j) { v[j] = v[j] - mean; s2 += (v[j][0] * v[j][0] + v[j][1] * v[j][1]) + (v[j][2] * v[j][2] + v[j][3] * v[j][3]); }
                float rstd = 1.f / sqrtf(wave_sum(s2) * (1.f / D) + LN_EPS);
                s1 = 0.f;
#pragma unroll
                for (int j = 0; j < 8; ++j) { const int c0 = 256 * j + lane * 4;
                    v[j] = v[j] * rstd * *(const f32x4*)(p.ln1_g + c0) + *(const f32x4*)(p.ln1_b + c0);
                    *(f32x4*)(X1 + (size_t)row * D + c0) = v[j];
                    s1 += (v[j][0] + v[j][1]) + (v[j][2] + v[j][3]); }
                mean = wave_sum(s1) * (1.f / D); s2 = 0.f;
#pragma unroll
                for (int j = 0; j < 8; ++j) { v[j] = v[j] - mean; s2 += (v[j][0] * v[j][0] + v[j][1] * v[j][1]) + (v[j][2] * v[j][2] + v[j][3] * v[j][3]); }
                rstd = 1.f / sqrtf(wave_sum(s2) * (1.f / D) + LN_EPS);
                u32x2* o8 = (u32x2*)(H2 + (size_t)row * D) + lane;
#pragma unroll
                for (int j = 0; j < 8; ++j) { const int c0 = 256 * j + lane * 4;
                    const f32x4 sh = *(const f32x4*)(mod + b * 12288 + 3 * 2048 + c0), sc = *(const f32x4*)(mod + b * 12288 + 4 * 2048 + c0);
                    const f32x4 h = v[j] * rstd * (1.f + sc) + sh;
                    u32x2 hi; hi.x = cvt_pk_bf16(h[0], h[1]); hi.y = cvt_pk_bf16(h[2], h[3]);
                    o8[64 * j] = hi;
                    const float r0 = h[0] - __uint_as_float(hi.x << 16), r1 = h[1] - __uint_as_float(hi.x & 0xffff0000u), r2 = h[2] - __uint_as_float(hi.y << 16), r3 = h[3] - __uint_as_float(hi.y & 0xffff0000u);
                    u32x2 lo; lo.x = cvt_pk_bf16(r0, r1); lo.y = cvt_pk_bf16(r2, r3);
                    const unsigned off = (unsigned)(rl * 4096 + ((((32 * j + (lane >> 1))) ^ (rl & 15)) << 4) + (lane & 1) * 8);
                    *(LAS u32x2*)(img_hi + off) = hi; *(LAS u32x2*)(img_lo + off) = lo; }
            }
            __syncthreads();
            { const int r = lane & 15, g = lane >> 4;
              f32x4 acc[2] = {(f32x4){0.f, 0.f, 0.f, 0.f}, (f32x4){0.f, 0.f, 0.f, 0.f}};
#pragma unroll 2
              for (int ks = 0; ks < 8; ++ks) {
                  const int k0 = 256 * wave + 32 * ks, ch = (k0 >> 3) + g;
                  const unsigned aoff = (unsigned)(r * 4096 + ((ch ^ r) << 4));
                  const bf16x8 ahi = *(const LAS bf16x8*)(img_hi + aoff), alo = *(const LAS bf16x8*)(img_lo + aoff);
#pragma unroll
                  for (int et = 0; et < 2; ++et) {
                      const bf16x8 whi = *(const bf16x8*)(WRT + (size_t)(16 * et + r) * 2048 + k0 + 8 * g);
                      const bf16x8 wlo = *(const bf16x8*)(WRT + 65536 + (size_t)(16 * et + r) * 2048 + k0 + 8 * g);
                      acc[et] = __builtin_amdgcn_mfma_f32_16x16x32_bf16(whi, ahi, acc[et], 0, 0, 0);
                      acc[et] = __builtin_amdgcn_mfma_f32_16x16x32_bf16(whi, alo, acc[et], 0, 0, 0);
                      acc[et] = __builtin_amdgcn_mfma_f32_16x16x32_bf16(wlo, ahi, acc[et], 0, 0, 0);
                  }
              }
#pragma unroll
              for (int et = 0; et < 2; ++et)
#pragma unroll
                  for (int i = 0; i < 4; ++i) part[(wave * 16 + r) * 32 + 16 * et + 4 * g + i] = acc[et][i];
            }
            __syncthreads();
            { const int rl = tid >> 5, e = tid & 31; float sum = p.b_router[e];
#pragma unroll
              for (int w8 = 0; w8 < 8; ++w8) sum += part[(w8 * 16 + rl) * 32 + e];
              lgt[rl * 32 + e] = sum; }
            __syncthreads();
            if (tid < 16) {
                const int row = blk * 32 + half * 16 + tid;
                float tv[4]; int ti[4];
#pragma unroll
                for (int k = 0; k < 4; ++k) { tv[k] = -INFINITY; ti[k] = 0; }
                for (int e = 0; e < 32; ++e) {
                    const float v = lgt[tid * 32 + e];
                    if (v > tv[3]) {
                        if (v > tv[0]) { tv[3] = tv[2]; ti[3] = ti[2]; tv[2] = tv[1]; ti[2] = ti[1]; tv[1] = tv[0]; ti[1] = ti[0]; tv[0] = v; ti[0] = e; }
                        else if (v > tv[1]) { tv[3] = tv[2]; ti[3] = ti[2]; tv[2] = tv[1]; ti[2] = ti[1]; tv[1] = v; ti[1] = e; }
                        else if (v > tv[2]) { tv[3] = tv[2]; ti[3] = ti[2]; tv[2] = v; ti[2] = e; }
                        else { tv[3] = v; ti[3] = e; }
                    }
                }
                const float e1 = __expf(tv[1] - tv[0]), e2 = __expf(tv[2] - tv[0]), e3 = __expf(tv[3] - tv[0]);
                const float isum = 1.f / (1.f + e1 + e2 + e3);
                const float ww[4] = {isum, e1 * isum, e2 * isum, e3 * isum};
#pragma unroll
                for (int k = 0; k < 4; ++k) {
                    const unsigned pos = atomicAdd(ctl + CW_CNT + 64 * ti[k], 1u);
                    LIST[ti[k] * 8192 + pos] = row * 4 + k;
                    TOPW[row * 4 + k] = ww[k];
                }
            }
        }
    }
}


constexpr int NPHASE = 11;
__global__ void __launch_bounds__(NTHR, 2) fwd_kernel(Params p) {
    extern __shared__ __attribute__((aligned(16))) unsigned char lds_raw[];
    float* lds = (float*)lds_raw;
    volatile LAS unsigned* misc = (volatile LAS unsigned*)((LAS unsigned char*)lds_raw + LDS_BYTES - 64);
    if (threadIdx.x < 16) misc[threadIdx.x] = 0u;
    __syncthreads();
    unsigned* ctl = (unsigned*)(p.ws + WS_CTL);
    const bool multi = (p.ph_hi - p.ph_lo) > 1;
    XcdBarrier bar; bar.bar = ctl + CW_BAR; bar.x = 0; bar.st = misc;
    if (multi) bar = xcd_barrier_post(ctl + CW_BAR, misc);
#define IN(k) (p.ph_lo <= (k) && (k) < p.ph_hi)
#ifndef REPEAT_PHASE
#define REPEAT_PHASE -1
#endif
#define SEAM(k) do { if (IN(k) && IN((k) + 1)) xcd_barrier(bar); } while (0)
    if (IN(0)) { ph0(p, lds); if (REPEAT_PHASE == 0) ph0(p, lds); }
    SEAM(0);
    if (IN(1)) { ph1(p, lds); if (REPEAT_PHASE == 1) ph1(p, lds); }
    SEAM(1);
    if (IN(2)) { ph2_v2(p, (ldsp_t)lds_raw); if (REPEAT_PHASE == 2) ph2_v2(p, (ldsp_t)lds_raw); }
    SEAM(2);
    if (IN(3)) { ph3_mfma(p, (ldsp_t)lds_raw); if (REPEAT_PHASE == 3) ph3_mfma(p, (ldsp_t)lds_raw, true); }
    SEAM(3);
    if (IN(4)) { ph3b_mfma(p, lds); if (REPEAT_PHASE == 4) ph3b_mfma(p, lds); }
    SEAM(4);
    if (IN(5)) ph4_mfma(p, (ldsp_t)lds_raw, REPEAT_PHASE == 50 ? 2 : 1, REPEAT_PHASE == 51 ? 2 : 1);
    SEAM(5);
    if (IN(6)) { ph5_v2(p, (ldsp_t)lds_raw); if (REPEAT_PHASE == 6) ph5_v2(p, (ldsp_t)lds_raw); }
    SEAM(6);
    if (IN(7)) { for (int r7 = 0; r7 < (REPEAT_PHASE == 7 ? 2 : 1); ++r7) ph6_v2(p, (ldsp_t)lds_raw, r7); }
    SEAM(7);
    if (IN(8)) ph78(p, (ldsp_t)lds_raw);
    SEAM(9);
    if (IN(10)) { ph9(p, lds); if (REPEAT_PHASE == 10) ph9(p, lds); }
}

extern "C" void kernel_launch(void* const* d_in, const int* in_sizes, int n_in, void* d_out, int out_size, void* d_ws, size_t ws_size, hipStream_t stream) {
    static int grid = 0;
    if (grid == 0) {
        int dev = 0, cus = 0;
        if (hipGetDevice(&dev) != hipSuccess || hipDeviceGetAttribute(&cus, hipDeviceAttributeMultiprocessorCount, dev) != hipSuccess) { fprintf(stderr, "kernel_launch: device query failed\n"); grid = -1; return; }
        if (hipFuncSetAttribute((const void*)fwd_kernel, hipFuncAttributeMaxDynamicSharedMemorySize, LDS_BYTES) != hipSuccess) { fprintf(stderr, "kernel_launch: hipFuncSetAttribute failed\n"); grid = -1; return; }
        if (n_in != 31 || ws_size < WS_END) { fprintf(stderr, "kernel_launch: unexpected n_in %d / ws %zu\n", n_in, ws_size); grid = -1; return; }
        (void)hipGetLastError();
        grid = cus;
    }
    if (grid < 0) return;
    (void)hipMemsetAsync((char*)d_ws + WS_CTL, 0, CTL_BYTES, stream);
    Params p{};
    const float** f = (const float**)&p;
    for (int i = 0; i < 31; ++i) f[i] = (const float*)d_in[i];
    p.out = (float*)d_out; p.ws = (unsigned char*)d_ws;
#if N_LAUNCH_MODE == 1
    p.ph_lo = 0; p.ph_hi = NPHASE;
    hipLaunchKernelGGL(fwd_kernel, dim3(grid), dim3(NTHR), LDS_BYTES, stream, p);
#else
    for (int k = 0; k < NPHASE; ++k) { p.ph_lo = k; p.ph_hi = k + 1; hipLaunchKernelGGL(fwd_kernel, dim3(grid), dim3(NTHR), LDS_BYTES, stream, p); }
#endif
}
```

```cpp
#include <hip/hip_runtime.h>
#include <stdint.h>
#include <cstdio>

#ifndef N_LAUNCH_MODE
#define N_LAUNCH_MODE 1
#endif

typedef unsigned short bf16_t;
typedef float f32x4 __attribute__((ext_vector_type(4)));
#define LAS __attribute__((address_space(3)))

constexpr int NB = 2, T = 4096, D = 2048, NTOK = NB * T;
constexpr int DIN = 5672;
constexpr int C_GQ = 0, C_GK = 512, C_GV = 1024, C_GR = 2048, C_GLR = 3072, C_NQ = 3088, C_KCM = 4112, C_VCM = 4368,
              C_KSL = 4624, C_VSL = 4880, C_KWN = 5136, C_VWN = 5392, C_NGT = 5648;
constexpr int NE = 32, TOPK = 4, DFF = 2048;
constexpr int NCMP = 255;
constexpr float LN_EPS = 1e-5f;
constexpr float DN_ALPHA = 1.189207115002721f;
constexpr int NTHR = 512;

constexpr size_t MiB = 1u << 20;
constexpr size_t WS_CTL = 0, CTL_BYTES = 1 * MiB;
constexpr size_t WS_MODP = 1 * MiB;
constexpr size_t WS_MOD = 2 * MiB;
constexpr size_t WS_ROPE = 3 * MiB;
constexpr size_t WS_PEBP = 4 * MiB;
constexpr size_t WS_KC = 5 * MiB;
constexpr size_t WS_VC = 6 * MiB;
constexpr size_t WS_H = 16 * MiB;
constexpr size_t WS_PROJ = 48 * MiB;
constexpr size_t WS_MIXIN = 144 * MiB;
constexpr size_t WS_Z = 176 * MiB;
constexpr size_t WS_X1 = 240 * MiB;
constexpr size_t WS_TOPW = 304 * MiB;
constexpr size_t WS_LIST = 305 * MiB;
constexpr size_t WS_ACT = 340 * MiB;
constexpr size_t WS_YP = 470 * MiB;
constexpr size_t WS_HIDP = 600 * MiB;
constexpr size_t WS_BC = 616 * MiB;
constexpr size_t WS_U = 632 * MiB;
constexpr size_t WS_DTOT = 648 * MiB;
constexpr size_t WS_WRT = 650 * MiB;
constexpr size_t WS_WINB = 652 * MiB;
constexpr size_t WS_WOB = 676 * MiB;
constexpr size_t WS_END = 686 * MiB;
constexpr int CW_BAR = 4096;
constexpr int CW_CNT = 8192;
constexpr int CW_Q = 12288;

constexpr int LDS_BYTES = 160 * 1024;

__device__ __forceinline__ float bf2f(bf16_t b) { return __uint_as_float(((unsigned)b) << 16); }
__device__ __forceinline__ bf16_t f2bf(float f) { unsigned u = __float_as_uint(f); u += 0x7fffu + ((u >> 16) & 1u); return (bf16_t)(u >> 16); }
__device__ __forceinline__ unsigned pk2(float lo, float hi) { return (unsigned)f2bf(lo) | ((unsigned)f2bf(hi) << 16); }
__device__ __forceinline__ float silu_f(float x) { return x / (1.f + __expf(-x)); }
__device__ __forceinline__ float sigmoid_f(float x) { return 1.f / (1.f + __expf(-x)); }
__device__ __forceinline__ float logsigmoid_f(float x) { return fminf(x, 0.f) - log1pf(__expf(-fabsf(x))); }
__device__ __forceinline__ float wave_sum(float v) {
#pragma unroll
    for (int o = 1; o < 64; o <<= 1) v += __shfl_xor(v, o);
    return v;
}
__device__ __forceinline__ float wave_max(float v) {
#pragma unroll
    for (int o = 1; o < 64; o <<= 1) v = fmaxf(v, __shfl_xor(v, o));
    return v;
}

#define XB_TMO      128
#define XB_XCNT(j)  (256  + 64 * (j))
#define XB_XSUB(j)  (1280 + 64 * (j))
#define XB_XGEN(j)  (2304 + 64 * (j))
#define XB_TOP      3328
#define XB_TOPGEN   3392
#define XCD_BAR_WORDS 3456
#define XB_SPIN_CAP (1u << 18)
__device__ __forceinline__ unsigned xb_ld(unsigned* p)              { return __hip_atomic_load(p, __ATOMIC_RELAXED, __HIP_MEMORY_SCOPE_AGENT); }
__device__ __forceinline__ unsigned xb_add(unsigned* p, unsigned v) { return __hip_atomic_fetch_add(p, v, __ATOMIC_RELAXED, __HIP_MEMORY_SCOPE_AGENT); }
__device__ __forceinline__ unsigned xb_xcc_id() { return (unsigned)__builtin_amdgcn_s_getreg((3 << 11) | 20) & 0xFu; }
#define XB_SPIN(cond, bar) do { unsigned _sp = 0; while (cond) { __builtin_amdgcn_s_sleep(1); \
    if ((++_sp & 255u) == 0u) { if (xb_ld(&(bar)[XB_TMO])) break; if (_sp > XB_SPIN_CAP) { atomicAdd(&(bar)[XB_TMO], 1u); break; } } } } while (0)
struct XcdBarrier { unsigned* bar; unsigned x; volatile LAS unsigned* st; };
__device__ __forceinline__ XcdBarrier xcd_barrier_post(unsigned* bar, volatile LAS unsigned* st) {
    XcdBarrier b; b.bar = bar; b.x = xb_xcc_id(); b.st = st;
    if (threadIdx.x == 0) (void)xb_add(&bar[XB_XCNT(b.x)], 1u);
    return b;
}
__device__ __forceinline__ void xcd_barrier_complete(unsigned* bar, unsigned x, unsigned& nloc, unsigned& nx) {
    const unsigned G = gridDim.x * gridDim.y * gridDim.z;
    unsigned sum, cnt, mine, sp = 0u;
    for (;;) {
        sum = 0u; cnt = 0u; mine = 0u;
#pragma unroll
        for (unsigned j = 0; j < 16; ++j) { const unsigned c = xb_ld(&bar[XB_XCNT(j)]); sum += c; cnt += (c > 0u) ? 1u : 0u; mine = (j == x) ? c : mine; }
        if (sum == G) break;
        __builtin_amdgcn_s_sleep(1);
        if ((++sp & 255u) == 0u) { if (xb_ld(&bar[XB_TMO])) break; if (sp > XB_SPIN_CAP) { atomicAdd(&bar[XB_TMO], 1u); break; } }
    }
    nloc = mine > 0u ? mine : 1u; nx = cnt > 0u ? cnt : 1u;
}
__device__ __forceinline__ void xcd_barrier(const XcdBarrier& b) {
    asm volatile("s_waitcnt vmcnt(0)" ::: "memory");
    __syncthreads();
    if (threadIdx.x == 0) {
        unsigned* bar = b.bar;
        __builtin_amdgcn_s_waitcnt(0);
        unsigned nloc = b.st[0], nx = b.st[1];
        if (nloc == 0u) { xcd_barrier_complete(bar, b.x, nloc, nx); b.st[0] = nloc; b.st[1] = nx; }
        const unsigned old = xb_add(&bar[XB_XSUB(b.x)], 1u);
        const unsigned gen = old / nloc;
        if (old + 1u == (gen + 1u) * nloc) {
            __builtin_amdgcn_fence(__ATOMIC_RELEASE, "agent");
            asm volatile("s_waitcnt vmcnt(0)" ::: "memory");
            const unsigned og = xb_add(&bar[XB_TOP], 1u);
            const unsigned tg = og / nx;
            if (og + 1u == (tg + 1u) * nx) xb_add(&bar[XB_TOPGEN], 1u);
            else XB_SPIN(xb_ld(&bar[XB_TOPGEN]) == tg, bar);
            __builtin_amdgcn_fence(__ATOMIC_ACQUIRE, "agent");
            xb_add(&bar[XB_XGEN(b.x)], 1u);
            asm volatile("s_waitcnt vmcnt(0)" ::: "memory");
        } else {
            XB_SPIN(xb_ld(&bar[XB_XGEN(b.x)]) == gen, bar);
            __builtin_amdgcn_fence(__ATOMIC_ACQUIRE, "agent");
            asm volatile("s_waitcnt vmcnt(0)" ::: "memory");
        }
    }
    __syncthreads();
}

struct Params {
    const float *x, *c, *w_ada, *b_ada, *w_in, *w_gk, *b_gk, *gla_g, *pe_k, *pe_v;
    const float *w_ck1, *b_ck1, *w_ck2, *b_ck2, *w_cv1, *b_cv1, *w_cv2, *b_cv2, *w_o, *ln1_g, *ln1_b;
    const float *w_router, *b_router, *w_gate, *b_gate, *w_up, *b_up, *w_down, *b_down, *ln2_g, *ln2_b;
    float* out; unsigned char* ws;
    int ph_lo, ph_hi;
};


__device__ __forceinline__ void ph0(const Params& p, float* lds) {
    const int tid = threadIdx.x, lane = tid & 63, wave = tid >> 6;
    float* modp = (float*)(p.ws + WS_MODP);
    float* rope = (float*)(p.ws + WS_ROPE);
    float* pebp = (float*)(p.ws + WS_PEBP);
    for (int u = blockIdx.x; u < 384; u += gridDim.x) {
        const int cb = u % 48, kc = u / 48;
        const int col = cb * 256 + lane * 4, kb = kc * 256 + wave * 32;
        f32x4 a0 = {0.f, 0.f, 0.f, 0.f}, a1 = {0.f, 0.f, 0.f, 0.f};
#pragma unroll 8
        for (int k = kb; k < kb + 32; ++k) {
            const f32x4 w = *(const f32x4*)(p.w_ada + (size_t)k * 12288 + col);
            const float s0 = silu_f(p.c[k]), s1 = silu_f(p.c[D + k]);
            a0 += s0 * w; a1 += s1 * w;
        }
        __syncthreads();
        *(f32x4*)(lds + (wave * 2 + 0) * 256 + lane * 4) = a0;
        *(f32x4*)(lds + (wave * 2 + 1) * 256 + lane * 4) = a1;
        __syncthreads();
        { const int b = tid >> 8, cc = tid & 255; float s = 0.f;
#pragma unroll
          for (int w = 0; w < 8; ++w) s += lds[(w * 2 + b) * 256 + cc];
          modp[((size_t)kc * 2 + b) * 12288 + cb * 256 + cc] = s; }
    }
    for (int i = blockIdx.x * NTHR + tid; i < 4096 * 16; i += gridDim.x * NTHR) {
        const int pos = i >> 4, f = i & 15;
        const double inv = pow(500000.0, -(double)f / 16.0);
        const double ang = (double)pos * inv;
        rope[i] = (float)cos(ang); rope[65536 + i] = (float)sin(ang);
    }
    { bf16_t* winb = (bf16_t*)(p.ws + WS_WINB); bf16_t* wob = (bf16_t*)(p.ws + WS_WOB);
      const size_t n1 = (size_t)D * DIN / 8, n2 = (size_t)D * D / 8;
      for (size_t i = (size_t)blockIdx.x * NTHR + tid; i < n1 + n2; i += (size_t)gridDim.x * NTHR) {
          const float* src = i < n1 ? p.w_in + i * 8 : p.w_o + (i - n1) * 8; bf16_t* dst = i < n1 ? winb + i * 8 : wob + (i - n1) * 8;
          const f32x4 a = *(const f32x4*)src, b = *(const f32x4*)(src + 4);
          uint4 o; o.x = pk2(a[0], a[1]); o.y = pk2(a[2], a[3]); o.z = pk2(b[0], b[1]); o.w = pk2(b[2], b[3]);
          *(uint4*)dst = o; } }
    { bf16_t* wrt = (bf16_t*)(p.ws + WS_WRT);
      for (int i = blockIdx.x * NTHR + tid; i < 2048 * 32; i += gridDim.x * NTHR) {
          const int k = i >> 5, e = i & 31; const float w = p.w_router[i];
          const bf16_t hi = f2bf(w); const bf16_t lo = f2bf(w - bf2f(hi));
          wrt[e * 2048 + k] = hi; wrt[65536 + e * 2048 + k] = lo; } }
    for (int u = blockIdx.x; u < 32; u += gridDim.x) {
        const int kv = u >> 4, rs = u & 15;
        const float* w1 = kv ? p.w_cv1 : p.w_ck1; const float* pe = kv ? p.pe_v : p.pe_k;
        const int j = tid & 255, half = tid >> 8;
        float s = 0.f;
        for (int r = rs * 256 + half * 128; r < rs * 256 + half * 128 + 128; ++r) s = fmaf(pe[r], w1[(size_t)r * 256 + j], s);
        __syncthreads();
        lds[tid] = s;
        __syncthreads();
        if (tid < 256) pebp[(kv * 16 + rs) * 256 + tid] = lds[tid] + lds[tid + 256];
    }
}

__device__ __forceinline__ void ph1(const Params& p, float* lds) {
    const int tid = threadIdx.x, lane = tid & 63, wave = tid >> 6;
    const float* modp = (const float*)(p.ws + WS_MODP);
    float* mod = (float*)(p.ws + WS_MOD);
    bf16_t* H = (bf16_t*)(p.ws + WS_H);
    for (int i = blockIdx.x * NTHR + tid; i < 2 * 12288; i += gridDim.x * NTHR) {
        const int b = i / 12288, col = i % 12288;
        float v = p.b_ada[col];
#pragma unroll
        for (int kc = 0; kc < 8; ++kc) v += modp[((size_t)kc * 2 + b) * 12288 + col];
        mod[i] = v;
    }
    const int rpb = (((NTOK + (int)gridDim.x - 1) / (int)gridDim.x) + 7) & ~7;
    int cached_b = -1;
    for (int r0 = blockIdx.x * rpb; r0 < min(NTOK, (int)(blockIdx.x + 1) * rpb); r0 += 8) {
        const int row = r0 + wave;
        const int bb = r0 / T;
        if (bb != cached_b) {
            __syncthreads();
            for (int i = tid; i < 4096; i += NTHR) { const int seg = i >> 11, jx = i & 2047, col = seg * 2048 + jx;
                float v = p.b_ada[col];
#pragma unroll
                for (int kc = 0; kc < 8; ++kc) v += modp[((size_t)kc * 2 + bb) * 12288 + col];
                lds[i] = v; }
            __syncthreads();
            cached_b = bb;
        }
        if (row >= NTOK) continue;
        const f32x4* xr = (const f32x4*)(p.x + (size_t)row * D) + lane;
        f32x4 v[8]; float s = 0.f;
#pragma unroll
        for (int j2 = 0; j2 < 8; ++j2) { v[j2] = xr[64 * j2]; s += (v[j2][0] + v[j2][1]) + (v[j2][2] + v[j2][3]); }
        const float mean = wave_sum(s) * (1.f / D); float s2 = 0.f;
#pragma unroll
        for (int j2 = 0; j2 < 8; ++j2) { v[j2] = v[j2] - mean; s2 += (v[j2][0] * v[j2][0] + v[j2][1] * v[j2][1]) + (v[j2][2] * v[j2][2] + v[j2][3] * v[j2][3]); }
        const float rstd = 1.f / sqrtf(wave_sum(s2) * (1.f / D) + LN_EPS);
        unsigned long long* o8 = (unsigned long long*)(H + (size_t)row * D) + lane;
#pragma unroll
        for (int j2 = 0; j2 < 8; ++j2) {
            const int c0 = 256 * j2 + lane * 4;
            const f32x4 sh = *(const f32x4*)(lds + c0), sc = *(const f32x4*)(lds + 2048 + c0);
            const f32x4 y = v[j2] * rstd * (1.f + sc) + sh;
            o8[64 * j2] = (unsigned long long)pk2(y[0], y[1]) | ((unsigned long long)pk2(y[2], y[3]) << 32);
        }
    }
}


__device__ __forceinline__ void ph9(const Params& p, float* lds) {
    const float* Z = (const float*)(p.ws + WS_Z);
    const float* mod = (const float*)(p.ws + WS_MOD);
    const bf16_t* YP = (const bf16_t*)(p.ws + WS_YP);
    const int tid = threadIdx.x, lane = tid & 63, wave = tid >> 6;
    for (int row = blockIdx.x * 8 + wave; row < NTOK; row += gridDim.x * 8) {
        const int b = row / T;
        f32x4 v[8]; float s = 0.f;
        { const f32x4* zr = (const f32x4*)(Z + (size_t)row * D) + lane;
          float s1 = 0.f;
#pragma unroll
          for (int j = 0; j < 8; ++j) { v[j] = zr[64 * j]; s1 += (v[j][0] + v[j][1]) + (v[j][2] + v[j][3]); }
          const float mean1 = wave_sum(s1) * (1.f / D); float q1 = 0.f;
#pragma unroll
          for (int j = 0; j < 8; ++j) { v[j] = v[j] - mean1; q1 += (v[j][0] * v[j][0] + v[j][1] * v[j][1]) + (v[j][2] * v[j][2] + v[j][3] * v[j][3]); }
          const float rstd1 = 1.f / sqrtf(wave_sum(q1) * (1.f / D) + LN_EPS);
#pragma unroll
          for (int j = 0; j < 8; ++j) { const int c0 = 256 * j + lane * 4; v[j] = v[j] * rstd1 * *(const f32x4*)(p.ln1_g + c0) + *(const f32x4*)(p.ln1_b + c0); } }
#pragma unroll
        for (int j = 0; j < 8; ++j) { const int c0 = 256 * j + lane * 4;
            f32x4 y = {0.f, 0.f, 0.f, 0.f};
#pragma unroll
            for (int k = 0; k < 4; ++k) { const unsigned long long w = *(const unsigned long long*)(YP + ((size_t)row * 4 + k) * D + c0);
                y[0] += bf2f((bf16_t)(w & 0xffff)); y[1] += bf2f((bf16_t)((w >> 16) & 0xffff)); y[2] += bf2f((bf16_t)((w >> 32) & 0xffff)); y[3] += bf2f((bf16_t)(w >> 48)); }
            const f32x4 g2 = *(const f32x4*)(mod + b * 12288 + 5 * 2048 + c0);
            v[j] = DN_ALPHA * v[j] + (1.f + g2) * y;
            s += (v[j][0] + v[j][1]) + (v[j][2] + v[j][3]); }
        const float mean = wave_sum(s) * (1.f / D); float s2 = 0.f;
#pragma unroll
        for (int j = 0; j < 8; ++j) { v[j] = v[j] - mean; s2 += (v[j][0] * v[j][0] + v[j][1] * v[j][1]) + (v[j][2] * v[j][2] + v[j][3] * v[j][3]); }
        const float rstd = 1.f / sqrtf(wave_sum(s2) * (1.f / D) + LN_EPS);
        const float pscale = 1.f;
#pragma unroll
        for (int j = 0; j < 8; ++j) { const int c0 = 256 * j + lane * 4;
            *(f32x4*)(p.out + (size_t)row * D + c0) = pscale * (v[j] * rstd * *(const f32x4*)(p.ln2_g + c0) + *(const f32x4*)(p.ln2_b + c0)); }
    }
}


typedef short bf16x8 __attribute__((ext_vector_type(8)));
typedef short s16x4 __attribute__((ext_vector_type(4)));
typedef unsigned u32x4 __attribute__((ext_vector_type(4)));
typedef unsigned u32x2 __attribute__((ext_vector_type(2)));
typedef LAS unsigned char* ldsp_t;
__device__ __forceinline__ unsigned cvt_pk_bf16(float lo, float hi) { unsigned r; asm volatile("v_cvt_pk_bf16_f32 %0, %1, %2" : "=v"(r) : "v"(lo), "v"(hi)); return r; }
constexpr int GT_A_BYTES = 256 * 128, GT_B_BYTES = 64 * 256;
constexpr int GT_A0 = 0, GT_A1 = GT_A_BYTES, GT_B0 = 2 * GT_A_BYTES, GT_B1 = 2 * GT_A_BYTES + GT_B_BYTES, GT_LDS = 2 * GT_A_BYTES + 2 * GT_B_BYTES;

struct TileSrc {
    const bf16_t* arow[4];
    const float* bcol;
    int SA;
    int ldb;
    int nkt;
    bool bvalid;
};

__device__ __forceinline__ void gemm_tile(ldsp_t lds, const TileSrc& s, f32x4 (&acc)[4][4]) {
    const int tid = threadIdx.x, lane = tid & 63, wave = __builtin_amdgcn_readfirstlane(tid >> 6);
    const int wm0 = (wave >> 1) * 64, wn = wave & 1;
    const int rA = tid >> 3, chA = tid & 7;
    const unsigned wA = (unsigned)(rA * 128 + ((chA ^ (rA & 7)) << 4));
    const int kB = tid >> 5, cB = (tid & 31) * 4;
    const int sB = (kB & 3) | (((kB >> 3) & 1) << 2);
    const unsigned wB = (unsigned)(kB * 256 + (((cB >> 4) ^ sB) << 5) + (cB & 15) * 2);
    const int r = lane & 15, g = lane >> 4;
    const unsigned aR0 = (unsigned)((wm0 + r) * 128 + (((g) ^ (r & 7)) << 4));
    const unsigned aR1 = (unsigned)((wm0 + r) * 128 + (((4 + g) ^ (r & 7)) << 4));
    const int q = r >> 2, pp = r & 3, sR = q | ((g & 1) << 2);
    unsigned bR[4];
#pragma unroll
    for (int ni = 0; ni < 4; ++ni) bR[ni] = (unsigned)((8 * g + q) * 256 + (((wn * 4 + ni) ^ sR) << 5) + 8 * pp);
#pragma unroll
    for (int mi = 0; mi < 4; ++mi)
#pragma unroll
        for (int ni = 0; ni < 4; ++ni) acc[mi][ni] = (f32x4){0.f, 0.f, 0.f, 0.f};
    u32x4 ra[4]; f32x4 rb[4];
    const f32x4 zero4 = {0.f, 0.f, 0.f, 0.f};
#define GT_ISSUE(t) do { const int _k0 = (t) * 64; const int _ao = (_k0 >> 7) * s.SA + (_k0 & 127); \
        _Pragma("unroll") for (int i = 0; i < 4; ++i) ra[i] = *(const u32x4*)(s.arow[i] + _ao); \
        _Pragma("unroll") for (int i = 0; i < 4; ++i) rb[i] = s.bvalid ? *(const f32x4*)(s.bcol + (size_t)(_k0 + kB + 16 * i) * s.ldb) : zero4; } while (0)
#define GT_WRITE(aoff, boff) do { \
        _Pragma("unroll") for (int i = 0; i < 4; ++i) *(LAS u32x4*)(lds + (aoff) + wA + i * 8192) = ra[i]; \
        _Pragma("unroll") for (int i = 0; i < 4; ++i) { u32x2 w; w.x = cvt_pk_bf16(rb[i][0], rb[i][1]); w.y = cvt_pk_bf16(rb[i][2], rb[i][3]); *(LAS u32x2*)(lds + (boff) + wB + i * 4096) = w; } } while (0)
#define GT_COMPUTE(aoff, boff) do { \
        _Pragma("unroll") for (int ks = 0; ks < 2; ++ks) { \
            bf16x8 af[4], bfr[4]; \
            _Pragma("unroll") for (int mi = 0; mi < 4; ++mi) af[mi] = *(const LAS bf16x8*)(lds + (aoff) + (ks ? aR1 : aR0) + mi * 2048); \
            _Pragma("unroll") for (int ni = 0; ni < 4; ++ni) { \
                const s16x4 lo = __builtin_bit_cast(s16x4, __builtin_amdgcn_ds_read_tr16_b64_v4i16((LAS s16x4*)(lds + (boff) + bR[ni] + ks * 8192))); \
                const s16x4 hi = __builtin_bit_cast(s16x4, __builtin_amdgcn_ds_read_tr16_b64_v4i16((LAS s16x4*)(lds + (boff) + bR[ni] + ks * 8192 + 1024))); \
                bfr[ni] = __builtin_shufflevector(lo, hi, 0, 1, 2, 3, 4, 5, 6, 7); } \
            _Pragma("unroll") for (int mi = 0; mi < 4; ++mi) \
                _Pragma("unroll") for (int ni = 0; ni < 4; ++ni) acc[mi][ni] = __builtin_amdgcn_mfma_f32_16x16x32_bf16(bfr[ni], af[mi], acc[mi][ni], 0, 0, 0); } } while (0)
    __syncthreads();
    GT_ISSUE(0); GT_WRITE(GT_A0, GT_B0);
    if (s.nkt > 1) GT_ISSUE(1);
    for (int t = 0; t < s.nkt; t += 2) {
        __syncthreads();
        if (t + 1 < s.nkt) GT_WRITE(GT_A1, GT_B1);
        if (t + 2 < s.nkt) GT_ISSUE(t + 2);
        GT_COMPUTE(GT_A0, GT_B0);
        if (t + 1 < s.nkt) {
            __syncthreads();
            if (t + 2 < s.nkt) GT_WRITE(GT_A0, GT_B0);
            if (t + 3 < s.nkt) GT_ISSUE(t + 3);
            GT_COMPUTE(GT_A1, GT_B1);
        }
    }
#undef GT_ISSUE
#undef GT_WRITE
#undef GT_COMPUTE
}

constexpr int G2_A = 0  , G2_B0 = 49152, G2_B1 = 65536, G2_LDS = 81920;
__device__ __forceinline__ int f4(int x) { return (0x1320 >> (4 * x)) & 3; }
struct TileSrc2 {
    const bf16_t* arow[2];
    const float* bcol;
    int SA, ldb, nkt; bool bvalid;
};
__device__ __forceinline__ void glds16_asm(const void* gsrc, unsigned lds_dst) {
    unsigned keep;
    asm volatile("s_mov_b32 %0, m0\n\ts_mov_b32 m0, %2\n\ts_nop 0\n\tglobal_load_lds_dwordx4 %1, off\n\ts_mov_b32 m0, %0" : "=&s"(keep) : "v"(gsrc), "s"(lds_dst) : "memory");
}
__device__ __forceinline__ void gemm_tile2(ldsp_t lds, const TileSrc2& s, f32x4 (&acc)[8][4], const int nmi) {
    int tid = threadIdx.x; asm volatile("" : "+v"(tid));
    const int lane = tid & 63, wave = __builtin_amdgcn_readfirstlane(tid >> 6);
    const int wm0 = (wave >> 2) * 128, wn = wave & 3;
    const int kB = 2 * (tid >> 6) + ((tid >> 5) & 1), cB = (tid & 31) * 8;
    const int r = lane & 15, g = lane >> 4;
    const unsigned aR = (unsigned)((wm0 + r) * 64 + ((g ^ f4((r >> 2) & 3)) << 4));
    const int q = r >> 2, pp = r & 3, sR = q | ((g & 1) << 2);
    const unsigned bR0 = (unsigned)((8 * g + q) * 512 + (((wn * 4) ^ sR) << 5) + 8 * pp);
    const unsigned wB0 = (unsigned)(kB * 512 + (((cB >> 4) ^ ((kB & 3) | (((kB >> 3) & 1) << 2))) << 5) + (cB & 15) * 2);
#pragma unroll
    for (int mi = 0; mi < 8; ++mi)
#pragma unroll
        for (int ni = 0; ni < 4; ++ni) acc[mi][ni] = (f32x4){0.f, 0.f, 0.f, 0.f};
    f32x4 rb[4]; u32x4 wv[2];
    const f32x4 zero4 = {0.f, 0.f, 0.f, 0.f};
    const unsigned ldsbase = (unsigned)(unsigned long long)lds;
    const unsigned dmaw = ldsbase + G2_A + (unsigned)wave * 1024u;
#define G2_DMA_A(t, stage) do { const int _k0 = (t) * 32; const int _ao = (_k0 >> 7) * s.SA + (_k0 & 127); \
        _Pragma("unroll") for (int i = 0; i < 2; ++i) glds16_asm(s.arow[i] + _ao, dmaw + (unsigned)(stage) * 16384u + i * 8192u); } while (0)
#define G2_ISSUE_B(t) do { const int _k0 = (t) * 32; \
        _Pragma("unroll") for (int i = 0; i < 2; ++i) { const float* _p = s.bcol + (size_t)(_k0 + kB + 16 * i) * s.ldb; \
            asm volatile("global_load_dwordx4 %0, %1, off" : "=v"(rb[2 * i]) : "v"(_p) : "memory"); \
            asm volatile("global_load_dwordx4 %0, %1, off offset:16" : "=v"(rb[2 * i + 1]) : "v"(_p) : "memory"); } } while (0)
#define G2_WAIT_B(N) asm volatile("s_waitcnt vmcnt(" #N ")" : "+v"(rb[0]), "+v"(rb[1]), "+v"(rb[2]), "+v"(rb[3]) :: "memory")
#define G2_WRITE_B(boff, tt) do { \
        _Pragma("unroll") for (int i = 0; i < 2; ++i) { wv[i].x = cvt_pk_bf16(rb[2 * i][0], rb[2 * i][1]); wv[i].y = cvt_pk_bf16(rb[2 * i][2], rb[2 * i][3]); \
            wv[i].z = cvt_pk_bf16(rb[2 * i + 1][0], rb[2 * i + 1][1]); wv[i].w = cvt_pk_bf16(rb[2 * i + 1][2], rb[2 * i + 1][3]); \
            *(LAS u32x4*)(lds + (boff) + wB0 + i * 8192) = wv[i]; } } while (0)
    const int nkt = s.nkt;
    const int grp = wave >> 2;
    __syncthreads();
    G2_ISSUE_B(0); G2_DMA_A(0, 0); G2_DMA_A(1, 1);
    G2_WAIT_B(4);
    G2_WRITE_B(G2_B0, 0); G2_ISSUE_B(1);
    asm volatile("s_waitcnt vmcnt(6) lgkmcnt(0)" ::: "memory");
    __syncthreads();
    if (grp) { __builtin_amdgcn_s_barrier(); asm volatile("" ::: "memory"); }
    int st = 0, st2 = 2;
    for (int t = 0; t < nkt; ++t) {
        const int bcur = (t & 1) ? G2_B1 : G2_B0, bnxt = (t & 1) ? G2_B0 : G2_B1;
        bf16x8 bfr[4], af[8];
#pragma unroll
        for (int ni = 0; ni < 4; ++ni) {
            const s16x4 lo = __builtin_bit_cast(s16x4, __builtin_amdgcn_ds_read_tr16_b64_v4i16((LAS s16x4*)(lds + bcur + (bR0 ^ (ni << 5)))));
            const s16x4 hi = __builtin_bit_cast(s16x4, __builtin_amdgcn_ds_read_tr16_b64_v4i16((LAS s16x4*)(lds + bcur + (bR0 ^ (ni << 5)) + 2048)));
            bfr[ni] = __builtin_shufflevector(lo, hi, 0, 1, 2, 3, 4, 5, 6, 7); }
#pragma unroll
        for (int mi = 0; mi < 8; ++mi) af[mi] = *(const LAS bf16x8*)(lds + G2_A + st * 16384 + aR + mi * 1024);
        __builtin_amdgcn_sched_barrier(0);
        if (t + 2 < nkt) { G2_DMA_A(t + 2, st2); G2_WAIT_B(2); } else { G2_WAIT_B(0); }
        if (t + 1 < nkt) G2_WRITE_B(bnxt, t + 1);
        if (t + 2 < nkt) G2_ISSUE_B(t + 2);
        asm volatile("s_waitcnt lgkmcnt(0)" ::: "memory");
        __builtin_amdgcn_s_barrier(); asm volatile("" ::: "memory");
        __builtin_amdgcn_s_setprio(1);
        if (nmi > 0) {
#pragma unroll
            for (int mi = 0; mi < 8; ++mi) {
#pragma unroll
                for (int ni = 0; ni < 4; ++ni) acc[mi][ni] = __builtin_amdgcn_mfma_f32_16x16x32_bf16(bfr[ni], af[mi], acc[mi][ni], 0, 0, 0); }
        }
        __builtin_amdgcn_s_setprio(0);
        asm volatile("" ::: "memory"); __builtin_amdgcn_s_barrier(); asm volatile("" ::: "memory");
        st = (st == 2) ? 0 : st + 1; st2 = (st2 == 2) ? 0 : st2 + 1;
    }
    if (!grp) { __builtin_amdgcn_s_barrier(); asm volatile("" ::: "memory"); }
#undef G2_DMA_A
#undef G2_ISSUE_B
#undef G2_WRITE_B
#undef G2_WAIT_B
#undef G2_COMPUTE
}

struct TileSrc2b { const bf16_t* arow[2]; const bf16_t* brow[2]; int SA, ldb, nkt; };
constexpr int G3_A = 0  , G3_B = 49152  ;
__device__ __forceinline__ void gemm_tile2b(ldsp_t lds, const TileSrc2b& s, f32x4 (&acc)[8][4], const int nmi = 8) {
    int tid = threadIdx.x; asm volatile("" : "+v"(tid));
    const int lane = tid & 63, wave = __builtin_amdgcn_readfirstlane(tid >> 6);
    const int wm0 = (wave >> 2) * 128, wn = wave & 3;
    const int r = lane & 15, g = lane >> 4;
    const unsigned aR = (unsigned)((wm0 + r) * 64 + ((g ^ f4((r >> 2) & 3)) << 4));
    const int q = r >> 2, pp = r & 3, sR = q | ((g & 1) << 2);
    const unsigned bR0 = (unsigned)((8 * g + q) * 512 + (((wn * 4) ^ sR) << 5) + 8 * pp);
#pragma unroll
    for (int mi = 0; mi < 8; ++mi)
#pragma unroll
        for (int ni = 0; ni < 4; ++ni) acc[mi][ni] = (f32x4){0.f, 0.f, 0.f, 0.f};
    const unsigned ldsbase = (unsigned)(unsigned long long)lds;
    const unsigned dmaw = ldsbase + (unsigned)wave * 1024u;
#define G3_DMA(t, stage) do { const int _k0 = (t) * 32; const int _ao = (_k0 >> 7) * s.SA + (_k0 & 127); \
        _Pragma("unroll") for (int i = 0; i < 2; ++i) glds16_asm(s.arow[i] + _ao, dmaw + G3_A + (unsigned)(stage) * 16384u + i * 8192u); \
        _Pragma("unroll") for (int i = 0; i < 2; ++i) glds16_asm(s.brow[i] + (size_t)_k0 * s.ldb, dmaw + G3_B + (unsigned)(stage) * 16384u + i * 8192u); } while (0)
    const int nkt = s.nkt;
    const int grp = wave >> 2;
    __syncthreads();
    G3_DMA(0, 0); G3_DMA(1, 1);
    asm volatile("s_waitcnt vmcnt(4)" ::: "memory");
    __syncthreads();
    if (grp) { __builtin_amdgcn_s_barrier(); asm volatile("" ::: "memory"); }
    int st = 0, st2 = 2;
    for (int t = 0; t < nkt; ++t) {
        if (t + 2 < nkt) G3_DMA(t + 2, st2);
        bf16x8 bfr[4], af[8];
#pragma unroll
        for (int ni = 0; ni < 4; ++ni) {
            const s16x4 lo = __builtin_bit_cast(s16x4, __builtin_amdgcn_ds_read_tr16_b64_v4i16((LAS s16x4*)(lds + G3_B + st * 16384 + (bR0 ^ (ni << 5)))));
            const s16x4 hi = __builtin_bit_cast(s16x4, __builtin_amdgcn_ds_read_tr16_b64_v4i16((LAS s16x4*)(lds + G3_B + st * 16384 + (bR0 ^ (ni << 5)) + 2048)));
            bfr[ni] = __builtin_shufflevector(lo, hi, 0, 1, 2, 3, 4, 5, 6, 7); }
#pragma unroll
        for (int mi = 0; mi < 8; ++mi) af[mi] = *(const LAS bf16x8*)(lds + G3_A + st * 16384 + aR + mi * 1024);
        if (t + 2 < nkt) asm volatile("s_waitcnt vmcnt(4) lgkmcnt(0)" ::: "memory"); else asm volatile("s_waitcnt vmcnt(0) lgkmcnt(0)" ::: "memory");
        __builtin_amdgcn_s_barrier(); asm volatile("" ::: "memory");
        __builtin_amdgcn_s_setprio(1);
#pragma unroll
        for (int mi = 0; mi < 8; ++mi) {
#pragma unroll
            for (int ni = 0; ni < 4; ++ni) acc[mi][ni] = __builtin_amdgcn_mfma_f32_16x16x32_bf16(bfr[ni], af[mi], acc[mi][ni], 0, 0, 0); }
        __builtin_amdgcn_s_setprio(0);
        asm volatile("" ::: "memory"); __builtin_amdgcn_s_barrier(); asm volatile("" ::: "memory");
        st = (st == 2) ? 0 : st + 1; st2 = (st2 == 2) ? 0 : st2 + 1;
    }
    if (!grp) { __builtin_amdgcn_s_barrier(); asm volatile("" ::: "memory"); }
#undef G3_DMA
}
__device__ __forceinline__ void b_src_setup(TileSrc2b& s, const bf16_t* Bbase, int ldb, int n0, int ncols, int tid) {
    const int lane = tid & 63, wave = tid >> 6;
#pragma unroll
    for (int j = 0; j < 2; ++j) {
        const int k = 2 * (8 * j + wave) + (lane >> 5), slot = lane & 31;
        const int piece = (((slot >> 1) ^ ((k & 3) | (((k >> 3) & 1) << 2))) << 1) | (slot & 1);
        int col = n0 + piece * 8; if (col > ncols - 8) col = ncols - 8;
        s.brow[j] = Bbase + (size_t)k * ldb + col;
    }
}

__device__ __forceinline__ int vcu_of_block() { const int G = gridDim.x, bx = blockIdx.x; return (G % 8 == 0) ? (bx % 8) * (G / 8) + bx / 8 : bx; }


__device__ __forceinline__ void moe_offsets256(const Params& p, LAS int* li) {
    const unsigned* ctl = (const unsigned*)(p.ws + WS_CTL);
    __syncthreads();
    if (threadIdx.x < 32) li[threadIdx.x] = (int)__hip_atomic_load(ctl + CW_CNT + 64 * threadIdx.x, __ATOMIC_RELAXED, __HIP_MEMORY_SCOPE_AGENT);
    __syncthreads();
    if (threadIdx.x == 0) { int o = 0, tt = 0; for (int e = 0; e < 32; ++e) { li[32 + e] = o; li[72 + e] = tt; o += li[e]; tt += (li[e] + 255) / 256; } li[64] = o; li[104] = tt; }
    __syncthreads();
}


constexpr int NA_KV = 32768;
constexpr int NA_PBH = 65536;
constexpr int NA_SELM = NA_PBH + 32768;
constexpr float NA_C = 0.08838834764831845f * 1.4426950408889634f;

struct NaTile { const bf16_t* k; const bf16_t* v; };
#define NA_ISSUE(tile, rs) do { _Pragma("unroll") for (int i = 0; i < 2; ++i) { const size_t _o = (size_t)((tid >> 4) + 32 * i) * (rs) + (tid & 15) * 8; \
        rk[i] = *(const u32x4*)((tile).k + _o); rv[i] = *(const u32x4*)((tile).v + _o); } } while (0)
#define NA_WRITE(buf) do { _Pragma("unroll") for (int i = 0; i < 2; ++i) { const int _key = (tid >> 4) + 32 * i, _ch = tid & 15; \
        *(LAS u32x4*)(lds + (buf) * NA_KV + _key * 256 + ((_ch ^ (_key & 15)) << 4)) = rk[i]; \
        *(LAS u32x4*)(lds + (buf) * NA_KV + 16384 + _key * 256 + (((_ch >> 1) ^ (_key & 7)) << 5) + (_ch & 1) * 16) = rv[i]; } } while (0)

__device__ __forceinline__ void na_tile(ldsp_t img, const bf16x8 (&qf)[4], const unsigned (&kR)[4], unsigned vB, int sv, int g,
                                        float& m, float& l, f32x4 (&o)[8], bool need_mask, int key0, int lo, int hi, f32x4 (&p)[4], float& alpha_out) {
    f32x4 sc[4];
#pragma unroll
    for (int kt = 0; kt < 4; ++kt) { sc[kt] = (f32x4){0.f, 0.f, 0.f, 0.f};
#pragma unroll
        for (int ks = 0; ks < 4; ++ks) { const bf16x8 kf = *(const LAS bf16x8*)(img + kt * 4096 + kR[ks]); sc[kt] = __builtin_amdgcn_mfma_f32_16x16x32_bf16(kf, qf[ks], sc[kt], 0, 0, 0); } }
    float mx = -INFINITY;
#pragma unroll
    for (int kt = 0; kt < 4; ++kt)
#pragma unroll
        for (int i = 0; i < 4; ++i) { float v = sc[kt][i] * NA_C; if (need_mask) { const int key = key0 + 16 * kt + 4 * g + i; v = (key >= lo && key <= hi) ? v : -INFINITY; } sc[kt][i] = v; mx = fmaxf(mx, v); }
    mx = fmaxf(mx, __shfl_xor(mx, 16)); mx = fmaxf(mx, __shfl_xor(mx, 32));
    const float mn = fmaxf(m, mx), mu = (mn == -INFINITY) ? 0.f : mn;
    const float alpha = __builtin_amdgcn_exp2f(m - mu);
    float ls = 0.f;
#pragma unroll
    for (int kt = 0; kt < 4; ++kt)
#pragma unroll
        for (int i = 0; i < 4; ++i) { const float e = __builtin_amdgcn_exp2f(sc[kt][i] - mu); p[kt][i] = e; ls += e; }
    l = l * alpha + ls; m = mn; alpha_out = alpha;
    if (!__all(alpha == 1.f)) {
#pragma unroll
        for (int dt = 0; dt < 8; ++dt) o[dt] = o[dt] * alpha;
    }
    bf16x8 pf[2];
#pragma unroll
    for (int kk = 0; kk < 2; ++kk) { u32x4 w; w.x = cvt_pk_bf16(p[2 * kk][0], p[2 * kk][1]); w.y = cvt_pk_bf16(p[2 * kk][2], p[2 * kk][3]);
        w.z = cvt_pk_bf16(p[2 * kk + 1][0], p[2 * kk + 1][1]); w.w = cvt_pk_bf16(p[2 * kk + 1][2], p[2 * kk + 1][3]); pf[kk] = __builtin_bit_cast(bf16x8, w); }
#pragma unroll
    for (int dt = 0; dt < 8; ++dt) {
        const unsigned va = 16384u + vB + (unsigned)((dt ^ sv) << 5);
#pragma unroll
        for (int kk = 0; kk < 2; ++kk) {
            const s16x4 lo4 = __builtin_bit_cast(s16x4, __builtin_amdgcn_ds_read_tr16_b64_v4i16((LAS s16x4*)(img + va + kk * 8192)));
            const s16x4 hi4 = __builtin_bit_cast(s16x4, __builtin_amdgcn_ds_read_tr16_b64_v4i16((LAS s16x4*)(img + va + kk * 8192 + 4096)));
            const bf16x8 vf = __builtin_shufflevector(lo4, hi4, 0, 1, 2, 3, 4, 5, 6, 7);
            o[dt] = __builtin_amdgcn_mfma_f32_16x16x32_bf16(vf, pf[kk], o[dt], 0, 0, 0);
        }
    }
}

__device__ __forceinline__ void nsa_unit(const Params& p, ldsp_t lds, int u) {
    const bf16_t* PROJ = (const bf16_t*)(p.ws + WS_PROJ);
    const bf16_t* KC = (const bf16_t*)(p.ws + WS_KC);
    const bf16_t* VC = (const bf16_t*)(p.ws + WS_VC);
    bf16_t* MIXIN = (bf16_t*)(p.ws + WS_MIXIN);
    const int tid = threadIdx.x, lane = tid & 63, wave = __builtin_amdgcn_readfirstlane(tid >> 6);
    const int tb = 127 - (u >> 2), b = (u >> 1) & 1, grp = u & 1;
    const int t0 = 32 * tb, cur = t0 >> 6;
    const int hh = wave >> 1, th = wave & 1, qi = lane & 15, g = lane >> 4;
    const int tq = t0 + 16 * th + qi;
    const size_t rowq = (size_t)b * T + tq;
    const int head = grp * 4 + hh;
    bf16x8 qf[4];
#pragma unroll
    for (int ks = 0; ks < 4; ++ks) qf[ks] = *(const bf16x8*)(PROJ + rowq * DIN + C_NQ + head * 128 + 32 * ks + 8 * g);
    const float g0 = sigmoid_f(bf2f(PROJ[rowq * DIN + C_NGT + head * 3 + 0])), g1 = sigmoid_f(bf2f(PROJ[rowq * DIN + C_NGT + head * 3 + 1])), g2 = sigmoid_f(bf2f(PROJ[rowq * DIN + C_NGT + head * 3 + 2]));
    unsigned kR[4];
#pragma unroll
    for (int ks = 0; ks < 4; ++ks) kR[ks] = (unsigned)(qi * 256 + (((4 * ks + g) ^ qi) << 4));
    const int qq = qi >> 2, pp = qi & 3;
    const unsigned vB = (unsigned)((4 * g + qq) * 256 + 8 * pp);
    const int sv = ((4 * g + qq) & 7);
    u32x4 rk[2], rv[2];
    f32x4 o[8], outacc[8], pt[4];
    float m, l, alpha;
    const int nvis_q = tq >= 31 ? (tq - 31) / 16 + 1 : 0;
    const int nvis_max = t0 / 16 + 1;
    const int ntl = (min(nvis_max, NCMP) + 63) >> 6;
    float pb[17];
#pragma unroll
    for (int i = 0; i < 17; ++i) pb[i] = 0.f;
#pragma unroll
    for (int dt = 0; dt < 8; ++dt) o[dt] = (f32x4){0.f, 0.f, 0.f, 0.f};
    m = -INFINITY; l = 0.f;
    const bf16_t* kc0 = KC + ((size_t)b * 256 * 2 + grp) * 128; const bf16_t* vc0 = VC + ((size_t)b * 256 * 2 + grp) * 128;
    __syncthreads();
    { NaTile t0_{kc0, vc0}; NA_ISSUE(t0_, 256); NA_WRITE(0); if (ntl > 1) { NaTile t1_{kc0 + 64 * 256, vc0 + 64 * 256}; NA_ISSUE(t1_, 256); } }
#pragma unroll
    for (int tl = 0; tl < 4; ++tl) {
        if (tl < ntl) {
            __syncthreads();
            if (tl + 1 < ntl) NA_WRITE((tl + 1) & 1);
            if (tl + 2 < ntl) { NaTile t2_{kc0 + (size_t)(tl + 2) * 64 * 256, vc0 + (size_t)(tl + 2) * 64 * 256}; NA_ISSUE(t2_, 256); }
            na_tile(lds + (tl & 1) * NA_KV, qf, kR, vB, sv, g, m, l, o, true, 64 * tl, 0, nvis_q - 1, pt, alpha);
#pragma unroll
            for (int i = 0; i < 17; ++i) pb[i] *= alpha;
#pragma unroll
            for (int kt = 0; kt < 4; ++kt) {
                const float s4 = (pt[kt][0] + pt[kt][1]) + (pt[kt][2] + pt[kt][3]);
                const float recv = __shfl(pt[kt][3], (lane + 48) & 63);
                pb[tl * 4 + kt] += s4 + (g >= 1 ? recv : 0.f);
                pb[tl * 4 + kt + 1] += (g == 0 ? recv : 0.f);
            }
        }
    }
    {
        float lr = l; lr += __shfl_xor(lr, 16); lr += __shfl_xor(lr, 32);
        const float inv = lr > 0.f ? 1.f / lr : 0.f;
#pragma unroll
        for (int dt = 0; dt < 8; ++dt) outacc[dt] = o[dt] * (inv * g0);
        LAS float* pbh = (LAS float*)(lds + NA_PBH) + (hh * 32 + 16 * th + qi) * 64;
#pragma unroll
        for (int i = 0; i < 16; ++i) pbh[4 * i + g] = pb[i] * inv;
    }
    __syncthreads();
    {
        const LAS float* pball = (const LAS float*)(lds + NA_PBH);
        LAS unsigned long long* selm = (LAS unsigned long long*)(lds + NA_SELM);
#pragma unroll 1
        for (int tt = 0; tt < 4; ++tt) {
            const int tok = 4 * wave + tt;
            const float v = (pball[(0 * 32 + tok) * 64 + lane] + pball[(1 * 32 + tok) * 64 + lane]) + (pball[(2 * 32 + tok) * 64 + lane] + pball[(3 * 32 + tok) * 64 + lane]);
            const bool forced = (lane == 0) || (lane == cur) || (lane == cur - 1);
            const float score = forced ? INFINITY : (lane <= cur ? v : -INFINITY);
            int rank = 0;
            for (int i = 0; i < 64; ++i) { const float w = __shfl(score, i); rank += (w > score || (w == score && i < lane)) ? 1 : 0; }
            const unsigned long long mk = __ballot(rank < 16);
            if (lane == 0) selm[tok] = mk;
        }
    }
    __syncthreads();
    const unsigned long long mysel = ((const LAS unsigned long long*)(lds + NA_SELM))[16 * th + qi];
    {
#pragma unroll
        for (int dt = 0; dt < 8; ++dt) o[dt] = (f32x4){0.f, 0.f, 0.f, 0.f};
        m = -INFINITY; l = 0.f;
        const bf16_t* kb = PROJ + (size_t)b * T * DIN + C_KSL + grp * 128; const bf16_t* vb = PROJ + (size_t)b * T * DIN + C_VSL + grp * 128;
        const int n = cur + 1;
        { NaTile a{kb, vb}; NA_ISSUE(a, DIN); NA_WRITE(0); if (n > 1) { NaTile c{kb + (size_t)64 * DIN, vb + (size_t)64 * DIN}; NA_ISSUE(c, DIN); } }
        for (int j = 0; j < n; ++j) {
            __syncthreads();
            if (j + 1 < n) NA_WRITE((j + 1) & 1);
            if (j + 2 < n) { NaTile c{kb + (size_t)(j + 2) * 64 * DIN, vb + (size_t)(j + 2) * 64 * DIN}; NA_ISSUE(c, DIN); }
            const bool sel = (mysel >> j) & 1ull;
            na_tile(lds + (j & 1) * NA_KV, qf, kR, vB, sv, g, m, l, o, true, 64 * j, 0, sel ? tq : -1, pt, alpha);
        }
        float lr = l; lr += __shfl_xor(lr, 16); lr += __shfl_xor(lr, 32);
        const float inv = g1 / lr;
#pragma unroll
        for (int dt = 0; dt < 8; ++dt) outacc[dt] += o[dt] * inv;
    }
    {
#pragma unroll
        for (int dt = 0; dt < 8; ++dt) o[dt] = (f32x4){0.f, 0.f, 0.f, 0.f};
        m = -INFINITY; l = 0.f;
        const bf16_t* kb = PROJ + (size_t)b * T * DIN + C_KWN + grp * 128; const bf16_t* vb = PROJ + (size_t)b * T * DIN + C_VWN + grp * 128;
        const int kb_lo = max(0, t0 - 511) >> 6, n = cur - kb_lo + 1;
        __syncthreads();
        { NaTile a{kb + (size_t)kb_lo * 64 * DIN, vb + (size_t)kb_lo * 64 * DIN}; NA_ISSUE(a, DIN); NA_WRITE(0);
          if (n > 1) { NaTile c{kb + (size_t)(kb_lo + 1) * 64 * DIN, vb + (size_t)(kb_lo + 1) * 64 * DIN}; NA_ISSUE(c, DIN); } }
        for (int j = 0; j < n; ++j) {
            __syncthreads();
            if (j + 1 < n) NA_WRITE((j + 1) & 1);
            if (j + 2 < n) { NaTile c{kb + (size_t)(kb_lo + j + 2) * 64 * DIN, vb + (size_t)(kb_lo + j + 2) * 64 * DIN}; NA_ISSUE(c, DIN); }
            const int key0 = 64 * (kb_lo + j);
            const bool need = (key0 + 63 > t0) || (key0 < t0 + 31 - 511);
            na_tile(lds + (j & 1) * NA_KV, qf, kR, vB, sv, g, m, l, o, need, key0, tq - 511, tq, pt, alpha);
        }
        float lr = l; lr += __shfl_xor(lr, 16); lr += __shfl_xor(lr, 32);
        const float inv = g2 / lr;
#pragma unroll
        for (int dt = 0; dt < 8; ++dt) outacc[dt] += o[dt] * inv;
    }
#pragma unroll
    for (int dt = 0; dt < 8; ++dt) { u32x2 w; w.x = cvt_pk_bf16(outacc[dt][0], outacc[dt][1]); w.y = cvt_pk_bf16(outacc[dt][2], outacc[dt][3]);
        *(u32x2*)(MIXIN + rowq * D + 1024 + head * 128 + 16 * dt + 4 * g) = w; }
}


__device__ __forceinline__ int sfun(int row) { return (row & 3) | (((row >> 3) & 1) << 2); }
__device__ __forceinline__ bf16x8 tr_frag(ldsp_t a, int rs4) {
    const s16x4 lo = __builtin_bit_cast(s16x4, __builtin_amdgcn_ds_read_tr16_b64_v4i16((LAS s16x4*)a));
    const s16x4 hi = __builtin_bit_cast(s16x4, __builtin_amdgcn_ds_read_tr16_b64_v4i16((LAS s16x4*)(a + rs4)));
    return __builtin_shufflevector(lo, hi, 0, 1, 2, 3, 4, 5, 6, 7);
}
__device__ __forceinline__ void gla_stage_v(ldsp_t vimg, const bf16_t* PROJ, size_t row0, int col0) {
    const int tid = threadIdx.x;
#pragma unroll
    for (int i = 0; i < 4; ++i) { const int idx = tid + 512 * i, sr = idx >> 5, ch = idx & 31;
        const u32x4 w = *(const u32x4*)(PROJ + (row0 + sr) * DIN + col0 + ch * 8);
        *(LAS u32x4*)(vimg + sr * 512 + (((ch >> 1) ^ sfun(sr)) << 5) + (ch & 1) * 16) = w; }
}

__device__ __forceinline__ void gla_a_unit(const Params& p, ldsp_t lds, int u) {
    const bf16_t* PROJ = (const bf16_t*)(p.ws + WS_PROJ);
    float* BC = (float*)(p.ws + WS_BC); float* U = (float*)(p.ws + WS_U); float* DTOT = (float*)(p.ws + WS_DTOT);
    const int tid = threadIdx.x, lane = tid & 63, wave = __builtin_amdgcn_readfirstlane(tid >> 6);
    const int b = u >> 6, h = (u >> 4) & 3, sc = u & 15;
    const size_t row0 = (size_t)b * T + sc * 256;
    LAS float* glr = (LAS float*)lds;
    LAS float* tot = (LAS float*)(lds + 16384);
    ldsp_t kimg = lds + 20480;
    ldsp_t vimg = lds + 86016;
    __syncthreads();
#pragma unroll
    for (int i = 0; i < 8; ++i) { const int idx = tid + 512 * i; glr[idx] = bf2f(PROJ[(row0 + (idx >> 4)) * DIN + C_GLR + (idx & 15)]); }
    __syncthreads();
    const int d = tid & 127, c = tid >> 7, hd = h * 128 + d;
    float w[16];
#pragma unroll
    for (int r = 0; r < 16; ++r) w[r] = p.w_gk[r * 512 + hd];
    const float bias = p.b_gk[hd];
    float cum = 0.f;
    for (int sl = 0; sl < 64; ++sl) {
        const int sr = 64 * c + sl; float x = bias;
#pragma unroll
        for (int r4 = 0; r4 < 4; ++r4) { const f32x4 gv = *(const LAS f32x4*)(glr + sr * 16 + r4 * 4); x = fmaf(gv[0], w[4 * r4], x); x = fmaf(gv[1], w[4 * r4 + 1], x); x = fmaf(gv[2], w[4 * r4 + 2], x); x = fmaf(gv[3], w[4 * r4 + 3], x); }
        cum += logsigmoid_f(x) * (1.f / 16.f);
        BC[(row0 + sr) * 512 + hd] = cum;
    }
    tot[c * 128 + d] = cum;
    __syncthreads();
    float suffix = 0.f;
    for (int c2 = c + 1; c2 < 4; ++c2) suffix += tot[c2 * 128 + d];
    if (c == 0) DTOT[(size_t)u * 128 + d] = __expf(cum + suffix);
    for (int sl = 0; sl < 64; ++sl) {
        const int sr = 64 * c + sl;
        const float bcs = BC[(row0 + sr) * 512 + hd];
        const float kv = bf2f(PROJ[(row0 + sr) * DIN + C_GK + hd]) * __expf((cum - bcs) + suffix);
        *(LAS bf16_t*)(kimg + sr * 256 + (((d >> 4) ^ sfun(sr)) << 5) + (d & 15) * 2) = f2bf(kv);
    }
    const int e0 = (wave >> 1) * 64, d0 = (wave & 1) * 64;
    const int g = lane >> 4, qq = (lane & 15) >> 2, pp = lane & 3, sR = qq | ((g & 1) << 2);
    f32x4 acc[4][4];
#pragma unroll
    for (int a = 0; a < 4; ++a)
#pragma unroll
        for (int bb = 0; bb < 4; ++bb) acc[a][bb] = (f32x4){0.f, 0.f, 0.f, 0.f};
    for (int cc = 0; cc < 4; ++cc) {
        __syncthreads();
        gla_stage_v(vimg, PROJ, row0 + 64 * cc, C_GV + h * 256);
        __syncthreads();
#pragma unroll
        for (int ks = 0; ks < 2; ++ks) {
            bf16x8 vf[4], kf[4];
            const int rl = 32 * ks + 8 * g + qq;
#pragma unroll
            for (int et = 0; et < 4; ++et) vf[et] = tr_frag(vimg + rl * 512 + ((((e0 >> 4) + et) ^ sR) << 5) + 8 * pp, 2048);
#pragma unroll
            for (int dt = 0; dt < 4; ++dt) kf[dt] = tr_frag(kimg + (64 * cc + rl) * 256 + ((((d0 >> 4) + dt) ^ sR) << 5) + 8 * pp, 1024);
#pragma unroll
            for (int et = 0; et < 4; ++et)
#pragma unroll
                for (int dt = 0; dt < 4; ++dt) acc[et][dt] = __builtin_amdgcn_mfma_f32_16x16x32_bf16(vf[et], kf[dt], acc[et][dt], 0, 0, 0);
        }
    }
    float* Uu = U + (size_t)u * 128 * 256;
#pragma unroll
    for (int et = 0; et < 4; ++et)
#pragma unroll
        for (int dt = 0; dt < 4; ++dt) *(f32x4*)(Uu + (size_t)(d0 + 16 * dt + (lane & 15)) * 256 + e0 + 16 * et + 4 * g) = acc[et][dt];
}

__device__ __forceinline__ void gla_c_unit(const Params& p, ldsp_t lds, int u) {
    const bf16_t* PROJ = (const bf16_t*)(p.ws + WS_PROJ);
    const float* BC = (const float*)(p.ws + WS_BC); const float* U = (const float*)(p.ws + WS_U); const float* DTOT = (const float*)(p.ws + WS_DTOT);
    bf16_t* MIXIN = (bf16_t*)(p.ws + WS_MIXIN);
    const int tid = threadIdx.x, lane = tid & 63, wave = __builtin_amdgcn_readfirstlane(tid >> 6);
    const int b = u >> 6, h = (u >> 4) & 3, sc = u & 15;
    const size_t row0 = (size_t)b * T + sc * 256;
    ldsp_t simg = lds;
    ldsp_t vimg = lds + 65536;
    ldsp_t qimg = lds + 98304;
    ldsp_t kimg = lds + 114688;
    ldsp_t aimg = lds + 131072;
    LAS float* ssq = (LAS float*)(lds + 139264);
    LAS float* blast = (LAS float*)(lds + 141312);
    const int g = lane >> 4, li = lane & 15, qq = li >> 2, pp = li & 3, sR = qq | ((g & 1) << 2);
    const int e0 = (wave >> 1) * 64, d0 = (wave & 1) * 64;
    f32x4 S[4][4];
#pragma unroll
    for (int a = 0; a < 4; ++a)
#pragma unroll
        for (int bb = 0; bb < 4; ++bb) S[a][bb] = (f32x4){0.f, 0.f, 0.f, 0.f};
    for (int j = 0; j < sc; ++j) {
        const float* Uj = U + (size_t)(u - sc + j) * 128 * 256; const float* Dj = DTOT + (size_t)(u - sc + j) * 128;
#pragma unroll
        for (int dt = 0; dt < 4; ++dt) { const int dd = d0 + 16 * dt + li; const float dj = Dj[dd];
#pragma unroll
            for (int et = 0; et < 4; ++et) S[et][dt] = S[et][dt] * dj + *(const f32x4*)(Uj + (size_t)dd * 256 + e0 + 16 * et + 4 * g); }
    }
    const float scale = 0.08838834764831845f;
    for (int cc = 0; cc < 4; ++cc) {
        const size_t rowc = row0 + 64 * cc;
        __syncthreads();
#pragma unroll
        for (int et = 0; et < 4; ++et)
#pragma unroll
            for (int dt = 0; dt < 4; ++dt) { const int dd = d0 + 16 * dt + li, ee = e0 + 16 * et + 4 * g;
                u32x2 w; w.x = cvt_pk_bf16(S[et][dt][0], S[et][dt][1]); w.y = cvt_pk_bf16(S[et][dt][2], S[et][dt][3]);
                *(LAS u32x2*)(simg + dd * 512 + (((ee >> 4) ^ sfun(dd)) << 5) + (ee & 15) * 2) = w; }
        { const int d = tid & 127, tq4 = tid >> 7, hd = h * 128 + d;
#pragma unroll 4
          for (int i = 0; i < 16; ++i) { const int t = 16 * tq4 + i;
              const float bc = BC[(rowc + t) * 512 + hd];
              const float qv = bf2f(PROJ[(rowc + t) * DIN + C_GQ + hd]) * scale * __expf(bc);
              const float kv = bf2f(PROJ[(rowc + t) * DIN + C_GK + hd]) * __expf(-bc);
              *(LAS bf16_t*)(qimg + t * 256 + (((d >> 3) ^ (t & 15)) << 4) + (d & 7) * 2) = f2bf(qv);
              *(LAS bf16_t*)(kimg + t * 256 + (((d >> 4) ^ sfun(t)) << 5) + (d & 15) * 2) = f2bf(kv);
              if (t == 63) blast[d] = bc; } }
        gla_stage_v(vimg, PROJ, rowc, C_GV + h * 256);
        __syncthreads();
        { const int st = wave & 3, tt0 = (wave >> 2) * 2;
          f32x4 at[2] = {(f32x4){0.f, 0.f, 0.f, 0.f}, (f32x4){0.f, 0.f, 0.f, 0.f}};
#pragma unroll
          for (int ks = 0; ks < 4; ++ks) {
              const int rs_ = 16 * st + li, ch = 4 * ks + g;
              const bf16x8 kf = *(const LAS bf16x8*)(kimg + rs_ * 256 + (((ch >> 1) ^ sfun(rs_)) << 5) + (ch & 1) * 16);
#pragma unroll
              for (int k2 = 0; k2 < 2; ++k2) { const int rt = 16 * (tt0 + k2) + li;
                  const bf16x8 qf = *(const LAS bf16x8*)(qimg + rt * 256 + ((ch ^ (rt & 15)) << 4));
                  at[k2] = __builtin_amdgcn_mfma_f32_16x16x32_bf16(kf, qf, at[k2], 0, 0, 0); } }
#pragma unroll
          for (int k2 = 0; k2 < 2; ++k2) { const int t = 16 * (tt0 + k2) + li, s0 = 16 * st + 4 * g;
              float a[4];
#pragma unroll
              for (int i = 0; i < 4; ++i) a[i] = (s0 + i <= t) ? at[k2][i] : 0.f;
              u32x2 w; w.x = cvt_pk_bf16(a[0], a[1]); w.y = cvt_pk_bf16(a[2], a[3]);
              *(LAS u32x2*)(aimg + t * 128 + (((s0 >> 3) ^ (t & 7)) << 4) + (s0 & 7) * 2) = w; } }
        __syncthreads();
        f32x4 o[2][4];
#pragma unroll
        for (int a = 0; a < 2; ++a)
#pragma unroll
            for (int bb = 0; bb < 4; ++bb) o[a][bb] = (f32x4){0.f, 0.f, 0.f, 0.f};
#pragma unroll
        for (int ks = 0; ks < 4; ++ks) {
            const int rl = 32 * ks + 8 * g + qq, ch = 4 * ks + g;
            bf16x8 sf[2], qf[4];
#pragma unroll
            for (int et = 0; et < 2; ++et) sf[et] = tr_frag(simg + rl * 512 + (((2 * wave + et) ^ sR) << 5) + 8 * pp, 2048);
#pragma unroll
            for (int tt = 0; tt < 4; ++tt) { const int rt = 16 * tt + li; qf[tt] = *(const LAS bf16x8*)(qimg + rt * 256 + ((ch ^ (rt & 15)) << 4)); }
#pragma unroll
            for (int et = 0; et < 2; ++et)
#pragma unroll
                for (int tt = 0; tt < 4; ++tt) o[et][tt] = __builtin_amdgcn_mfma_f32_16x16x32_bf16(sf[et], qf[tt], o[et][tt], 0, 0, 0);
        }
#pragma unroll
        for (int ks = 0; ks < 2; ++ks) {
            const int rl = 32 * ks + 8 * g + qq, ch = 4 * ks + g;
            bf16x8 vf[2], af[4];
#pragma unroll
            for (int et = 0; et < 2; ++et) vf[et] = tr_frag(vimg + rl * 512 + (((2 * wave + et) ^ sR) << 5) + 8 * pp, 2048);
#pragma unroll
            for (int tt = 0; tt < 4; ++tt) { const int rt = 16 * tt + li; af[tt] = *(const LAS bf16x8*)(aimg + rt * 128 + ((ch ^ (rt & 7)) << 4)); }
#pragma unroll
            for (int et = 0; et < 2; ++et)
#pragma unroll
                for (int tt = 0; tt < 4; ++tt) o[et][tt] = __builtin_amdgcn_mfma_f32_16x16x32_bf16(vf[et], af[tt], o[et][tt], 0, 0, 0);
        }
#pragma unroll
        for (int tt = 0; tt < 4; ++tt) { float q2 = 0.f;
#pragma unroll
            for (int et = 0; et < 2; ++et) q2 += (o[et][tt][0] * o[et][tt][0] + o[et][tt][1] * o[et][tt][1]) + (o[et][tt][2] * o[et][tt][2] + o[et][tt][3] * o[et][tt][3]);
            q2 += __shfl_xor(q2, 16); q2 += __shfl_xor(q2, 32);
            if (g == 0) ssq[wave * 64 + 16 * tt + li] = q2; }
        __syncthreads();
#pragma unroll
        for (int tt = 0; tt < 4; ++tt) { const int t = 16 * tt + li; float q2 = 0.f;
#pragma unroll
            for (int w8 = 0; w8 < 8; ++w8) q2 += ssq[w8 * 64 + t];
            const float rs_ = 1.f / sqrtf(q2 * (1.f / 256.f) + LN_EPS);
#pragma unroll
            for (int et = 0; et < 2; ++et) { const int ee = 32 * wave + 16 * et + 4 * g;
                const f32x4 gg = *(const f32x4*)(p.gla_g + ee);
                const u32x2 rw = *(const u32x2*)(PROJ + (rowc + t) * DIN + C_GR + h * 256 + ee);
                const float r0 = __uint_as_float(rw.x << 16), r1 = __uint_as_float(rw.x & 0xffff0000u), r2 = __uint_as_float(rw.y << 16), r3 = __uint_as_float(rw.y & 0xffff0000u);
                u32x2 w; w.x = cvt_pk_bf16(o[et][tt][0] * rs_ * gg[0] * silu_f(r0), o[et][tt][1] * rs_ * gg[1] * silu_f(r1));
                w.y = cvt_pk_bf16(o[et][tt][2] * rs_ * gg[2] * silu_f(r2), o[et][tt][3] * rs_ * gg[3] * silu_f(r3));
                *(u32x2*)(MIXIN + (rowc + t) * D + h * 256 + ee) = w; } }
        if (cc < 3) {
#pragma unroll
            for (int ks = 0; ks < 2; ++ks) {
                const int rl = 32 * ks + 8 * g + qq;
                bf16x8 vf[4], kf[4];
#pragma unroll
                for (int et = 0; et < 4; ++et) vf[et] = tr_frag(vimg + rl * 512 + ((((e0 >> 4) + et) ^ sR) << 5) + 8 * pp, 2048);
#pragma unroll
                for (int dt = 0; dt < 4; ++dt) kf[dt] = tr_frag(kimg + rl * 256 + ((((d0 >> 4) + dt) ^ sR) << 5) + 8 * pp, 1024);
#pragma unroll
                for (int et = 0; et < 4; ++et)
#pragma unroll
                    for (int dt = 0; dt < 4; ++dt) S[et][dt] = __builtin_amdgcn_mfma_f32_16x16x32_bf16(vf[et], kf[dt], S[et][dt], 0, 0, 0);
            }
#pragma unroll
            for (int dt = 0; dt < 4; ++dt) { const float dl = __expf(blast[d0 + 16 * dt + li]);
#pragma unroll
                for (int et = 0; et < 4; ++et) S[et][dt] = S[et][dt] * dl; }
        }
    }
}

__device__ __forceinline__ void ph3_mfma(const Params& p, ldsp_t lds, bool rep = false) {
    bf16_t* PROJ = (bf16_t*)(p.ws + WS_PROJ);
    const float* rope = (const float*)(p.ws + WS_ROPE);
    float* HIDP = (float*)(p.ws + WS_HIDP);
    const int tid = threadIdx.x, lane = tid & 63, wave = tid >> 6, wm0 = (wave >> 1) * 64, wn0 = (wave & 1) * 64;
    if (false) for (int i = blockIdx.x * NTHR + tid; i < NTOK * 12 * 16; i += gridDim.x * NTHR) {
        const int f = i & 15, slot = (i >> 4) % 12, row = i / (16 * 12);
        const int cb = slot < 8 ? C_NQ + slot * 128 : (slot < 10 ? C_KSL + (slot - 8) * 128 : C_KWN + (slot - 10) * 128);
        const int pos = row % T;
        const float cs = rope[pos * 16 + f], sn = rope[65536 + pos * 16 + f];
        bf16_t* q = PROJ + (size_t)row * DIN + cb;
        const float x1 = bf2f(q[f]), x2 = bf2f(q[16 + f]);
        q[f] = f2bf(x1 * cs - x2 * sn); q[16 + f] = f2bf(x2 * cs + x1 * sn);
    }
    for (int u = blockIdx.x; u < 256; u += gridDim.x) {
        if (u < 128) { gla_a_unit(p, lds, u); continue; }
        const int v = u - 128, kv = v >> 6, mt = (v >> 4) & 3, nt = (v >> 3) & 1, ks = v & 7;
        const int m0 = mt * 256, n0 = nt * 128, cbase = kv ? C_VCM : C_KCM;
        TileSrc s;
#pragma unroll
        for (int i = 0; i < 4; ++i) { int rr = m0 + (tid >> 3) + 64 * i; if (rr > 1019) rr = 1019; const int g = rr & 1, bi = rr >> 1, b = bi / 255, ii = bi % 255;
            s.arow[i] = PROJ + (size_t)(b * T + 16 * ii + 4 * ks) * DIN + cbase + g * 128 + (tid & 7) * 8; }
        s.bcol = (kv ? p.w_cv1 : p.w_ck1) + (size_t)(ks * 512) * 256 + n0 + (tid & 31) * 4; s.bvalid = true; s.SA = DIN; s.ldb = 256; s.nkt = 8;
        f32x4 acc[4][4];
        gemm_tile(lds, s, acc);
#pragma unroll
        for (int mi = 0; mi < 4; ++mi)
#pragma unroll
            for (int ni = 0; ni < 4; ++ni) *(f32x4*)(HIDP + ((size_t)(kv * 8 + ks) * 1024 + m0 + wm0 + 16 * mi + (lane & 15)) * 256 + n0 + wn0 + 16 * ni + 4 * (lane >> 4)) = acc[mi][ni];
    }
}

__device__ __forceinline__ void ph3b_mfma(const Params& p, float* lds) {
    const float* HIDP = (const float*)(p.ws + WS_HIDP);
    const float* pebp = (const float*)(p.ws + WS_PEBP);
    const float* rope = (const float*)(p.ws + WS_ROPE);
    const int tid = threadIdx.x;
    for (int u = blockIdx.x; u < 2 * 255; u += gridDim.x) {
        const int kv = u / 255, rg = u % 255;
        const float* w2 = kv ? p.w_cv2 : p.w_ck2; const float* b2 = kv ? p.b_cv2 : p.b_ck2; const float* b1 = kv ? p.b_cv1 : p.b_ck1;
        bf16_t* OUT = (bf16_t*)(p.ws + (kv ? WS_VC : WS_KC));
        __syncthreads();
        for (int i = tid; i < 4 * 256; i += NTHR) { const int n = i & 255; float v = b1[n];
#pragma unroll
            for (int rs = 0; rs < 16; ++rs) v += pebp[(kv * 16 + rs) * 256 + n];
#pragma unroll
            for (int ks = 0; ks < 8; ++ks) v += HIDP[((size_t)(kv * 8 + ks) * 1024 + rg * 4) * 256 + i];
            lds[i] = silu_f(v); }
        __syncthreads();
        const int rl = tid >> 7, d = tid & 127, rr = rg * 4 + rl;
        float sacc = b2[d];
        for (int j = 0; j < 256; ++j) sacc = fmaf(lds[rl * 256 + j], w2[j * 128 + d], sacc);
        lds[1024 + tid] = sacc;
        __syncthreads();
        const int g = rr & 1, bi = rr >> 1, b = bi / 255, n = bi % 255;
        float o = sacc;
        if (kv == 0 && d < 32) {
            const int pos = 16 * n + 31, f = d & 15;
            const float cs = rope[pos * 16 + f], sn = rope[65536 + pos * 16 + f];
            const float x1 = lds[1024 + rl * 128 + f], x2 = lds[1024 + rl * 128 + 16 + f];
            o = d < 16 ? x1 * cs - x2 * sn : x2 * cs + x1 * sn;
        }
        OUT[(((size_t)b * 256 + n) * 2 + g) * 128 + d] = f2bf(o);
    }
}

__device__ __forceinline__ void ph4_mfma(const Params& p, ldsp_t lds, int nrep_gla = 1, int nrep_nsa = 1) {
    unsigned* qh = (unsigned*)(p.ws + WS_CTL) + CW_Q;
    LAS int* nxt = (LAS int*)(lds + LDS_BYTES - 128);
    for (int r = 0; r < nrep_gla; ++r)
    for (;;) {
        __syncthreads();
        if (threadIdx.x == 0) *nxt = (int)__hip_atomic_fetch_add(qh + 128 * r, 1u, __ATOMIC_RELAXED, __HIP_MEMORY_SCOPE_AGENT);
        __syncthreads();
        const int u = *nxt;
        if (u >= 128) break;
        gla_c_unit(p, lds, u);
    }
    for (int r = 0; r < nrep_nsa; ++r)
    for (;;) {
        __syncthreads();
        if (threadIdx.x == 0) *nxt = (int)__hip_atomic_fetch_add(qh + 64 + 128 * r, 1u, __ATOMIC_RELAXED, __HIP_MEMORY_SCOPE_AGENT);
        __syncthreads();
        const int u = *nxt;
        if (u >= 512) break;
        nsa_unit(p, lds, u);
    }
}


__device__ __forceinline__ u32x4 pair16(u32x2 t0, u32x2 t1, int g) {
    const bool odd = g & 1;
    const unsigned s0 = odd ? t0.x : t1.x, s1 = odd ? t0.y : t1.y;
    const unsigned r0 = (unsigned)__shfl_xor((int)s0, 16), r1 = (unsigned)__shfl_xor((int)s1, 16);
    u32x4 o;
    o.x = odd ? r0 : t0.x; o.y = odd ? r1 : t0.y; o.z = odd ? t1.x : r0; o.w = odd ? t1.y : r1;
    return o;
}
__device__ __forceinline__ int lane_id_opaque() { int l; asm volatile("v_mbcnt_lo_u32_b32 %0, -1, 0\n\tv_mbcnt_hi_u32_b32 %0, -1, %0" : "=v"(l)); return l; }
__device__ __forceinline__ int a_src_chunk(int tid) { return ((tid & 3) ^ f4((tid >> 4) & 3)) * 8; }

__device__ __forceinline__ void ph2_v2(const Params& p, ldsp_t lds) {
    const bf16_t* H = (const bf16_t*)(p.ws + WS_H);
    bf16_t* PROJ = (bf16_t*)(p.ws + WS_PROJ);
    const int tid0 = threadIdx.x, wave = __builtin_amdgcn_readfirstlane(tid0 >> 6), wm0 = (wave >> 2) * 128, wn0 = (wave & 3) * 64;
    const int vcu = vcu_of_block();
    constexpr int NT = (DIN + 255) / 256;
    for (int u = vcu; u < 4 * 6 * 32; u += gridDim.x) {
        const int sb = u >> 5, j = u & 31, mt = (sb & 3) * 8 + (j & 7), nt = (sb >> 2) * 4 + (j >> 3);
        if (nt >= NT) continue;
        const int m0 = mt * 256, n0 = nt * 256;
        int tid = threadIdx.x; asm volatile("" : "+v"(tid));
        TileSrc2b s;
#pragma unroll
        for (int i = 0; i < 2; ++i) s.arow[i] = H + (size_t)(m0 + (tid >> 2) + 128 * i) * D + a_src_chunk(tid);
        b_src_setup(s, (const bf16_t*)(p.ws + WS_WINB), DIN, n0, DIN, tid);
        s.SA = 128; s.ldb = DIN; s.nkt = D / 32;
        f32x4 acc[8][4];
        gemm_tile2b(lds, s, acc);
        const int lane = lane_id_opaque();
        const int g = lane >> 4;
        {
          const int c0 = n0 + wn0 + 16;
          const bool is_rope = (c0 >= C_NQ && c0 < C_NQ + 1024 && ((c0 - C_NQ) & 127) == 0) || c0 == C_KSL || c0 == C_KSL + 128 || c0 == C_KWN || c0 == C_KWN + 128;
          if (is_rope) {
              const float* rope = (const float*)(p.ws + WS_ROPE);
#pragma unroll
              for (int mi = 0; mi < 8; ++mi) { const int pos = (m0 + wm0 + 16 * mi + (lane & 15)) % T;
                  const f32x4 cs = *(const f32x4*)(rope + pos * 16 + 4 * g), sn = *(const f32x4*)(rope + 65536 + pos * 16 + 4 * g);
                  const f32x4 x1 = acc[mi][1], x2 = acc[mi][2];
                  acc[mi][1] = x1 * cs - x2 * sn; acc[mi][2] = x2 * cs + x1 * sn; } } }
#pragma unroll
        for (int mi = 0; mi < 8; ++mi)
#pragma unroll
            for (int np = 0; np < 2; ++np) {
                u32x2 t0, t1; t0.x = cvt_pk_bf16(acc[mi][2 * np][0], acc[mi][2 * np][1]); t0.y = cvt_pk_bf16(acc[mi][2 * np][2], acc[mi][2 * np][3]);
                t1.x = cvt_pk_bf16(acc[mi][2 * np + 1][0], acc[mi][2 * np + 1][1]); t1.y = cvt_pk_bf16(acc[mi][2 * np + 1][2], acc[mi][2 * np + 1][3]);
                const u32x4 o = pair16(t0, t1, g);
                const int m = m0 + wm0 + 16 * mi + (lane & 15), n = n0 + wn0 + 32 * np + ((g & 1) ? 16 + 4 * (g - 1) : 4 * g);
                if (n < DIN) *(u32x4*)(PROJ + (size_t)m * DIN + n) = o;
            }
    }
}

__device__ __forceinline__ void ph5_v2(const Params& p, ldsp_t lds) {
    const bf16_t* MIXIN = (const bf16_t*)(p.ws + WS_MIXIN);
    const float* mod = (const float*)(p.ws + WS_MOD);
    float* Z = (float*)(p.ws + WS_Z);
    const int tid0 = threadIdx.x, wave = __builtin_amdgcn_readfirstlane(tid0 >> 6), wm0 = (wave >> 2) * 128, wn0 = (wave & 3) * 64;
    const int vcu = vcu_of_block();
    for (int u = vcu; u < 32 * 8; u += gridDim.x) {
        const int sb = u >> 5, j = u & 31, mt = (sb & 3) * 8 + (j & 7), nt = (sb >> 2) * 4 + (j >> 3);
        const int m0 = mt * 256, n0 = nt * 256;
        int tid = threadIdx.x; asm volatile("" : "+v"(tid));
        TileSrc2b s;
#pragma unroll
        for (int i = 0; i < 2; ++i) s.arow[i] = MIXIN + (size_t)(m0 + (tid >> 2) + 128 * i) * D + a_src_chunk(tid);
        b_src_setup(s, (const bf16_t*)(p.ws + WS_WOB), D, n0, D, tid);
        s.SA = 128; s.ldb = D; s.nkt = D / 32;
        f32x4 acc[8][4];
        gemm_tile2b(lds, s, acc);
        const int lane = lane_id_opaque();
        const int b = m0 / T;
#pragma unroll
        for (int ni = 0; ni < 4; ++ni) {
            const int n = n0 + wn0 + 16 * ni + 4 * (lane >> 4);
            const f32x4 g1 = 1.f + *(const f32x4*)(mod + b * 12288 + 2 * 2048 + n);
#pragma unroll
            for (int mi = 0; mi < 8; ++mi) { const size_t o = (size_t)(m0 + wm0 + 16 * mi + (lane & 15)) * D + n;
                *(f32x4*)(Z + o) = DN_ALPHA * *(const f32x4*)(p.x + o) + g1 * acc[mi][ni]; }
        }
    }
}

__device__ __forceinline__ void ph7_v2(const Params& p, ldsp_t lds) {
    const bf16_t* H2 = (const bf16_t*)(p.ws + WS_H);
    const int* LIST = (const int*)(p.ws + WS_LIST);
    bf16_t* ACT = (bf16_t*)(p.ws + WS_ACT);
    LAS int* li = (LAS int*)(lds + G2_LDS);
    moe_offsets256(p, li);
    const int tid0 = threadIdx.x, wave = __builtin_amdgcn_readfirstlane(tid0 >> 6), wm0 = (wave >> 2) * 128, wn = wave & 3;
    unsigned* qh = (unsigned*)(p.ws + WS_CTL) + CW_Q + 256;
    LAS int* nxt = (LAS int*)(lds + LDS_BYTES - 128);
    const int myx = (int)(xb_xcc_id() & 7u);
    for (int qi = 0; qi < 8; ++qi) {
    const int xq = (myx + qi) & 7;
    for (;;) {
        __syncthreads();
        if (threadIdx.x == 0) *nxt = (int)__hip_atomic_fetch_add(qh + 64 * xq, 1u, __ATOMIC_RELAXED, __HIP_MEMORY_SCOPE_AGENT);
        __syncthreads();
        const int u = *nxt;
        int e = xq, base = 0;
        for (; e < 32; e += 8) { const int ne = (li[72 + e + 1] - li[72 + e]) * 16; if (u < base + ne) break; base += ne; }
        if (e >= 32) break;
        const int mte = li[72 + e + 1] - li[72 + e];
        const int ul = u - base, nt = ul / mte, mt = ul % mte;
        const int cnt = li[e], off = li[32 + e], n0 = nt * 128;
        int tid = threadIdx.x; asm volatile("" : "+v"(tid));
        TileSrc2 s;
#pragma unroll
        for (int i = 0; i < 2; ++i) { int rr = mt * 256 + (tid >> 2) + 128 * i; if (rr >= cnt) rr = cnt - 1; const int slot = LIST[e * 8192 + rr]; s.arow[i] = H2 + (size_t)(slot >> 2) * D + a_src_chunk(tid); }
        { const int c = (tid & 31) * 8, w = c >> 6, jj = c & 63;
          s.bcol = (jj < 32 ? p.w_gate : p.w_up) + (size_t)e * D * DFF + n0 + 32 * w + (jj & 31); }
        s.bvalid = true; s.SA = 128; s.ldb = DFF; s.nkt = D / 32;
        f32x4 acc[8][4];
        const int nmi_ = min(8, max(0, (cnt - mt * 256 - (wave >> 2) * 128 + 15) >> 4));
        gemm_tile2(lds, s, acc, nmi_);
        const int lane = lane_id_opaque();
        { const int g = lane >> 4;
          f32x4 bg[2], bu[2];
#pragma unroll
          for (int ni = 0; ni < 2; ++ni) { const int n = n0 + 32 * wn + 16 * ni + 4 * g; bg[ni] = *(const f32x4*)(p.b_gate + e * DFF + n); bu[ni] = *(const f32x4*)(p.b_up + e * DFF + n); }
#pragma unroll
          for (int mi = 0; mi < 8; ++mi) { const int rr = mt * 256 + wm0 + 16 * mi + (lane & 15);
              u32x2 t[2];
#pragma unroll
              for (int ni = 0; ni < 2; ++ni) { float a[4];
#pragma unroll
                  for (int i = 0; i < 4; ++i) { const float gt = fminf(acc[mi][ni][i] + bg[ni][i], 7.f), up = fminf(fmaxf(acc[mi][ni + 2][i] + bu[ni][i], -7.f), 7.f); a[i] = gt * sigmoid_f(1.702f * gt) * (up + 1.f); }
                  t[ni].x = cvt_pk_bf16(a[0], a[1]); t[ni].y = cvt_pk_bf16(a[2], a[3]); }
              const u32x4 o = pair16(t[0], t[1], g);
              const int n = n0 + 32 * wn + ((g & 1) ? 16 + 4 * (g - 1) : 4 * g);
              if (rr < cnt) *(u32x4*)(ACT + (size_t)(off + rr) * DFF + n) = o; } }
    }
    }
}

__device__ __forceinline__ void ph8_v2(const Params& p, ldsp_t lds) {
    const bf16_t* ACT = (const bf16_t*)(p.ws + WS_ACT);
    const int* LIST = (const int*)(p.ws + WS_LIST);
    const float* TOPW = (const float*)(p.ws + WS_TOPW);
    bf16_t* YP = (bf16_t*)(p.ws + WS_YP);
    LAS int* li = (LAS int*)(lds + G2_LDS);
    moe_offsets256(p, li);
    const int tid0 = threadIdx.x, wave = __builtin_amdgcn_readfirstlane(tid0 >> 6), wm0 = (wave >> 2) * 128, wn0 = (wave & 3) * 64;
    unsigned* qh = (unsigned*)(p.ws + WS_CTL) + CW_Q + 256 + 512;
    LAS int* nxt = (LAS int*)(lds + LDS_BYTES - 128);
    const int myx = (int)(xb_xcc_id() & 7u);
    for (int qi = 0; qi < 8; ++qi) {
    const int xq = (myx + qi) & 7;
    for (;;) {
        __syncthreads();
        if (threadIdx.x == 0) *nxt = (int)__hip_atomic_fetch_add(qh + 64 * xq, 1u, __ATOMIC_RELAXED, __HIP_MEMORY_SCOPE_AGENT);
        __syncthreads();
        const int u = *nxt;
        int e = xq, base = 0;
        for (; e < 32; e += 8) { const int ne = (li[72 + e + 1] - li[72 + e]) * 8; if (u < base + ne) break; base += ne; }
        if (e >= 32) break;
        const int mte = li[72 + e + 1] - li[72 + e];
        const int ul = u - base, nt = ul / mte, mt = ul % mte;
        const int cnt = li[e], off = li[32 + e], n0 = nt * 256;
        int tid = threadIdx.x; asm volatile("" : "+v"(tid));
        TileSrc2 s;
#pragma unroll
        for (int i = 0; i < 2; ++i) { int rr = mt * 256 + (tid >> 2) + 128 * i; if (rr >= cnt) rr = cnt - 1; s.arow[i] = ACT + (size_t)(off + rr) * DFF + a_src_chunk(tid); }
        s.bcol = p.w_down + (size_t)e * DFF * D + n0 + (tid & 31) * 8; s.bvalid = true; s.SA = 128; s.ldb = D; s.nkt = DFF / 32;
        f32x4 acc[8][4];
        const int nmi_ = min(8, max(0, (cnt - mt * 256 - (wave >> 2) * 128 + 15) >> 4));
        gemm_tile2(lds, s, acc, nmi_);
        const int lane = lane_id_opaque();
        { const int g = lane >> 4;
          f32x4 bd[4];
#pragma unroll
          for (int ni = 0; ni < 4; ++ni) bd[ni] = *(const f32x4*)(p.b_down + e * D + n0 + wn0 + 16 * ni + 4 * g);
#pragma unroll
          for (int mi = 0; mi < 8; ++mi) { int rr = mt * 256 + wm0 + 16 * mi + (lane & 15); const bool ok = rr < cnt; if (!ok) rr = cnt - 1;
              const int slot = LIST[e * 8192 + rr]; const float w = TOPW[slot];
#pragma unroll
              for (int np = 0; np < 2; ++np) { u32x2 t[2];
#pragma unroll
                  for (int k2 = 0; k2 < 2; ++k2) { const f32x4 y = w * (acc[mi][2 * np + k2] + bd[2 * np + k2]); t[k2].x = cvt_pk_bf16(y[0], y[1]); t[k2].y = cvt_pk_bf16(y[2], y[3]); }
                  const u32x4 o = pair16(t[0], t[1], g);
                  const int n = n0 + wn0 + 32 * np + ((g & 1) ? 16 + 4 * (g - 1) : 4 * g);
                  if (ok) *(u32x4*)(YP + (size_t)slot * D + n) = o; } } }
    }
    }
}


constexpr int CW_DONE = 32768;
__device__ __forceinline__ void ph78(const Params& p, ldsp_t lds) {
    const bf16_t* H2 = (const bf16_t*)(p.ws + WS_H);
    const int* LIST = (const int*)(p.ws + WS_LIST);
    const float* TOPW = (const float*)(p.ws + WS_TOPW);
    bf16_t* ACT = (bf16_t*)(p.ws + WS_ACT);
    bf16_t* YP = (bf16_t*)(p.ws + WS_YP);
    LAS int* li = (LAS int*)(lds + G2_LDS);
    moe_offsets256(p, li);
    const int tid0 = threadIdx.x, wave = __builtin_amdgcn_readfirstlane(tid0 >> 6), wm0 = (wave >> 2) * 128, wn = wave & 3;
    unsigned* qh = (unsigned*)(p.ws + WS_CTL) + CW_Q + 256;
    unsigned* done = (unsigned*)(p.ws + WS_CTL) + CW_DONE;
    LAS int* nxt = (LAS int*)(lds + LDS_BYTES - 128);
    const int myx = (int)(xb_xcc_id() & 7u);
    const auto actr = __builtin_amdgcn_make_buffer_rsrc((void*)ACT, 0, 0x7fffffff, 0x00020000);
    int pend = -1;
    for (int qi = 0; qi < 8; ++qi) {
    const int xq = (myx + qi) & 7;
    for (;;) {
        asm volatile("s_waitcnt vmcnt(0)" ::: "memory");
        __syncthreads();
        if (threadIdx.x == 0) {
            if (pend >= 0) __hip_atomic_fetch_add(done + 16 * pend, 1u, __ATOMIC_RELAXED, __HIP_MEMORY_SCOPE_AGENT);
            *nxt = (int)__hip_atomic_fetch_add(qh + 64 * xq, 1u, __ATOMIC_RELAXED, __HIP_MEMORY_SCOPE_AGENT);
        }
        pend = -1;
        __syncthreads();
        const int u = *nxt;
        int base = 0, sg = 0, kind = 0, e = 0, mte = 0;
        for (; sg < 8; ++sg) { kind = (0xD4 >> sg) & 1; e = xq + 8 * ((0xED84 >> (2 * sg)) & 3); mte = li[72 + e + 1] - li[72 + e];
            const int ne = mte * (kind ? 8 : 16); if (u < base + ne) break; base += ne; }
        if (sg >= 8) break;
        const int ul = u - base, nt = ul / mte, mt = ul % mte;
        const int cnt = li[e], off = li[32 + e], n0 = kind ? nt * 256 : nt * 128;
        int tid = threadIdx.x; asm volatile("" : "+v"(tid));
        TileSrc2 s;
        if (kind == 0) {
#pragma unroll
            for (int i = 0; i < 2; ++i) { int rr = mt * 256 + (tid >> 2) + 128 * i; if (rr >= cnt) rr = cnt - 1; const int slot = LIST[e * 8192 + rr]; s.arow[i] = H2 + (size_t)(slot >> 2) * D + a_src_chunk(tid); }
            const int c = (tid & 31) * 8, w = c >> 6, jj = c & 63;
            s.bcol = (jj < 32 ? p.w_gate : p.w_up) + (size_t)e * D * DFF + n0 + 32 * w + (jj & 31);
        } else {
#pragma unroll
            for (int i = 0; i < 2; ++i) { int rr = mt * 256 + (tid >> 2) + 128 * i; if (rr >= cnt) rr = cnt - 1; s.arow[i] = ACT + (size_t)(off + rr) * DFF + a_src_chunk(tid); }
            s.bcol = p.w_down + (size_t)e * DFF * D + n0 + (tid & 31) * 8;
            if (threadIdx.x == 0) {
                unsigned sp = 0;
                while (__hip_atomic_load(done + 16 * (e * 32 + mt), __ATOMIC_RELAXED, __HIP_MEMORY_SCOPE_AGENT) < 16u) { __builtin_amdgcn_s_sleep(2); if (++sp > (1u << 22)) break; }
                __builtin_amdgcn_fence(__ATOMIC_ACQUIRE, "agent");
                asm volatile("s_waitcnt vmcnt(0)" ::: "memory");
            }
        }
        s.bvalid = true; s.SA = 128; s.ldb = DFF; s.nkt = D / 32;
        f32x4 acc[8][4];
        const int nmi_ = __builtin_amdgcn_readfirstlane(min(8, max(0, (cnt - mt * 256 - (wave >> 2) * 128 + 15) >> 4)));
        gemm_tile2(lds, s, acc, nmi_);
        const int lane = lane_id_opaque();
        const int g = lane >> 4;
        if (kind == 0) {
          f32x4 bg[2], bu[2];
#pragma unroll
          for (int ni = 0; ni < 2; ++ni) { const int n = n0 + 32 * wn + 16 * ni + 4 * g; bg[ni] = *(const f32x4*)(p.b_gate + e * DFF + n); bu[ni] = *(const f32x4*)(p.b_up + e * DFF + n); }
#pragma unroll
          for (int mi = 0; mi < 8; ++mi) { const int rr = mt * 256 + wm0 + 16 * mi + (lane & 15);
              u32x2 t[2];
#pragma unroll
              for (int ni = 0; ni < 2; ++ni) { float a[4];
#pragma unroll
                  for (int i = 0; i < 4; ++i) { const float gt = fminf(acc[mi][ni][i] + bg[ni][i], 7.f), up = fminf(fmaxf(acc[mi][ni + 2][i] + bu[ni][i], -7.f), 7.f); a[i] = gt * sigmoid_f(1.702f * gt) * (up + 1.f); }
                  t[ni].x = cvt_pk_bf16(a[0], a[1]); t[ni].y = cvt_pk_bf16(a[2], a[3]); }
              const u32x4 o = pair16(t[0], t[1], g);
              const int n = n0 + 32 * wn + ((g & 1) ? 16 + 4 * (g - 1) : 4 * g);
              if (rr < cnt) __builtin_amdgcn_raw_buffer_store_b128(o, actr, ((off + rr) * DFF + n) * 2, 0, 16); }
          pend = e * 32 + mt;
        } else {
          const int wn0 = wn * 64;
          f32x4 bd[4];
#pragma unroll
          for (int ni = 0; ni < 4; ++ni) bd[ni] = *(const f32x4*)(p.b_down + e * D + n0 + wn0 + 16 * ni + 4 * g);
#pragma unroll
          for (int mi = 0; mi < 8; ++mi) { int rr = mt * 256 + wm0 + 16 * mi + (lane & 15); const bool ok = rr < cnt; if (!ok) rr = cnt - 1;
              const int slot = LIST[e * 8192 + rr]; const float w = TOPW[slot];
#pragma unroll
              for (int np = 0; np < 2; ++np) { u32x2 t[2];
#pragma unroll
                  for (int k2 = 0; k2 < 2; ++k2) { const f32x4 y = w * (acc[mi][2 * np + k2] + bd[2 * np + k2]); t[k2].x = cvt_pk_bf16(y[0], y[1]); t[k2].y = cvt_pk_bf16(y[2], y[3]); }
                  const u32x4 o = pair16(t[0], t[1], g);
                  const int n = n0 + wn0 + 32 * np + ((g & 1) ? 16 + 4 * (g - 1) : 4 * g);
                  if (ok) *(u32x4*)(YP + (size_t)slot * D + n) = o; } }
        }
    }
    }
}

__device__ __forceinline__ void ph6_v2(const Params& p, ldsp_t lds, const int rep = 0) {
    const float* Z = (const float*)(p.ws + WS_Z);
    const float* mod = (const float*)(p.ws + WS_MOD);
    bf16_t* H2 = (bf16_t*)(p.ws + WS_H);
    const bf16_t* WRT = (const bf16_t*)(p.ws + WS_WRT);
    float* TOPW = (float*)(p.ws + WS_TOPW + (rep ? 512 * 1024 : 0));
    int* LIST = (int*)(p.ws + WS_LIST + (rep ? MiB : 0));
    unsigned* ctl = (unsigned*)(p.ws + WS_CTL) + (rep ? 32 * 64 : 0);
    const int tid = threadIdx.x, lane = tid & 63, wave = __builtin_amdgcn_readfirstlane(tid >> 6);
    ldsp_t img_hi = lds, img_lo = lds + 65536;
    LAS float* part = (LAS float*)(lds + 131072);
    LAS float* lgt = (LAS float*)(lds + 131072 + 16384);
    for (int blk = blockIdx.x; blk < NTOK / 32; blk += gridDim.x) {
        for (int half = 0; half < 2; ++half) {
            __syncthreads();
#pragma unroll 1
            for (int rr = 0; rr < 2; ++rr) {
                const int rl = 2 * wave + rr, row = blk * 32 + half * 16 + rl, b = row / T;
                const f32x4* zr = (const f32x4*)(Z + (size_t)row * D) + lane;
                f32x4 v[8]; float s1 = 0.f;
#pragma unroll
                for (int j = 0; j < 8; ++j) { v[j] = zr[64 * j]; s1 += (v[j][0] + v[j][1]) + (v[j][2] + v[j][3]); }
                float mean = wave_sum(s1) * (1.f / D), s2 = 0.f;
#pragma unroll
                for (int j = 0; j < 8; ++j) { v[j] = v[j] - mean; s2 += (v[j][0] * v[j][0] + v[j][1] * v[j][1]) + (v[j][2] * v[j][2] + v[j][3] * v[j][3]); }
                float rstd = 1.f / sqrtf(wave_sum(s2) * (1.f / D) + LN_EPS);
                s1 = 0.f;
#pragma unroll
                for (int j = 0; j < 8; ++j) { const int c0 = 256 * j + lane * 4;
                    v[j] = v[j] * rstd * *(const f32x4*)(p.ln1_g + c0) + *(const f32x4*)(p.ln1_b + c0);
                    s1 += (v[j][0] + v[j][1]) + (v[j][2] + v[j][3]); }
                mean = wave_sum(s1) * (1.f / D); s2 = 0.f;
#pragma unroll
                for (int j = 0; j < 8; ++j) { v[j] = v[j] - mean; s2 += (v[j][0] * v[j][0] + v[j][1] * v[j][1]) + (v[j][2] * v[j][2] + v[j][3] * v[j][3]); }
                rstd = 1.f / sqrtf(wave_sum(s2) * (1.f / D) + LN_EPS);
                u32x2* o8 = (u32x2*)(H2 + (size_t)row * D) + lane;
#pragma unroll
                for (int j = 0; j < 8; ++j) { const int c0 = 256 * j + lane * 4;
                    const f32x4 sh = *(const f32x4*)(mod + b * 12288 + 3 * 2048 + c0), sc = *(const f32x4*)(mod + b * 12288 + 4 * 2048 + c0);
                    const f32x4 h = v[j] * rstd * (1.f + sc) + sh;
                    u32x2 hi; hi.x = cvt_pk_bf16(h[0], h[1]); hi.y = cvt_pk_bf16(h[2], h[3]);
                    o8[64 * j] = hi;
                    const float r0 = h[0] - __uint_as_float(hi.x << 16), r1 = h[1] - __uint_as_float(hi.x & 0xffff0000u), r2 = h[2] - __uint_as_float(hi.y << 16), r3 = h[3] - __uint_as_float(hi.y & 0xffff0000u);
                    u32x2 lo; lo.x = cvt_pk_bf16(r0, r1); lo.y = cvt_pk_bf16(r2, r3);
                    const unsigned off = (unsigned)(rl * 4096 + ((((32 * j + (lane >> 1))) ^ (rl & 15)) << 4) + (lane & 1) * 8);
                    *(LAS u32x2*)(img_hi + off) = hi; *(LAS u32x2*)(img_lo + off) = lo; }
            }
            __syncthreads();
            { const int r = lane & 15, g = lane >> 4;
              f32x4 acc[2] = {(f32x4){0.f, 0.f, 0.f, 0.f}, (f32x4){0.f, 0.f, 0.f, 0.f}};
#pragma unroll 2
              for (int ks = 0; ks < 8; ++ks) {
                  const int k0 = 256 * wave + 32 * ks, ch = (k0 >> 3) + g;
                  const unsigned aoff = (unsigned)(r * 4096 + ((ch ^ r) << 4));
                  const bf16x8 ahi = *(const LAS bf16x8*)(img_hi + aoff), alo = *(const LAS bf16x8*)(img_lo + aoff);
#pragma unroll
                  for (int et = 0; et < 2; ++et) {
                      const bf16x8 whi = *(const bf16x8*)(WRT + (size_t)(16 * et + r) * 2048 + k0 + 8 * g);
                      const bf16x8 wlo = *(const bf16x8*)(WRT + 65536 + (size_t)(16 * et + r) * 2048 + k0 + 8 * g);
                      acc[et] = __builtin_amdgcn_mfma_f32_16x16x32_bf16(whi, ahi, acc[et], 0, 0, 0);
                      acc[et] = __builtin_amdgcn_mfma_f32_16x16x32_bf16(whi, alo, acc[et], 0, 0, 0);
                      acc[et] = __builtin_amdgcn_mfma_f32_16x16x32_bf16(wlo, ahi, acc[et], 0, 0, 0);
                  }
              }
#pragma unroll
              for (int et = 0; et < 2; ++et)
#pragma unroll
                  for (int i = 0; i < 4; ++i) part[(wave * 16 + r) * 32 + 16 * et + 4 * g + i] = acc[et][i];
            }
            __syncthreads();
            { const int rl = tid >> 5, e = tid & 31; float sum = p.b_router[e];
#pragma unroll
              for (int w8 = 0; w8 < 8; ++w8) sum += part[(w8 * 16 + rl) * 32 + e];
              lgt[rl * 32 + e] = sum; }
            __syncthreads();
            if (tid < 16) {
                const int row = blk * 32 + half * 16 + tid;
                float tv[4]; int ti[4];
#pragma unroll
                for (int k = 0; k < 4; ++k) { tv[k] = -INFINITY; ti[k] = 0; }
                for (int e = 0; e < 32; ++e) {
                    const float v = lgt[tid * 32 + e];
                    if (v > tv[3]) {
                        if (v > tv[0]) { tv[3] = tv[2]; ti[3] = ti[2]; tv[2] = tv[1]; ti[2] = ti[1]; tv[1] = tv[0]; ti[1] = ti[0]; tv[0] = v; ti[0] = e; }
                        else if (v > tv[1]) { tv[3] = tv[2]; ti[3] = ti[2]; tv[2] = tv[1]; ti[2] = ti[1]; tv[1] = v; ti[1] = e; }
                        else if (v > tv[2]) { tv[3] = tv[2]; ti[3] = ti[2]; tv[2] = v; ti[2] = e; }
                        else { tv[3] = v; ti[3] = e; }
                    }
                }
                const float e1 = __expf(tv[1] - tv[0]), e2 = __expf(tv[2] - tv[0]), e3 = __expf(tv[3] - tv[0]);
                const float isum = 1.f / (1.f + e1 + e2 + e3);
                const float ww[4] = {isum, e1 * isum, e2 * isum, e3 * isum};
#pragma unroll
                for (int k = 0; k < 4; ++k) {
                    const unsigned pos = atomicAdd(ctl + CW_CNT + 64 * ti[k], 1u);
                    LIST[ti[k] * 8192 + pos] = row * 4 + k;
                    TOPW[row * 4 + k] = ww[k];
                }
            }
        }
    }
}


constexpr int NPHASE = 11;
__global__ void __launch_bounds__(NTHR, 2) fwd_kernel(Params p) {
    extern __shared__ __attribute__((aligned(16))) unsigned char lds_raw[];
    float* lds = (float*)lds_raw;
    volatile LAS unsigned* misc = (volatile LAS unsigned*)((LAS unsigned char*)lds_raw + LDS_BYTES - 64);
    if (threadIdx.x < 16) misc[threadIdx.x] = 0u;
    __syncthreads();
    unsigned* ctl = (unsigned*)(p.ws + WS_CTL);
    const bool multi = (p.ph_hi - p.ph_lo) > 1;
    XcdBarrier bar; bar.bar = ctl + CW_BAR; bar.x = 0; bar.st = misc;
    if (multi) bar = xcd_barrier_post(ctl + CW_BAR, misc);
#define IN(k) (p.ph_lo <= (k) && (k) < p.ph_hi)
#ifndef REPEAT_PHASE
#define REPEAT_PHASE -1
#endif
#define SEAM(k) do { if (IN(k) && IN((k) + 1)) xcd_barrier(bar); } while (0)
    if (IN(0)) { ph0(p, lds); if (REPEAT_PHASE == 0) ph0(p, lds); }
    SEAM(0);
    if (IN(1)) { ph1(p, lds); if (REPEAT_PHASE == 1) ph1(p, lds); }
    SEAM(1);
    if (IN(2)) { ph2_v2(p, (ldsp_t)lds_raw); if (REPEAT_PHASE == 2) ph2_v2(p, (ldsp_t)lds_raw); }
    SEAM(2);
    if (IN(3)) { ph3_mfma(p, (ldsp_t)lds_raw); if (REPEAT_PHASE == 3) ph3_mfma(p, (ldsp_t)lds_raw, true); }
    SEAM(3);
    if (IN(4)) { ph3b_mfma(p, lds); if (REPEAT_PHASE == 4) ph3b_mfma(p, lds); }
    SEAM(4);
    if (IN(5)) ph4_mfma(p, (ldsp_t)lds_raw, REPEAT_PHASE == 50 ? 2 : 1, REPEAT_PHASE == 51 ? 2 : 1);
    SEAM(5);
    if (IN(6)) { ph5_v2(p, (ldsp_t)lds_raw); if (REPEAT_PHASE == 6) ph5_v2(p, (ldsp_t)lds_raw); }
    SEAM(6);
    if (IN(7)) { for (int r7 = 0; r7 < (REPEAT_PHASE == 7 ? 2 : 1); ++r7) ph6_v2(p, (ldsp_t)lds_raw, r7); }
    SEAM(7);
    if (IN(8)) ph78(p, (ldsp_t)lds_raw);
    SEAM(9);
    if (IN(10)) { ph9(p, lds); if (REPEAT_PHASE == 10) ph9(p, lds); }
}

extern "C" void kernel_launch(void* const* d_in, const int* in_sizes, int n_in, void* d_out, int out_size, void* d_ws, size_t ws_size, hipStream_t stream) {
    static int grid = 0;
    if (grid == 0) {
        int dev = 0, cus = 0;
        if (hipGetDevice(&dev) != hipSuccess || hipDeviceGetAttribute(&cus, hipDeviceAttributeMultiprocessorCount, dev) != hipSuccess) { fprintf(stderr, "kernel_launch: device query failed\n"); grid = -1; return; }
        if (hipFuncSetAttribute((const void*)fwd_kernel, hipFuncAttributeMaxDynamicSharedMemorySize, LDS_BYTES) != hipSuccess) { fprintf(stderr, "kernel_launch: hipFuncSetAttribute failed\n"); grid = -1; return; }
        if (n_in != 31 || ws_size < WS_END) { fprintf(stderr, "kernel_launch: unexpected n_in %d / ws %zu\n", n_in, ws_size); grid = -1; return; }
        (void)hipGetLastError();
        grid = cus;
    }
    if (grid < 0) return;
    (void)hipMemsetAsync((char*)d_ws + WS_CTL, 0, CTL_BYTES, stream);
    Params p{};
    const float** f = (const float**)&p;
    for (int i = 0; i < 31; ++i) f[i] = (const float*)d_in[i];
    p.out = (float*)d_out; p.ws = (unsigned char*)d_ws;
#if N_LAUNCH_MODE == 1
    p.ph_lo = 0; p.ph_hi = NPHASE;
    hipLaunchKernelGGL(fwd_kernel, dim3(grid), dim3(NTHR), LDS_BYTES, stream, p);
#else
    for (int k = 0; k < NPHASE; ++k) { p.ph_lo = k; p.ph_hi = k + 1; hipLaunchKernelGGL(fwd_kernel, dim3(grid), dim3(NTHR), LDS_BYTES, stream, p); }
#endif
}
```
